# Optimizing an MI355X kernel written in HIP

```python
import jax, jax.numpy as jnp
from jax import lax
import numpy as np

D_MODEL = 1024
BATCH = 8
SEQ = 4096
DEPTH = 1

MEM_LEN = 256
EPS = 1e-6
HEAD_DIM = 64
ATTN_WIDTH = D_MODEL // 2
ATTN_Q_HEADS = ATTN_WIDTH // HEAD_DIM
ATTN_KV_HEADS = 2
ATTN_REP = ATTN_Q_HEADS // ATTN_KV_HEADS
KV_WIDTH = ATTN_KV_HEADS * HEAD_DIM
WINDOW = 128
ATTN_BLOCK = 128
SGU_WIDTH = D_MODEL - ATTN_WIDTH
SGU_GROUP_DIM = 64
SGU_GROUPS = SGU_WIDTH // SGU_GROUP_DIM
SGU_CHUNK = 128
IN_WIDTH = ATTN_WIDTH + 2 * KV_WIDTH + 2 * SGU_WIDTH
X_HEADS = 4
X_HEAD_DIM = D_MODEL // X_HEADS
N_GROUPS = 4
EXPERTS_PER_GROUP = 8
N_EXPERTS = N_GROUPS * EXPERTS_PER_GROUP
TOP_K = 2
D_EXPERT = D_MODEL // 2
MOE_BLOCK = 256

kernel_name = "hymba_swa_sgu_memxattn_hmoe"


def rms_norm(x, gain):
    xf = x.astype(jnp.float32)
    y = xf * lax.rsqrt(jnp.mean(xf * xf, axis=-1, keepdims=True) + EPS)
    return (y * gain.astype(jnp.float32)).astype(x.dtype)


def sliding_window_attention(q, k, v, sinks):
    B, S = q.shape[:2]
    nb = S // ATTN_BLOCK
    qb = q.reshape(B, nb, ATTN_BLOCK, ATTN_KV_HEADS, ATTN_REP, HEAD_DIM).astype(jnp.float32)
    kb = k.reshape(B, nb, ATTN_BLOCK, ATTN_KV_HEADS, HEAD_DIM)
    vb = v.reshape(B, nb, ATTN_BLOCK, ATTN_KV_HEADS, HEAD_DIM)
    pad = ((0, 0), (1, 0), (0, 0), (0, 0), (0, 0))
    kwin = jnp.concatenate([jnp.pad(kb, pad)[:, :-1], kb], axis=2).astype(jnp.float32)
    vwin = jnp.concatenate([jnp.pad(vb, pad)[:, :-1], vb], axis=2).astype(jnp.float32)
    scores = jnp.einsum('bnqhrd,bnkhd->bnhrqk', qb, kwin) * (HEAD_DIM ** -0.5)
    qi = jnp.arange(ATTN_BLOCK)[:, None]
    kj = jnp.arange(2 * ATTN_BLOCK)[None, :]
    dist = qi + ATTN_BLOCK - kj
    band = (dist >= 0) & (dist < WINDOW)
    key_pos = jnp.arange(nb)[:, None, None] * ATTN_BLOCK + kj[None] - ATTN_BLOCK
    mask = band[None] & (key_pos >= 0)
    scores = jnp.where(mask[None, :, None, None], scores, jnp.finfo(jnp.float32).min)
    sink = sinks.astype(jnp.float32).reshape(ATTN_KV_HEADS, ATTN_REP)[None, None, :, :, None, None]
    m = jnp.maximum(jnp.max(scores, axis=-1, keepdims=True), sink)
    p = jnp.exp(scores - m)
    denom = jnp.sum(p, axis=-1, keepdims=True) + jnp.exp(sink - m)
    out = jnp.einsum('bnhrqk,bnkhd->bnqhrd', p / denom, vwin)
    return out.reshape(B, S, ATTN_WIDTH).astype(q.dtype)


def spatial_gating(u, v, sgu_norm, sgu_w, sgu_b):
    B, S = u.shape[:2]
    nc = S // SGU_CHUNK
    vc = rms_norm(v, sgu_norm).reshape(B, nc, SGU_CHUNK, SGU_GROUPS, SGU_GROUP_DIM)
    causal = jnp.tril(jnp.ones((SGU_CHUNK, SGU_CHUNK), dtype=bool))
    w = jnp.where(causal[None], sgu_w, jnp.zeros((), sgu_w.dtype))
    s = jnp.einsum('gij,bcjgd->bcigd', w, vc) + sgu_b.T[None, None, :, :, None]
    return u * s.reshape(B, S, SGU_WIDTH)


def memory_cross_attention(h, mem_n, w_cq, w_ck, w_cv, cq_norm, ck_norm, w_co):
    B, S = h.shape[:2]
    M = mem_n.shape[1]
    q = rms_norm((h @ w_cq).reshape(B, S, X_HEADS, X_HEAD_DIM), cq_norm)
    k = rms_norm((mem_n @ w_ck).reshape(B, M, X_HEADS, X_HEAD_DIM), ck_norm)
    v = (mem_n @ w_cv).reshape(B, M, X_HEADS, X_HEAD_DIM)
    scores = jnp.einsum('bshd,bmhd->bhsm', q.astype(jnp.float32), k.astype(jnp.float32)) * (X_HEAD_DIM ** -0.5)
    p = jax.nn.softmax(scores, axis=-1)
    out = jnp.einsum('bhsm,bmhd->bshd', p, v.astype(jnp.float32)).astype(h.dtype)
    return out.reshape(B, S, D_MODEL) @ w_co


def hierarchical_moe(h, w_router_group, w_router_expert, w1, w3, w2):
    B, S, D = h.shape
    T = B * S
    xt = h.reshape(T, D)
    xf = xt.astype(jnp.float32)
    p_group = jax.nn.softmax(xf @ w_router_group.astype(jnp.float32), axis=-1)
    g_idx = jnp.argmax(p_group, axis=-1)
    g_w = jnp.take_along_axis(p_group, g_idx[:, None], axis=1)[:, 0]
    local = jnp.einsum('td,gde->tge', xf, w_router_expert.astype(jnp.float32))
    local = jnp.take_along_axis(local, g_idx[:, None, None], axis=1)[:, 0]
    top_logit, top_idx = lax.top_k(local, TOP_K)
    gate = jax.nn.softmax(top_logit, axis=-1) * g_w[:, None]
    flat_e = (g_idx[:, None] * EXPERTS_PER_GROUP + top_idx).reshape(-1).astype(jnp.int32)
    flat_w = gate.reshape(-1)
    A = T * TOP_K
    order = jnp.argsort(flat_e)
    sorted_e = flat_e[order]
    counts = jnp.zeros((N_EXPERTS,), jnp.int32).at[flat_e].add(1)
    starts = jnp.cumsum(counts) - counts
    padded = (counts + MOE_BLOCK - 1) // MOE_BLOCK * MOE_BLOCK
    pad_end = jnp.cumsum(padded)
    pad_start = pad_end - padded
    dest = pad_start[sorted_e] + jnp.arange(A, dtype=jnp.int32) - starts[sorted_e]
    nb = -(-A // MOE_BLOCK) + N_EXPERTS
    P = nb * MOE_BLOCK
    slot_tok = jnp.full((P,), T, jnp.int32).at[dest].set((order // TOP_K).astype(jnp.int32))
    slot_w = jnp.zeros((P,), jnp.float32).at[dest].set(flat_w[order])
    block_e = jnp.minimum(jnp.searchsorted(pad_end, jnp.arange(nb, dtype=jnp.int32) * MOE_BLOCK, side='right'), N_EXPERTS - 1)
    x_pad = jnp.concatenate([xt, jnp.zeros((1, D), xt.dtype)], axis=0)
    xb = x_pad[slot_tok].reshape(nb, MOE_BLOCK, D)

    def run_block(args):
        xblk, e = args
        hid = jax.nn.silu(xblk @ w1[e]) * (xblk @ w3[e])
        return hid @ w2[e]

    yb = lax.map(run_block, (xb, block_e)).reshape(P, D)
    y = jnp.zeros((T + 1, D), jnp.float32).at[slot_tok].add(yb.astype(jnp.float32) * slot_w[:, None])[:T]
    return y.astype(h.dtype).reshape(B, S, D)


def setup_inputs(seed: int = 0) -> dict:
    key = jax.random.key(seed)
    ks = jax.random.split(key, 32)
    f32 = jnp.float32
    nrm = lambda k, shape, s: jax.random.normal(k, shape, f32) * s
    gain = lambda k, n: 1.0 + 0.02 * jax.random.normal(k, (n,), f32)
    return {
        "x": nrm(ks[0], (BATCH, SEQ, D_MODEL), 1.0),
        "mem": nrm(ks[1], (BATCH, MEM_LEN, D_MODEL), 1.0),
        "norm_mix": gain(ks[2], D_MODEL),
        "w_in": nrm(ks[3], (D_MODEL, IN_WIDTH), D_MODEL ** -0.5),
        "q_norm": gain(ks[4], HEAD_DIM),
        "k_norm": gain(ks[5], HEAD_DIM),
        "attn_sinks": nrm(ks[6], (ATTN_Q_HEADS,), 0.5),
        "sgu_norm": gain(ks[7], SGU_WIDTH),
        "sgu_w": nrm(ks[8], (SGU_GROUPS, SGU_CHUNK, SGU_CHUNK), SGU_CHUNK ** -0.5),
        "sgu_b": 1.0 + nrm(ks[9], (SGU_GROUPS, SGU_CHUNK), 0.1),
        "out_norm_attn": gain(ks[10], ATTN_WIDTH),
        "out_norm_sgu": gain(ks[11], SGU_WIDTH),
        "w_out": nrm(ks[12], (D_MODEL, D_MODEL), D_MODEL ** -0.5),
        "norm_cross": gain(ks[13], D_MODEL),
        "norm_mem": gain(ks[14], D_MODEL),
        "w_cq": nrm(ks[15], (D_MODEL, D_MODEL), D_MODEL ** -0.5),
        "w_ck": nrm(ks[16], (D_MODEL, D_MODEL), D_MODEL ** -0.5),
        "w_cv": nrm(ks[17], (D_MODEL, D_MODEL), D_MODEL ** -0.5),
        "cq_norm": gain(ks[18], X_HEAD_DIM),
        "ck_norm": gain(ks[19], X_HEAD_DIM),
        "w_co": nrm(ks[20], (D_MODEL, D_MODEL), D_MODEL ** -0.5),
        "norm_ffn": gain(ks[21], D_MODEL),
        "w_router_group": nrm(ks[22], (D_MODEL, N_GROUPS), D_MODEL ** -0.5),
        "w_router_expert": nrm(ks[23], (N_GROUPS, D_MODEL, EXPERTS_PER_GROUP), D_MODEL ** -0.5),
        "w1": nrm(ks[24], (N_EXPERTS, D_MODEL, D_EXPERT), D_MODEL ** -0.5),
        "w3": nrm(ks[25], (N_EXPERTS, D_MODEL, D_EXPERT), D_MODEL ** -0.5),
        "w2": nrm(ks[26], (N_EXPERTS, D_EXPERT, D_MODEL), D_EXPERT ** -0.5),
    }


def reference(x, mem, norm_mix, w_in, q_norm, k_norm, attn_sinks, sgu_norm, sgu_w, sgu_b,
              out_norm_attn, out_norm_sgu, w_out, norm_cross, norm_mem, w_cq, w_ck, w_cv,
              cq_norm, ck_norm, w_co, norm_ffn, w_router_group, w_router_expert, w1, w3, w2):
    B, S = x.shape[:2]
    mem_n = rms_norm(mem, norm_mem)
    for _ in range(DEPTH):
        h = rms_norm(x, norm_mix)
        proj = h @ w_in
        c0 = ATTN_WIDTH
        c1 = c0 + KV_WIDTH
        c2 = c1 + KV_WIDTH
        c3 = c2 + SGU_WIDTH
        q = rms_norm(proj[..., :c0].reshape(B, S, ATTN_Q_HEADS, HEAD_DIM), q_norm)
        k = rms_norm(proj[..., c0:c1].reshape(B, S, ATTN_KV_HEADS, HEAD_DIM), k_norm)
        v = proj[..., c1:c2].reshape(B, S, ATTN_KV_HEADS, HEAD_DIM)
        u = jax.nn.gelu(proj[..., c2:c3])
        g = jax.nn.gelu(proj[..., c3:])
        attn = sliding_window_attention(q, k, v, attn_sinks)
        sg = spatial_gating(u, g, sgu_norm, sgu_w, sgu_b)
        mixed = jnp.concatenate([rms_norm(attn, out_norm_attn), rms_norm(sg, out_norm_sgu)], axis=-1)
        x = x + mixed @ w_out
        x = x + memory_cross_attention(rms_norm(x, norm_cross), mem_n, w_cq, w_ck, w_cv, cq_norm, ck_norm, w_co)
        x = x + hierarchical_moe(rms_norm(x, norm_ffn), w_router_group, w_router_expert, w1, w3, w2)
    return x
```

```cpp
#include <hip/hip_runtime.h>
#include <hip/hip_bf16.h>
#include <cstdio>
#include <cstdint>

#define GAS __attribute__((address_space(1)))
#define LAS __attribute__((address_space(3)))
typedef unsigned short bf16_t;
typedef short bf16x8 __attribute__((ext_vector_type(8)));
typedef short s16x4 __attribute__((ext_vector_type(4)));
typedef float f32x4 __attribute__((ext_vector_type(4)));
typedef float f32x2 __attribute__((ext_vector_type(2)));
typedef float f32x16 __attribute__((ext_vector_type(16)));
typedef unsigned u32x4 __attribute__((ext_vector_type(4)));
typedef unsigned u32x2 __attribute__((ext_vector_type(2)));
typedef __bf16 bf16x2_t __attribute__((ext_vector_type(2)));
#define DI __device__ __forceinline__

constexpr int T = 32768, D = 1024, BATCH = 8, SEQ = 4096, MEML = 256, NMEM = BATCH * MEML;
constexpr int INW = 1792;
constexpr float EPS = 1e-6f;
constexpr int NWAVES = 8, NTHR = 512;
constexpr int CAP = 32768;
constexpr int MAXRT = 320;

constexpr size_t MiB = 1u << 20;
constexpr size_t WS_CTL = 0, CTL_ZERO_BYTES = 1 * MiB;
constexpr size_t WS_WRT = 1 * MiB;
constexpr size_t WS_SSQ1P = 2 * MiB;
constexpr size_t WS_SSQQ = 4 * MiB;
constexpr size_t WS_LSUM = 6 * MiB;
constexpr size_t WS_SSQK = 8 * MiB;
constexpr size_t WS_RSTDK = 8 * MiB + 512 * 1024;
constexpr size_t WS_LTOK = 10 * MiB, WS_LGATE = 18 * MiB, WS_LRSTD = 26 * MiB;
constexpr size_t WS_WIN = 34 * MiB, WS_WOUT = 38 * MiB, WS_WCQ = 40 * MiB, WS_WCK = 42 * MiB, WS_WCV = 44 * MiB, WS_WCO = 46 * MiB;
constexpr size_t WS_W13 = 48 * MiB, WS_W2 = 112 * MiB;
constexpr size_t WS_MEMB = 144 * MiB, WS_KMEM = 148 * MiB, WS_VMT = 152 * MiB;
constexpr size_t WS_RA = 156 * MiB;
constexpr size_t WS_RB = 220 * MiB;
constexpr size_t WS_RC = 332 * MiB;
constexpr size_t WS_RD = 396 * MiB;
constexpr size_t WS_END = 476 * MiB;
constexpr int CW_BAR = 4096, CW_CNT = 8192;

constexpr int RING_BYTES = 131072;
constexpr int LDSCTL_OFF = RING_BYTES, MISC_OFF = LDSCTL_OFF + 320;
constexpr int TBL_OFF = RING_BYTES + 512;
constexpr int XCH_OFF = RING_BYTES + 2048;
constexpr int SGP_OFF = RING_BYTES + 4096;
constexpr int SGR_OFF = RING_BYTES + 8192;
constexpr int LDS_BYTES = 147456;

#define RLX_AGENT __ATOMIC_RELAXED, __HIP_MEMORY_SCOPE_AGENT
#define LDS_WAIT() asm volatile("s_waitcnt lgkmcnt(0)" ::: "memory")
#define VM_WAIT() asm volatile("s_waitcnt vmcnt(0)" ::: "memory")
DI unsigned f2bf(float f) { unsigned u = __builtin_bit_cast(unsigned, f); return (u + 0x7fffu + ((u >> 16) & 1u)) >> 16; }
DI unsigned pk2(float lo, float hi) { f32x2 v = {lo, hi}; bf16x2_t b = __builtin_convertvector(v, bf16x2_t); return __builtin_bit_cast(unsigned, b); }
DI float bf2f(unsigned short h) { return __builtin_bit_cast(float, (unsigned)h << 16); }
DI float bflo(unsigned w) { return __builtin_bit_cast(float, w << 16); }
DI float bfhi(unsigned w) { return __builtin_bit_cast(float, w & 0xffff0000u); }
DI float wave_sum(float v) {
#pragma unroll
    for (int o = 1; o < 64; o <<= 1) v += __shfl_xor(v, o);
    return v;
}
DI float fast_exp(float x) { return __builtin_amdgcn_exp2f(x * 1.4426950408889634f); }
DI float gelu_tanh(float x) {
    const float z2 = 1.5957691216057308f * (x + 0.044715f * x * x * x);
    return x * __builtin_amdgcn_rcpf(1.0f + fast_exp(-z2));
}
DI float silu(float x) { return x * __builtin_amdgcn_rcpf(1.0f + fast_exp(-x)); }

#define XB_TMO      128
#define XB_XCNT(j)  (256  + 64 * (j))
#define XB_XSUB(j)  (1280 + 64 * (j))
#define XB_XGEN(j)  (2304 + 64 * (j))
#define XB_TOP      3328
#define XB_TOPGEN   3392
#define XCD_BAR_WORDS 3456
#define XB_SPIN_CAP (1u << 18)
DI unsigned xb_ld(unsigned* p)              { return __hip_atomic_load(p, __ATOMIC_RELAXED, __HIP_MEMORY_SCOPE_AGENT); }
DI unsigned xb_add(unsigned* p, unsigned v) { return __hip_atomic_fetch_add(p, v, __ATOMIC_RELAXED, __HIP_MEMORY_SCOPE_AGENT); }
DI unsigned xb_xcc_id() { return (unsigned)__builtin_amdgcn_s_getreg((3 << 11) | 20) & 0xFu; }
#define XB_SPIN(cond, bar) do { unsigned _sp = 0; while (cond) { __builtin_amdgcn_s_sleep(1); \
    if ((++_sp & 255u) == 0u) { if (xb_ld(&(bar)[XB_TMO])) break; if (_sp > XB_SPIN_CAP) { atomicAdd(&(bar)[XB_TMO], 1u); break; } } } } while (0)
struct XcdBarrier { unsigned* bar; unsigned x; volatile LAS unsigned* st; };
DI XcdBarrier xcd_barrier_post(unsigned* bar, volatile LAS unsigned* st) {
    XcdBarrier b; b.bar = bar; b.x = xb_xcc_id(); b.st = st;
    if (threadIdx.x == 0) (void)xb_add(&bar[XB_XCNT(b.x)], 1u);
    return b;
}
DI void xcd_barrier_complete(unsigned* bar, unsigned x, unsigned& nloc, unsigned& nx) {
    const unsigned G = gridDim.x * gridDim.y * gridDim.z;
    unsigned sum, cnt, mine, sp = 0u;
    for (;;) {
        sum = 0u; cnt = 0u; mine = 0u;
#pragma unroll
        for (unsigned j = 0; j < 16; ++j) { const unsigned c = xb_ld(&bar[XB_XCNT(j)]); sum += c; cnt += (c > 0u) ? 1u : 0u; mine = (j == x) ? c : mine; }
        if (sum == G) break;
        __builtin_amdgcn_s_sleep(1);
        if ((++sp & 255u) == 0u) { if (xb_ld(&bar[XB_TMO])) break; if (sp > XB_SPIN_CAP) { atomicAdd(&bar[XB_TMO], 1u); break; } }
    }
    nloc = mine > 0u ? mine : 1u; nx = cnt > 0u ? cnt : 1u;
}
DI void xcd_barrier(const XcdBarrier& b) {
    asm volatile("s_waitcnt vmcnt(0)" ::: "memory");
    __syncthreads();
    if (threadIdx.x == 0) {
        unsigned* bar = b.bar;
        __builtin_amdgcn_s_waitcnt(0);
        unsigned nloc = b.st[0], nx = b.st[1];
        if (nloc == 0u) { xcd_barrier_complete(bar, b.x, nloc, nx); b.st[0] = nloc; b.st[1] = nx; }
        const unsigned old = xb_add(&bar[XB_XSUB(b.x)], 1u);
        const unsigned gen = old / nloc;
        if (old + 1u == (gen + 1u) * nloc) {
            __builtin_amdgcn_fence(__ATOMIC_RELEASE, "agent");
            asm volatile("s_waitcnt vmcnt(0)" ::: "memory");
            const unsigned og = xb_add(&bar[XB_TOP], 1u);
            const unsigned tg = og / nx;
            if (og + 1u == (tg + 1u) * nx) xb_add(&bar[XB_TOPGEN], 1u);
            else XB_SPIN(xb_ld(&bar[XB_TOPGEN]) == tg, bar);
            __builtin_amdgcn_fence(__ATOMIC_ACQUIRE, "agent");
            xb_add(&bar[XB_XGEN(b.x)], 1u);
            asm volatile("s_waitcnt vmcnt(0)" ::: "memory");
        } else {
            XB_SPIN(xb_ld(&bar[XB_XGEN(b.x)]) == gen, bar);
            __builtin_amdgcn_fence(__ATOMIC_ACQUIRE, "agent");
            asm volatile("s_waitcnt vmcnt(0)" ::: "memory");
        }
    }
    __syncthreads();
}

struct Args {
    const float* in[27];
    float* out; unsigned char* ws;
    int ph_lo, ph_hi;
};
struct Frame {
    LAS unsigned char* lds;
    unsigned char* ws; float* out;
    int tid, lane, wave, G, bid;
    const float* const* in;
};
enum { I_X = 0, I_MEM, I_NORM_MIX, I_W_IN, I_Q_NORM, I_K_NORM, I_SINKS, I_SGU_NORM, I_SGU_W, I_SGU_B, I_ON_ATTN, I_ON_SGU, I_W_OUT,
       I_NORM_CROSS, I_NORM_MEM, I_W_CQ, I_W_CK, I_W_CV, I_CQ_NORM, I_CK_NORM, I_W_CO, I_NORM_FFN, I_WRG, I_WRE, I_W1, I_W3, I_W2 };

DI void p0_transpose_item(const float* W, int N, bf16_t* WT, int ldt, int row_off, const float* gain, LAS float* scr, int kb, int nb, int lane) {
    const int k0 = 64 * kb, n0 = 32 * nb;
#pragma unroll 8
    for (int i = 0; i < 32; ++i) { const int kk = 2 * i + (lane >> 5); float v = W[(size_t)(k0 + kk) * N + n0 + (lane & 31)]; if (gain) v *= gain[k0 + kk]; scr[kk * 33 + (lane & 31)] = v; }
    LDS_WAIT(); asm volatile("" ::: "memory");
    const int c = lane & 7;
#pragma unroll
    for (int j = 0; j < 4; ++j) { const int n = (lane >> 3) + 8 * j; const LAS float* s = scr + (8 * c) * 33 + n;
        u32x4 o; o.x = pk2(s[0 * 33], s[1 * 33]); o.y = pk2(s[2 * 33], s[3 * 33]); o.z = pk2(s[4 * 33], s[5 * 33]); o.w = pk2(s[6 * 33], s[7 * 33]);
        *(GAS u32x4*)(WT + (size_t)(row_off + n0 + n) * ldt + k0 + 8 * c) = o; }
    LDS_WAIT(); asm volatile("" ::: "memory");
}
DI void rms_row_to_bf16(const float* xrow, bf16_t* orow, int lane) {
    const GAS f32x4* xr = (const GAS f32x4*)xrow + lane;
    f32x4 v[4]; float s = 0.f;
#pragma unroll
    for (int j = 0; j < 4; ++j) { v[j] = xr[64 * j]; s += (v[j].x * v[j].x + v[j].y * v[j].y) + (v[j].z * v[j].z + v[j].w * v[j].w); }
    const float rstd = 1.0f / sqrtf(wave_sum(s) * (1.f / D) + EPS);
    GAS u32x2* o8 = (GAS u32x2*)orow + lane;
#pragma unroll
    for (int j = 0; j < 4; ++j) { u32x2 w; w.x = pk2(v[j].x * rstd, v[j].y * rstd); w.y = pk2(v[j].z * rstd, v[j].w * rstd); o8[64 * j] = w; }
}
DI void p0_prologue(Frame& F) {
    LAS float* scr = (LAS float*)(F.lds + F.wave * 16384);
    const int gw = F.bid * NWAVES + F.wave, NGW = F.G * NWAVES, lane = F.lane;
    unsigned char* ws = F.ws;
    constexpr int I_IN = 16 * 56, I_SQ = 16 * 32, I_E1 = 32 * 16 * 16, I_E2 = 32 * 8 * 32;
    constexpr int NITEMS = I_IN + 5 * I_SQ + 2 * I_E1 + I_E2;
    for (int it = gw; it < NITEMS; it += NGW) {
        int r = it;
        if (r < I_IN) { p0_transpose_item(F.in[I_W_IN], INW, (bf16_t*)(ws + WS_WIN), D, 0, F.in[I_NORM_MIX], scr, r / 56, r % 56, lane); continue; } r -= I_IN;
        if (r < I_SQ) { const int kb = r / 32; const float* g = (kb < 8) ? F.in[I_ON_ATTN] : (F.in[I_ON_SGU] - 512);
                        p0_transpose_item(F.in[I_W_OUT], D, (bf16_t*)(ws + WS_WOUT), D, 0, g, scr, kb, r % 32, lane); continue; } r -= I_SQ;
        if (r < I_SQ) { p0_transpose_item(F.in[I_W_CQ], D, (bf16_t*)(ws + WS_WCQ), D, 0, F.in[I_NORM_CROSS], scr, r / 32, r % 32, lane); continue; } r -= I_SQ;
        if (r < I_SQ) { p0_transpose_item(F.in[I_W_CK], D, (bf16_t*)(ws + WS_WCK), D, 0, F.in[I_NORM_MEM], scr, r / 32, r % 32, lane); continue; } r -= I_SQ;
        if (r < I_SQ) { p0_transpose_item(F.in[I_W_CV], D, (bf16_t*)(ws + WS_WCV), D, 0, F.in[I_NORM_MEM], scr, r / 32, r % 32, lane); continue; } r -= I_SQ;
        if (r < I_SQ) { p0_transpose_item(F.in[I_W_CO], D, (bf16_t*)(ws + WS_WCO), D, 0, nullptr, scr, r / 32, r % 32, lane); continue; } r -= I_SQ;
        if (r < I_E1) { const int e = r / 256, q = r % 256;
                        p0_transpose_item(F.in[I_W1] + (size_t)e * D * 512, 512, (bf16_t*)(ws + WS_W13) + (size_t)e * 1024 * 1024, D, 0, F.in[I_NORM_FFN], scr, q / 16, q % 16, lane); continue; } r -= I_E1;
        if (r < I_E1) { const int e = r / 256, q = r % 256;
                        p0_transpose_item(F.in[I_W3] + (size_t)e * D * 512, 512, (bf16_t*)(ws + WS_W13) + (size_t)e * 1024 * 1024, D, 512, F.in[I_NORM_FFN], scr, q / 16, q % 16, lane); continue; } r -= I_E1;
        { const int e = r / 256, q = r % 256;
          p0_transpose_item(F.in[I_W2] + (size_t)e * 512 * D, D, (bf16_t*)(ws + WS_W2) + (size_t)e * 1024 * 512, 512, 0, nullptr, scr, q / 32, q % 32, lane); }
    }
    for (int m = gw; m < T + NMEM; m += NGW) {
        if (m < T) rms_row_to_bf16(F.in[I_X] + (size_t)m * D, (bf16_t*)(ws + WS_RA) + (size_t)m * D, lane);
        else rms_row_to_bf16(F.in[I_MEM] + (size_t)(m - T) * D, (bf16_t*)(ws + WS_MEMB) + (size_t)(m - T) * D, lane);
    }
    {
        float* wrt = (float*)(ws + WS_WRT);
        for (int i = F.bid * NTHR + F.tid; i < 36 * D; i += F.G * NTHR) {
            const int e = i >> 10, k = i & 1023;
            float w;
            if (e < 4) w = F.in[I_WRG][k * 4 + e];
            else { const int g = (e - 4) >> 3, ee = (e - 4) & 7; w = F.in[I_WRE][((size_t)g * D + k) * 8 + ee]; }
            wrt[i] = w * F.in[I_NORM_FFN][k];
        }
        if (F.bid == 0 && F.wave == 0) {
            float a = 0.f, b = 0.f;
            for (int i = lane; i < 256; i += 64) { a = fmaxf(a, fabsf(F.in[I_CQ_NORM][i])); b = fmaxf(b, fabsf(F.in[I_CK_NORM][i])); }
#pragma unroll
            for (int o = 1; o < 64; o <<= 1) { a = fmaxf(a, __shfl_xor(a, o)); b = fmaxf(b, __shfl_xor(b, o)); }
            if (lane == 0) *(float*)(ws + WS_WRT + 256 * 1024) = 16.0f * a * b;
        }
    }
}

constexpr int BM = 256, BK = 64, HALF = 128, HTB = HALF * BK * 2;
DI int lds_byte(int r, int c) { const int st = (r >> 4) * 2 + (c >> 5), rr = r & 15, cc = c & 31, ob = rr * 64 + cc * 2; return st * 1024 + (ob ^ (((ob >> 9) & 1) << 5)); }
DI void stage_rc(int b, int& R, int& C) { const int st = b / 1024, sb = b % 1024, swz = sb ^ (((sb >> 9) & 1) << 5); R = (st >> 1) * 16 + swz / 64; C = (st & 1) * 32 + (swz % 64) / 2; }
DI int perm32(int rho) { const int n = rho >> 4, i = rho & 15; return 8 * (i >> 2) + 4 * n + (i & 3); }

enum { K_PROJ = 0, K_MEMK, K_MEMVT, K_WOUT, K_WCQ, K_SC, K_PV, K_WCO, K_UP, K_DOWN };
enum { PH_MEMK = 100, PH_MEMV = 101 };
enum { PH_P0 = 0, PH_PROJ, PH_MIX, PH_WOUT, PH_WCQ, PH_SC, PH_PV, PH_WCO, PH_ROUTE, PH_UP, PH_DOWN0, PH_DOWN1, PH_N };

struct GUnit {
    const char* A; const char* B;
    int kind, pm, pn;
    const int* gl; int gcnt;
    int aux;
};

DI int xcd_remap(int wgid, int nwg) { const int q = nwg / 8, r = nwg % 8, xcd = wgid % 8, off = wgid / 8; return (xcd < r ? xcd * (q + 1) : r * (q + 1) + (xcd - r) * q) + off; }
DI void grouped_tile(int wgid, int nM, int nN, int& pm, int& pn) {
    const int nig = 8 * nN, gid = wgid / nig, fm = gid * 8, gsz = (nM - fm) < 8 ? (nM - fm) : 8;
    pm = fm + ((wgid % nig) % gsz); pn = (wgid % nig) / gsz;
}

struct Sched { int G, c; unsigned char* ws; const LAS int* tbl; int round; };
template <int PH> struct PCfg { static constexpr int K = 1024; static constexpr unsigned lda2 = 2048, ldb2 = 2048, hstepB = 32 * 2048; static constexpr int RS = 64; };
template <> struct PCfg<PH_SC> { static constexpr int K = 256; static constexpr unsigned lda2 = 2048, ldb2 = 2048, hstepB = 32 * 2048; static constexpr int RS = 64; };
template <> struct PCfg<PH_PV> { static constexpr int K = 256; static constexpr unsigned lda2 = 512, ldb2 = 4096, hstepB = 32 * 4096; static constexpr int RS = 64; };
template <> struct PCfg<PH_UP> { static constexpr int K = 1024; static constexpr unsigned lda2 = 2048, ldb2 = 2048, hstepB = 512 * 2048; static constexpr int RS = 32; };
template <> struct PCfg<PH_DOWN0> { static constexpr int K = 512; static constexpr unsigned lda2 = 1024, ldb2 = 1024, hstepB = 32 * 1024; static constexpr int RS = 64; };

template <int PH> DI bool sched_next(const Sched& S, int i, GUnit& u) {
    const int L = i * S.G + S.c; unsigned char* ws = S.ws;
    u.gl = nullptr; u.gcnt = 256; u.aux = 0;
    if constexpr (PH == PH_PROJ) {
        constexpr int NP = 128 * 7;
        if (L >= NP) return false;
        const int w = xcd_remap(L, NP); grouped_tile(w, 128, 7, u.pm, u.pn); u.kind = K_PROJ;
        u.A = (const char*)(ws + WS_RA) + (size_t)u.pm * 256 * 2048; u.B = (const char*)(ws + WS_WIN) + (size_t)u.pn * 256 * 2048;
        return true;
    } else if constexpr (PH == PH_MEMK) {
        const int j = S.c - 128; if (i != 0 || j < 0 || j >= 32) return false;
        u.pm = j >> 2; u.pn = j & 3; u.kind = K_MEMK;
        u.A = (const char*)(ws + WS_MEMB) + (size_t)u.pm * 256 * 2048; u.B = (const char*)(ws + WS_WCK) + (size_t)u.pn * 256 * 2048;
        return true;
    } else if constexpr (PH == PH_MEMV) {
        const int j = S.c - 160; if (i != 0 || j < 0 || j >= 32) return false;
        u.pm = j >> 3; u.pn = j & 7; u.kind = K_MEMVT;
        u.A = (const char*)(ws + WS_WCV) + (size_t)u.pm * 256 * 2048; u.B = (const char*)(ws + WS_MEMB) + (size_t)u.pn * 256 * 2048;
        return true;
    } else if constexpr (PH == PH_WOUT || PH == PH_WCQ || PH == PH_WCO) {
        if (L >= 512) return false;
        const int w = xcd_remap(L, 512); grouped_tile(w, 128, 4, u.pm, u.pn);
        constexpr size_t wa = PH == PH_WOUT ? WS_RC : (PH == PH_WCQ ? WS_RA : WS_RD), wb = PH == PH_WOUT ? WS_WOUT : (PH == PH_WCQ ? WS_WCQ : WS_WCO);
        u.kind = PH == PH_WOUT ? K_WOUT : (PH == PH_WCQ ? K_WCQ : K_WCO);
        u.A = (const char*)(ws + wa) + (size_t)u.pm * 256 * 2048; u.B = (const char*)(ws + wb) + (size_t)u.pn * 256 * 2048;
        return true;
    } else if constexpr (PH == PH_SC || PH == PH_PV) {
        if (L >= 512) return false;
        const int w = xcd_remap(L, 512); const int bh = w >> 4, rt = w & 15, b = bh >> 2, h = bh & 3;
        u.pm = bh; u.pn = rt;
        if constexpr (PH == PH_SC) { u.kind = K_SC;
            u.A = (const char*)(ws + WS_RB) + ((size_t)(b * SEQ + rt * 256) * D + h * 256) * 2;
            u.B = (const char*)(ws + WS_KMEM) + ((size_t)(b * MEML) * D + h * 256) * 2; }
        else { u.kind = K_PV;
            u.A = (const char*)(ws + WS_RC) + ((size_t)bh * SEQ + rt * 256) * 256 * 2;
            u.B = (const char*)(ws + WS_VMT) + ((size_t)(h * 256) * NMEM + b * MEML) * 2; }
        return true;
    } else {
        const LAS int* tbl = S.tbl;
        const int r0 = (PH == PH_UP) ? 0 : 32 * S.round, r1 = (PH == PH_UP) ? 64 : r0 + 32;
        const int t0 = __builtin_amdgcn_readfirstlane(tbl[64 + r0]), t1 = __builtin_amdgcn_readfirstlane(tbl[64 + r1]), nu = (t1 - t0) * 4;
        if (L >= nu) return false;
        const int w = xcd_remap(L, nu); const int rt = t0 + (w >> 2), pn = w & 3;
        const int jl = r0 + 1 + (int)(threadIdx.x & 63);
        const bool hit = (jl < r1) && (tbl[64 + (jl < 64 ? jl : 64)] <= rt);
        const int re = r0 + (int)__popcll(__ballot(hit));
        const int jt = rt - __builtin_amdgcn_readfirstlane(tbl[64 + re]), cnt = __builtin_amdgcn_readfirstlane(tbl[re]), e = re & 31;
        u.pm = rt; u.pn = pn; u.gcnt = (cnt - jt * 256) < 256 ? (cnt - jt * 256) : 256; u.aux = re * CAP + jt * 256;
        if constexpr (PH == PH_UP) { u.kind = K_UP; u.gl = (const int*)(ws + WS_LTOK) + u.aux;
            u.A = (const char*)(ws + WS_RA); u.B = (const char*)(ws + WS_W13) + ((size_t)e * 1024 + pn * 128) * 2048; }
        else { u.kind = K_DOWN;
            u.A = (const char*)(ws + WS_RD) + (size_t)rt * 256 * 1024; u.B = (const char*)(ws + WS_W2) + ((size_t)e * 1024 + pn * 256) * 1024; }
        return true;
    }
}

struct EpiCtx {
    unsigned char* ws; float* out; const float* const* in; float shift;
};

DI void store_bf16x8(bf16_t* p, const f32x4& a, const f32x4& b) { u32x4 w; w.x = pk2(a[0], a[1]); w.y = pk2(a[2], a[3]); w.z = pk2(b[0], b[1]); w.w = pk2(b[2], b[3]); *(GAS u32x4*)p = w; }
DI float sumsq16(const f32x4& a, const f32x4& b, const f32x4& c, const f32x4& d) {
    return ((a[0] * a[0] + a[1] * a[1]) + (a[2] * a[2] + a[3] * a[3])) + ((b[0] * b[0] + b[1] * b[1]) + (b[2] * b[2] + b[3] * b[3])) +
           ((c[0] * c[0] + c[1] * c[1]) + (c[2] * c[2] + c[3] * c[3])) + ((d[0] * d[0] + d[1] * d[1]) + (d[2] * d[2] + d[3] * d[3]));
}
DI float quad_sum(float s) { s += __shfl_xor(s, 16); s += __shfl_xor(s, 32); return s; }

template <int PH> DI void epilogue(const EpiCtx& E, const GUnit& u, f32x4 (&acc)[2][2][4][2], int wr, int wc, int fr_, int fq_) {
    int fr = fr_, fq = fq_; asm volatile("" : "+v"(fr), "+v"(fq));
    unsigned char* ws = E.ws;
    const int rbase = wr * 64 + fr;
    const int cb = 64 * wc + 8 * fq;
    const int kind = (PH == PH_PROJ) ? K_PROJ : (PH == PH_MEMK) ? K_MEMK : (PH == PH_MEMV) ? K_MEMVT : (PH == PH_WOUT ? K_WOUT : PH == PH_WCQ ? K_WCQ : PH == PH_SC ? K_SC : PH == PH_PV ? K_PV : PH == PH_WCO ? K_WCO : PH == PH_UP ? K_UP : K_DOWN);
    switch (kind) {
    case K_PROJ: {
        const int hd = 4 * u.pn + wc;
        bf16_t* PJ = (bf16_t*)(ws + WS_RB) + ((size_t)u.pm * 256 + rbase) * INW + 64 * hd + 8 * fq;
        if (hd < 10) {
            const float* gp = (hd < 8) ? E.in[I_Q_NORM] : E.in[I_K_NORM]; const float sc = (hd < 8) ? 0.125f : 1.0f;
#pragma unroll
            for (int ai = 0; ai < 2; ++ai)
#pragma unroll
                for (int m = 0; m < 4; ++m) {
                    const float ss = quad_sum(sumsq16(acc[ai][0][m][0], acc[ai][0][m][1], acc[ai][1][m][0], acc[ai][1][m][1]));
                    const float rstd = sc / sqrtf(ss * (1.0f / 64.0f) + EPS);
#pragma unroll
                    for (int bj = 0; bj < 2; ++bj) {
                        const f32x4 g0 = *(const f32x4*)(gp + 32 * bj + 8 * fq), g1 = *(const f32x4*)(gp + 32 * bj + 8 * fq + 4);
                        store_bf16x8(PJ + (size_t)(ai * 128 + m * 16) * INW + 32 * bj, acc[ai][bj][m][0] * rstd * g0, acc[ai][bj][m][1] * rstd * g1);
                    }
                    asm volatile("" ::: "memory");
                }
        } else if (hd < 12) {
#pragma unroll
            for (int ai = 0; ai < 2; ++ai)
#pragma unroll
                for (int m = 0; m < 4; ++m) {
#pragma unroll
                    for (int bj = 0; bj < 2; ++bj) store_bf16x8(PJ + (size_t)(ai * 128 + m * 16) * INW + 32 * bj, acc[ai][bj][m][0], acc[ai][bj][m][1]);
                }
        } else {
#pragma unroll
            for (int ai = 0; ai < 2; ++ai)
#pragma unroll
                for (int m = 0; m < 4; ++m) {
#pragma unroll
                    for (int bj = 0; bj < 2; ++bj) {
                        f32x4 v0 = acc[ai][bj][m][0], v1 = acc[ai][bj][m][1];
#pragma unroll
                        for (int e = 0; e < 4; ++e) { v0[e] = gelu_tanh(v0[e]); v1[e] = gelu_tanh(v1[e]); }
                        store_bf16x8(PJ + (size_t)(ai * 128 + m * 16) * INW + 32 * bj, v0, v1);
                    }
                    asm volatile("" ::: "memory");
                }
        }
        break; }
    case K_MEMK: {
        bf16_t* KM = (bf16_t*)(ws + WS_KMEM); float* SK = (float*)(ws + WS_SSQK);
        f32x4 g[2][2];
#pragma unroll
        for (int bj = 0; bj < 2; ++bj)
#pragma unroll
            for (int n = 0; n < 2; ++n) g[bj][n] = *(const f32x4*)(E.in[I_CK_NORM] + cb + 32 * bj + 4 * n);
#pragma unroll
        for (int ai = 0; ai < 2; ++ai)
#pragma unroll
            for (int m = 0; m < 4; ++m) {
                const size_t grow = (size_t)u.pm * 256 + ai * 128 + m * 16 + rbase;
                const float ss = quad_sum(sumsq16(acc[ai][0][m][0], acc[ai][0][m][1], acc[ai][1][m][0], acc[ai][1][m][1]));
                if (fq == 0) SK[(grow * 4 + u.pn) * 4 + wc] = ss;
#pragma unroll
                for (int bj = 0; bj < 2; ++bj) store_bf16x8(KM + grow * D + u.pn * 256 + cb + 32 * bj, acc[ai][bj][m][0] * g[bj][0], acc[ai][bj][m][1] * g[bj][1]);
            }
        break; }
    case K_MEMVT: {
        bf16_t* VT = (bf16_t*)(ws + WS_VMT);
#pragma unroll
        for (int ai = 0; ai < 2; ++ai)
#pragma unroll
            for (int m = 0; m < 4; ++m) {
                const size_t grow = (size_t)u.pm * 256 + ai * 128 + m * 16 + rbase;
#pragma unroll
                for (int bj = 0; bj < 2; ++bj) store_bf16x8(VT + grow * NMEM + u.pn * 256 + cb + 32 * bj, acc[ai][bj][m][0], acc[ai][bj][m][1]);
            }
        break; }
    case K_WOUT: case K_WCO: {
        const bool first = (kind == K_WOUT);
        const float* base = first ? E.in[I_X] : E.out;
        bf16_t* XB = (bf16_t*)(ws + WS_RA); float* SP = (float*)(ws + WS_SSQ1P);
#pragma unroll
        for (int ai = 0; ai < 2; ++ai)
#pragma unroll
            for (int m = 0; m < 4; ++m) {
                const size_t grow = (size_t)u.pm * 256 + ai * 128 + m * 16 + rbase;
                const size_t off = grow * D + u.pn * 256 + cb;
                f32x4 v[2][2];
#pragma unroll
                for (int bj = 0; bj < 2; ++bj)
#pragma unroll
                    for (int n = 0; n < 2; ++n) v[bj][n] = *(const f32x4*)(base + off + 32 * bj + 4 * n) + acc[ai][bj][m][n];
#pragma unroll
                for (int bj = 0; bj < 2; ++bj) {
                    *(f32x4*)(E.out + off + 32 * bj) = v[bj][0]; *(f32x4*)(E.out + off + 32 * bj + 4) = v[bj][1];
                    store_bf16x8(XB + off + 32 * bj, v[bj][0], v[bj][1]);
                }
                if (first) { const float ss = quad_sum(sumsq16(v[0][0], v[0][1], v[1][0], v[1][1])); if (fq == 0) SP[grow * 16 + u.pn * 4 + wc] = ss; }
            }
        break; }
    case K_WCQ: {
        bf16_t* QC = (bf16_t*)(ws + WS_RB); const float* SP = (const float*)(ws + WS_SSQ1P); float* SQ = (float*)(ws + WS_SSQQ);
        f32x4 g[2][2];
#pragma unroll
        for (int bj = 0; bj < 2; ++bj)
#pragma unroll
            for (int n = 0; n < 2; ++n) g[bj][n] = *(const f32x4*)(E.in[I_CQ_NORM] + cb + 32 * bj + 4 * n);
#pragma unroll
        for (int ai = 0; ai < 2; ++ai)
#pragma unroll
            for (int m = 0; m < 4; ++m) {
                const size_t grow = (size_t)u.pm * 256 + ai * 128 + m * 16 + rbase;
                const f32x4 p = *(const f32x4*)(SP + grow * 16 + 4 * fq);
                const float tot = quad_sum((p[0] + p[1]) + (p[2] + p[3]));
                const float rstd1 = 1.0f / sqrtf(tot * (1.0f / D) + EPS);
                f32x4 v[2][2];
#pragma unroll
                for (int bj = 0; bj < 2; ++bj)
#pragma unroll
                    for (int n = 0; n < 2; ++n) v[bj][n] = acc[ai][bj][m][n] * rstd1;
                const float ss = quad_sum(sumsq16(v[0][0], v[0][1], v[1][0], v[1][1]));
                if (fq == 0) SQ[(grow * 4 + u.pn) * 4 + wc] = ss;
#pragma unroll
                for (int bj = 0; bj < 2; ++bj) store_bf16x8(QC + grow * D + u.pn * 256 + cb + 32 * bj, v[bj][0] * g[bj][0], v[bj][1] * g[bj][1]);
            }
        break; }
    case K_SC: {
        const int bh = u.pm, rt = u.pn, b = bh >> 2, h = bh & 3;
        bf16_t* PC = (bf16_t*)(ws + WS_RC); const float* SQ = (const float*)(ws + WS_SSQQ); float* LS = (float*)(ws + WS_LSUM);
        const float* RK = (const float*)(ws + WS_RSTDK) + (size_t)bh * 256;
        f32x4 rk[2][2];
#pragma unroll
        for (int bj = 0; bj < 2; ++bj)
#pragma unroll
            for (int n = 0; n < 2; ++n) rk[bj][n] = *(const f32x4*)(RK + cb + 32 * bj + 4 * n) * (0.0625f * 1.4426950408889634f);
        const float sh2 = E.shift * 1.4426950408889634f;
#pragma unroll
        for (int ai = 0; ai < 2; ++ai)
#pragma unroll
            for (int m = 0; m < 4; ++m) {
                const int lrow = rt * 256 + ai * 128 + m * 16 + rbase;
                const size_t grow = (size_t)b * SEQ + lrow;
                const f32x4 p = *(const f32x4*)(SQ + (grow * 4 + h) * 4);
                const float rq = 1.0f / sqrtf(((p[0] + p[1]) + (p[2] + p[3])) * (1.0f / 256.0f) + EPS);
                f32x4 v[2][2]; float ls = 0.f;
#pragma unroll
                for (int bj = 0; bj < 2; ++bj)
#pragma unroll
                    for (int n = 0; n < 2; ++n) {
#pragma unroll
                        for (int e = 0; e < 4; ++e) { const float pe = __builtin_amdgcn_exp2f(acc[ai][bj][m][n][e] * rq * rk[bj][n][e] - sh2); v[bj][n][e] = pe; ls += pe; }
                    }
                ls = quad_sum(ls);
                if (fq == 0) LS[(grow * 4 + h) * 4 + wc] = ls;
#pragma unroll
                for (int bj = 0; bj < 2; ++bj) store_bf16x8(PC + ((size_t)bh * SEQ + lrow) * 256 + cb + 32 * bj, v[bj][0], v[bj][1]);
            }
        break; }
    case K_PV: {
        const int bh = u.pm, rt = u.pn, b = bh >> 2, h = bh & 3;
        bf16_t* OC = (bf16_t*)(ws + WS_RD); const float* LS = (const float*)(ws + WS_LSUM);
#pragma unroll
        for (int ai = 0; ai < 2; ++ai)
#pragma unroll
            for (int m = 0; m < 4; ++m) {
                const size_t grow = (size_t)b * SEQ + rt * 256 + ai * 128 + m * 16 + rbase;
                const f32x4 p = *(const f32x4*)(LS + (grow * 4 + h) * 4);
                const float inv = 1.0f / ((p[0] + p[1]) + (p[2] + p[3]));
#pragma unroll
                for (int bj = 0; bj < 2; ++bj) store_bf16x8(OC + grow * D + h * 256 + cb + 32 * bj, acc[ai][bj][m][0] * inv, acc[ai][bj][m][1] * inv);
            }
        break; }
    case K_UP: {
        bf16_t* HID = (bf16_t*)(ws + WS_RD); const float* LR = (const float*)(ws + WS_LRSTD) + u.aux;
#pragma unroll
        for (int ai = 0; ai < 2; ++ai)
#pragma unroll
            for (int m = 0; m < 4; ++m) {
                const int lrow = ai * 128 + m * 16 + rbase;
                const float rs = (lrow < u.gcnt) ? LR[lrow] : 0.f;
                f32x4 hv[2];
#pragma unroll
                for (int n = 0; n < 2; ++n)
#pragma unroll
                    for (int e = 0; e < 4; ++e) hv[n][e] = silu(acc[ai][0][m][n][e] * rs) * (acc[ai][1][m][n][e] * rs);
                store_bf16x8(HID + ((size_t)u.pm * 256 + lrow) * 512 + u.pn * 128 + 32 * wc + 8 * fq, hv[0], hv[1]);
                asm volatile("" ::: "memory");
            }
        break; }
    case K_DOWN: {
        const int* LT = (const int*)(ws + WS_LTOK) + u.aux; const float* LG = (const float*)(ws + WS_LGATE) + u.aux;
#pragma unroll
        for (int ai = 0; ai < 2; ++ai)
#pragma unroll
            for (int m = 0; m < 4; ++m) {
                const int lrow = ai * 128 + m * 16 + rbase;
                if (lrow < u.gcnt) {
                    const int tok = LT[lrow]; const float gt = LG[lrow];
                    float* o = E.out + (size_t)tok * D + u.pn * 256 + cb;
#pragma unroll
                    for (int bj = 0; bj < 2; ++bj)
#pragma unroll
                        for (int n = 0; n < 2; ++n) { f32x4* p = (f32x4*)(o + 32 * bj + 4 * n); *p = *p + acc[ai][bj][m][n] * gt; }
                }
            }
        break; }
    }
}

template <int PH> DI void gemm_phase(LAS unsigned char* lds, const Sched& S, const EpiCtx& E) {
    typedef PCfg<(PH == PH_DOWN1 ? PH_DOWN0 : PH)> g;
    constexpr bool GATHER = (PH == PH_UP);
    const int tid = threadIdx.x, wid = __builtin_amdgcn_readfirstlane(tid >> 6), lane = tid & 63, wr = wid >> 2, wc = wid & 3, fr = lane & 15, fq = lane >> 4;
    constexpr int nt = g::K / BK;
    int R0, C0; stage_rc(tid * 16, R0, C0);
    unsigned vB[2], vA0[2];
#pragma unroll
    for (int i = 0; i < 2; ++i) { const int R = R0 + 64 * i; vB[i] = (unsigned)(g::RS * (R >> 5) + perm32(R & 31)) * g::ldb2 + (unsigned)C0 * 2u; vA0[i] = (unsigned)R * g::lda2 + (unsigned)C0 * 2u; }
    const unsigned ldsw = (unsigned)wid * 1024u;
    const int aoff = lds_byte(wr * 64 + fr, fq * 8), boff = lds_byte(wc * 32 + fr, fq * 8);
    constexpr size_t hA = (size_t)HALF * g::lda2;
#define SA(b, h) (((b) * 2 + (h)) * HTB)
#define SB(b, h) ((4 + (b) * 2 + (h)) * HTB)
#define GLDS(gp, loff) __builtin_amdgcn_global_load_lds((const unsigned*)(gp), (LAS unsigned*)(lds + (loff)), 16, 0, 0)
#define STG_A(bufoff, base, h, useN) do { if constexpr (GATHER) { \
        GLDS((base) + ((useN) ? vAn[h][0] : vAc[h][0]), (bufoff) + ldsw); GLDS((base) + ((useN) ? vAn[h][1] : vAc[h][1]), (bufoff) + ldsw + 8192); } else { \
        GLDS((base) + (h) * hA + vA0[0], (bufoff) + ldsw); GLDS((base) + (h) * hA + vA0[1], (bufoff) + ldsw + 8192); } } while (0)
#define STG_B(bufoff, base) do { GLDS((base) + vB[0], (bufoff) + ldsw); GLDS((base) + vB[1], (bufoff) + ldsw + 8192); } while (0)
#define LDA(dst, b, h) do { _Pragma("unroll") for (int m = 0; m < 4; ++m) _Pragma("unroll") for (int k = 0; k < 2; ++k) dst[m][k] = *(const LAS bf16x8*)(lds + SA(b, h) + aoff + m * 2048 + k * 1024); } while (0)
#define LDB(dst, b, h) do { _Pragma("unroll") for (int n = 0; n < 2; ++n) _Pragma("unroll") for (int k = 0; k < 2; ++k) dst[n][k] = *(const LAS bf16x8*)(lds + SB(b, h) + boff + n * 2048 + k * 1024); } while (0)
#define MMA(ai, bj, At, Bt) do { __builtin_amdgcn_s_setprio(1); _Pragma("unroll") for (int m = 0; m < 4; ++m) _Pragma("unroll") for (int n = 0; n < 2; ++n) _Pragma("unroll") for (int k = 0; k < 2; ++k) \
        acc[ai][bj][m][n] = __builtin_amdgcn_mfma_f32_16x16x32_bf16(Bt[n][k], At[m][k], acc[ai][bj][m][n], 0, 0, 0); __builtin_amdgcn_s_setprio(0); } while (0)
#define WAIT_V(n) asm volatile("s_waitcnt vmcnt(" #n ")" ::: "memory")
#define WAIT_L(n) asm volatile("s_waitcnt lgkmcnt(" #n ")" ::: "memory")
#define BAR __builtin_amdgcn_s_barrier()
#define SCHED __builtin_amdgcn_sched_barrier(0)
#define SET_VA(vv, U) do { _Pragma("unroll") for (int h = 0; h < 2; ++h) _Pragma("unroll") for (int i = 0; i < 2; ++i) { const int r_ = 128 * h + R0 + 64 * i; \
        const int idx_ = (r_ < (U).gcnt) ? (U).gl[r_] : 0; (vv)[h][i] = (unsigned)idx_ * g::lda2 + (unsigned)C0 * 2u; } } while (0)
    GUnit cur, nxt; int ui = 0;
    if (!sched_next<PH>(S, 0, cur)) return;
    f32x4 acc[2][2][4][2];
#pragma unroll
    for (int a = 0; a < 2; ++a)
#pragma unroll
        for (int b = 0; b < 2; ++b)
#pragma unroll
            for (int m = 0; m < 4; ++m)
#pragma unroll
                for (int n = 0; n < 2; ++n) acc[a][b][m][n] = (f32x4){0.f, 0.f, 0.f, 0.f};
    bf16x8 At[4][2], B0[2][2], B1[2][2];
    unsigned vAc[2][2], vAn[2][2];
    if constexpr (GATHER) { SET_VA(vAc, cur); }
    const char* cA = cur.A; const char* cB = cur.B;
    constexpr size_t kstep = BK * 2; constexpr size_t hB = g::hstepB;
    STG_B(SB(0, 0), cB); STG_B(SB(0, 1), cB + hB); STG_A(SA(0, 0), cA, 0, false); STG_A(SA(0, 1), cA, 1, false);
    if (wr == 1) BAR;
    WAIT_V(2); BAR;
    STG_B(SB(1, 0), cB + kstep); STG_A(SA(1, 0), cA + kstep, 0, false); STG_B(SB(1, 1), cB + hB + kstep);
    WAIT_V(6); BAR;
    for (;;) {
        const bool has_next = sched_next<PH>(S, ui + 1, nxt);
        const char* nA = has_next ? nxt.A : cA; const char* nB = has_next ? nxt.B : cB;
        for (int t = 0; t < nt; t += 2) {
            const bool last = (t == nt - 2);
            if constexpr (GATHER) { if (last) { if (has_next) { SET_VA(vAn, nxt); } else {
#pragma unroll
                for (int h = 0; h < 2; ++h)
#pragma unroll
                    for (int i = 0; i < 2; ++i) vAn[h][i] = vAc[h][i]; } } }
            const char* a1 = cA + (size_t)(t + 1) * kstep;
            const char* a2 = last ? nA : cA + (size_t)(t + 2) * kstep; const char* b2 = last ? nB : cB + (size_t)(t + 2) * kstep;
            const char* a3 = a2 + kstep; const char* b3 = b2 + kstep;
            LDB(B0, 0, 0); LDB(B1, 0, 1); SCHED; LDA(At, 0, 0); STG_A(SA(1, 1), a1, 1, false);
            WAIT_V(8); WAIT_L(0); BAR; MMA(0, 0, At, B0); MMA(0, 1, At, B1); BAR; SCHED;
            LDA(At, 0, 1); STG_B(SB(0, 0), b2); STG_B(SB(0, 1), b2 + hB); STG_A(SA(0, 0), a2, 0, last);
            WAIT_V(8); WAIT_L(0); BAR; MMA(1, 0, At, B0); MMA(1, 1, At, B1); BAR; SCHED;
            LDB(B0, 1, 0); LDB(B1, 1, 1); SCHED; LDA(At, 1, 0); STG_A(SA(0, 1), a2, 1, last);
            WAIT_V(8); WAIT_L(0); BAR; MMA(0, 0, At, B0); MMA(0, 1, At, B1); BAR; SCHED;
            LDA(At, 1, 1); STG_B(SB(1, 0), b3); STG_B(SB(1, 1), b3 + hB); STG_A(SA(1, 0), a3, 0, last);
            WAIT_V(8); WAIT_L(0); BAR; MMA(1, 0, At, B0); MMA(1, 1, At, B1); BAR; SCHED;
        }
        if (wr == 0) BAR;
        epilogue<PH>(E, cur, acc, wr, wc, fr, fq);
        if (!has_next) break;
#pragma unroll
        for (int a = 0; a < 2; ++a)
#pragma unroll
            for (int b = 0; b < 2; ++b)
#pragma unroll
                for (int m = 0; m < 4; ++m)
#pragma unroll
                    for (int n = 0; n < 2; ++n) acc[a][b][m][n] = (f32x4){0.f, 0.f, 0.f, 0.f};
        cur = nxt; cA = nA; cB = nB; ++ui;
        if constexpr (GATHER) {
#pragma unroll
            for (int h = 0; h < 2; ++h)
#pragma unroll
                for (int i = 0; i < 2; ++i) vAc[h][i] = vAn[h][i]; }
        if (wr == 1) BAR;
    }
    WAIT_V(0);
    BAR;
#undef SA
#undef SB
#undef GLDS
#undef STG_A
#undef STG_B
#undef LDA
#undef LDB
#undef MMA
#undef WAIT_V
#undef WAIT_L
#undef BAR
#undef SCHED
#undef SET_VA
}

DI int crow(int r, int hi) { return (r & 3) + 8 * (r >> 2) + 4 * hi; }
typedef short v4i16_t __attribute__((ext_vector_type(4)));
DI s16x4 vtr(const LAS unsigned char* p) { return __builtin_bit_cast(s16x4, __builtin_amdgcn_ds_read_tr16_b64_v4i16((LAS v4i16_t*)p)); }
#define MFMA32(a, b, c) __builtin_amdgcn_mfma_f32_32x32x16_bf16((a), (b), (c), 0, 0, 0)
DI bf16x8 cat8(s16x4 lo, s16x4 hi) { return __builtin_shufflevector(lo, hi, 0, 1, 2, 3, 4, 5, 6, 7); }
DI bf16x8 pack8(float a0, float a1, float a2, float a3, float a4, float a5, float a6, float a7) {
    u32x4 w; w.x = pk2(a0, a1); w.y = pk2(a2, a3); w.z = pk2(a4, a5); w.w = pk2(a6, a7); return __builtin_bit_cast(bf16x8, w);
}
DI void norm_store_512(Frame& F, f32x16 (&o)[2], int par, int ql, int hh, bf16_t* dst  ) {
    LAS float* xch = (LAS float*)(F.lds + XCH_OFF) + par * 256;
    float ss = 0.f;
#pragma unroll
    for (int d = 0; d < 2; ++d)
#pragma unroll
        for (int r = 0; r < 16; ++r) ss += o[d][r] * o[d][r];
    ss += __shfl_xor(ss, 32);
    if (hh == 0) xch[F.wave * 32 + ql] = ss;
    __syncthreads();
    float tot = 0.f;
#pragma unroll
    for (int w = 0; w < 8; ++w) tot += xch[w * 32 + ql];
    const float rstd = 1.0f / sqrtf(tot * (1.0f / 512.0f) + EPS);
#pragma unroll
    for (int d = 0; d < 2; ++d)
#pragma unroll
        for (int g = 0; g < 4; ++g) {
            u32x2 w; w.x = pk2(o[d][4 * g] * rstd, o[d][4 * g + 1] * rstd); w.y = pk2(o[d][4 * g + 2] * rstd, o[d][4 * g + 3] * rstd);
            *(GAS u32x2*)(dst + 32 * d + 8 * g + 4 * hh) = w;
        }
}

DI void attn_unit(Frame& F, int b, int n) {
    const int tid = F.tid, lane = F.lane, ql = lane & 31, hh = lane >> 5;
    const int t0 = b * SEQ + n * 128;
    const bf16_t* PJ = (const bf16_t*)(F.ws + WS_RB);
    bf16_t* MX = (bf16_t*)(F.ws + WS_RC);
    LAS unsigned char* lds = F.lds;
    __syncthreads();
#pragma unroll 4
    for (int j = 0; j < 16; ++j) {
        const int p = tid + NTHR * j, row = p >> 5, c = p & 31;
        int tok = t0 - 128 + row; if (n == 0 && row < 128) tok = t0;
        const u32x4 v = *(const GAS u32x4*)(PJ + (size_t)tok * INW + 512 + 8 * c);
        int addr;
        if (c < 16) { const int kvh = c >> 3, ch = c & 7; addr = kvh * 32768 + row * 128 + ((ch ^ ((row >> 1) & 7)) << 4); }
        else { const int cc = c - 16, kvh = cc >> 3, ch = cc & 7; addr = 65536 + kvh * 32768 + (ch >> 2) * 16384 + row * 64 + (ch & 3) * 16; }
        *(LAS u32x4*)(lds + addr) = v;
    }
    __syncthreads();
    const int h = F.wave, kvh = h >> 2;
    const float sinkv = F.in[I_SINKS][h];
    const LAS unsigned char* Kb = lds + kvh * 32768;
    const LAS unsigned char* Vb = lds + 65536 + kvh * 32768;
    const int vtr_off = ((lane & 15) >> 2) * 64 + (16 * ((lane >> 4) & 1) + 4 * (lane & 3)) * 2;
    constexpr float L2E = 1.4426950408889634f;
    for (int i = 0; i < 4; ++i) {
        const bf16_t* qrow = PJ + (size_t)(t0 + 32 * i + ql) * INW + h * 64 + 8 * hh;
        bf16x8 qf[4];
#pragma unroll
        for (int ks = 0; ks < 4; ++ks) qf[ks] = *(const GAS bf16x8*)(qrow + 16 * ks);
        f32x16 s[5];
#pragma unroll
        for (int jt = 0; jt < 5; ++jt) {
            const int key = 32 * (i + jt) + ql;
            f32x16 a = {};
#pragma unroll
            for (int ks = 0; ks < 4; ++ks) {
                const bf16x8 kf = *(const LAS bf16x8*)(Kb + key * 128 + (((2 * ks + hh) ^ ((key >> 1) & 7)) << 4));
                a = MFMA32(kf, qf[ks], a);
            }
            s[jt] = a;
        }
        float m = sinkv;
#pragma unroll
        for (int jt = 0; jt < 5; ++jt) {
            const bool tile_ok = (n != 0) || (i + jt >= 4);
#pragma unroll
            for (int r = 0; r < 16; ++r) {
                const int c = crow(r, hh);
                bool ok = tile_ok;
                if (jt == 0) ok = ok && (c > ql);
                if (jt == 4) ok = ok && (c <= ql);
                const float v = ok ? s[jt][r] : -INFINITY;
                s[jt][r] = v; m = fmaxf(m, v);
            }
        }
        m = fmaxf(m, __shfl_xor(m, 32));
        float l = 0.f;
#pragma unroll
        for (int jt = 0; jt < 5; ++jt)
#pragma unroll
            for (int r = 0; r < 16; ++r) { const float p = __builtin_amdgcn_exp2f((s[jt][r] - m) * L2E); s[jt][r] = p; l += p; }
        l += __shfl_xor(l, 32);
        l += __builtin_amdgcn_exp2f((sinkv - m) * L2E);
        f32x16 o[2]; o[0] = f32x16{}; o[1] = f32x16{};
#pragma unroll
        for (int jt = 0; jt < 5; ++jt)
#pragma unroll
            for (int s2 = 0; s2 < 2; ++s2) {
                const bf16x8 pf = pack8(s[jt][8 * s2], s[jt][8 * s2 + 1], s[jt][8 * s2 + 2], s[jt][8 * s2 + 3], s[jt][8 * s2 + 4], s[jt][8 * s2 + 5], s[jt][8 * s2 + 6], s[jt][8 * s2 + 7]);
                const int k0 = 32 * (i + jt) + 16 * s2 + 4 * hh;
#pragma unroll
                for (int d = 0; d < 2; ++d) {
                    const LAS unsigned char* vp = Vb + d * 16384 + k0 * 64 + vtr_off;
                    const s16x4 lo = vtr(vp), hi = vtr(vp + 8 * 64);
                    o[d] = MFMA32(cat8(lo, hi), pf, o[d]);
                }
            }
        const float inv = 1.0f / l;
#pragma unroll
        for (int d = 0; d < 2; ++d)
#pragma unroll
            for (int r = 0; r < 16; ++r) o[d][r] *= inv;
        norm_store_512(F, o, i & 1, ql, hh, MX + (size_t)(t0 + 32 * i + ql) * D + h * 64);
    }
}

DI void sgu_unit(Frame& F, int b, int n) {
    const int tid = F.tid, lane = F.lane, ql = lane & 31, hh = lane >> 5, gi = F.wave;
    const int t0 = b * SEQ + n * 128;
    const bf16_t* PJ = (const bf16_t*)(F.ws + WS_RB);
    bf16_t* MX = (bf16_t*)(F.ws + WS_RC);
    LAS unsigned char* lds = F.lds;
    LAS float* sgp = (LAS float*)(lds + SGP_OFF);
    LAS float* sgr = (LAS float*)(lds + SGR_OFF);
    __syncthreads();
    u32x4 gv[16];
    const int ch = lane & 7;
#pragma unroll
    for (int L = 0; L < 16; ++L) {
        const int tok = 8 * L + (lane >> 3);
        gv[L] = *(const GAS u32x4*)(PJ + (size_t)(t0 + tok) * INW + 1280 + 64 * gi + 8 * ch);
    }
#pragma unroll
    for (int L = 0; L < 16; ++L) {
        const int tok = 8 * L + (lane >> 3);
        float ss = 0.f;
#pragma unroll
        for (int e = 0; e < 4; ++e) { const float a = bflo(gv[L][e]), c = bfhi(gv[L][e]); ss += a * a + c * c; }
        ss += __shfl_xor(ss, 1); ss += __shfl_xor(ss, 2); ss += __shfl_xor(ss, 4);
        if (ch == 0) sgp[gi * 128 + tok] = ss;
    }
    __syncthreads();
    if (tid < 128) { float tot = 0.f;
#pragma unroll
        for (int g = 0; g < 8; ++g) tot += sgp[g * 128 + tid];
        sgr[tid] = 1.0f / sqrtf(tot * (1.0f / 512.0f) + EPS); }
    __syncthreads();
    float gn[8];
    { const f32x4 a = *(const f32x4*)(F.in[I_SGU_NORM] + 64 * gi + 8 * ch), c = *(const f32x4*)(F.in[I_SGU_NORM] + 64 * gi + 8 * ch + 4);
      gn[0] = a[0]; gn[1] = a[1]; gn[2] = a[2]; gn[3] = a[3]; gn[4] = c[0]; gn[5] = c[1]; gn[6] = c[2]; gn[7] = c[3]; }
    LAS unsigned char* vcb = lds + gi * 16384;
#pragma unroll
    for (int L = 0; L < 16; ++L) {
        const int tok = 8 * L + (lane >> 3);
        const float r = sgr[tok];
        u32x4 w;
#pragma unroll
        for (int e = 0; e < 4; ++e) w[e] = pk2(bflo(gv[L][e]) * r * gn[2 * e], bfhi(gv[L][e]) * r * gn[2 * e + 1]);
        *(LAS u32x4*)(vcb + (ch >> 2) * 8192 + tok * 64 + (ch & 3) * 16) = w;
    }
    LDS_WAIT();
    __syncthreads();
    const float* Wg = F.in[I_SGU_W] + (size_t)gi * 128 * 128;
    const float* bias = F.in[I_SGU_B] + gi * 128;
    const int vtr_off = ((lane & 15) >> 2) * 64 + (16 * ((lane >> 4) & 1) + 4 * (lane & 3)) * 2;
    for (int ib = 0; ib < 4; ++ib) {
        const int it = 32 * ib + ql;
        f32x16 a[2]; a[0] = f32x16{}; a[1] = f32x16{};
        const int njs = 2 * (ib + 1);
        for (int js = 0; js < njs; ++js) {
            const int jb = 16 * js + 8 * hh;
            const f32x4 w0 = *(const f32x4*)(Wg + (size_t)it * 128 + jb), w1 = *(const f32x4*)(Wg + (size_t)it * 128 + jb + 4);
            float wv[8] = {w0[0], w0[1], w0[2], w0[3], w1[0], w1[1], w1[2], w1[3]};
#pragma unroll
            for (int e = 0; e < 8; ++e) wv[e] = (jb + e <= it) ? wv[e] : 0.f;
            const bf16x8 bfr = pack8(wv[0], wv[1], wv[2], wv[3], wv[4], wv[5], wv[6], wv[7]);
#pragma unroll
            for (int d = 0; d < 2; ++d) {
                const LAS unsigned char* vp = vcb + d * 8192 + (16 * js + 8 * hh) * 64 + vtr_off;
                const s16x4 lo = vtr(vp), hi = vtr(vp + 4 * 64);
                a[d] = MFMA32(cat8(lo, hi), bfr, a[d]);
            }
        }
        const float bi = bias[it];
        const bf16_t* urow = PJ + (size_t)(t0 + it) * INW + 768 + 64 * gi;
#pragma unroll
        for (int d = 0; d < 2; ++d)
#pragma unroll
            for (int g = 0; g < 4; ++g) {
                const u32x2 uw = *(const GAS u32x2*)(urow + 32 * d + 8 * g + 4 * hh);
                a[d][4 * g] = bflo(uw.x) * (a[d][4 * g] + bi); a[d][4 * g + 1] = bfhi(uw.x) * (a[d][4 * g + 1] + bi);
                a[d][4 * g + 2] = bflo(uw.y) * (a[d][4 * g + 2] + bi); a[d][4 * g + 3] = bfhi(uw.y) * (a[d][4 * g + 3] + bi);
            }
        norm_store_512(F, a, ib & 1, ql, hh, MX + (size_t)(t0 + it) * D + 512 + 64 * gi);
    }
}

DI void mix_phase(Frame& F) {
    { const int i = F.bid * NTHR + F.tid;
      if (i < 8 * 4 * 256) { const int bh = i >> 8, key = i & 255, b = bh >> 2, h = bh & 3;
          const f32x4 p = *(const f32x4*)((const float*)(F.ws + WS_SSQK) + ((size_t)(b * 256 + key) * 4 + h) * 4);
          ((float*)(F.ws + WS_RSTDK))[i] = 1.0f / sqrtf(((p[0] + p[1]) + (p[2] + p[3])) * (1.0f / 256.0f) + EPS); } }
    for (int uidx = F.bid; uidx < 512; uidx += F.G) {
        const int c = uidx >> 1, b = c >> 5, n = c & 31;
        if (uidx & 1) sgu_unit(F, b, n); else attn_unit(F, b, n);
    }
}

DI void route_phase(Frame& F) {
    const int gw = F.bid * NWAVES + F.wave, NGW = F.G * NWAVES, lane = F.lane;
    const float* wrt = (const float*)(F.ws + WS_WRT);
    unsigned* cnt = (unsigned*)(F.ws + WS_CTL) + CW_CNT;
    int* LT = (int*)(F.ws + WS_LTOK); float* LG = (float*)(F.ws + WS_LGATE); float* LR = (float*)(F.ws + WS_LRSTD);
    for (int tok = gw; tok < T; tok += NGW) {
        const GAS f32x4* xr = (const GAS f32x4*)(F.out + (size_t)tok * D) + lane;
        f32x4 v[4]; float ss = 0.f;
#pragma unroll
        for (int j = 0; j < 4; ++j) { v[j] = xr[64 * j]; ss += (v[j].x * v[j].x + v[j].y * v[j].y) + (v[j].z * v[j].z + v[j].w * v[j].w); }
        const float rstd = 1.0f / sqrtf(wave_sum(ss) * (1.0f / D) + EPS);
        float lg[36];
#pragma unroll
        for (int e = 0; e < 36; ++e) {
            const GAS f32x4* wr = (const GAS f32x4*)(wrt + e * D) + lane;
            float p = 0.f;
#pragma unroll
            for (int j = 0; j < 4; ++j) { const f32x4 w = wr[64 * j]; p += (v[j].x * w.x + v[j].y * w.y) + (v[j].z * w.z + v[j].w * w.w); }
            lg[e] = wave_sum(p) * rstd;
        }
        float gmax = lg[0]; int gi = 0;
#pragma unroll
        for (int j = 1; j < 4; ++j) if (lg[j] > gmax) { gmax = lg[j]; gi = j; }
        float den = 0.f;
#pragma unroll
        for (int j = 0; j < 4; ++j) den += __expf(lg[j] - gmax);
        const float gwt = 1.0f / den;
        float le[8];
#pragma unroll
        for (int e = 0; e < 8; ++e) le[e] = gi == 0 ? lg[4 + e] : (gi == 1 ? lg[12 + e] : (gi == 2 ? lg[20 + e] : lg[28 + e]));
        float t1 = le[0]; int i1 = 0;
#pragma unroll
        for (int e = 1; e < 8; ++e) if (le[e] > t1) { t1 = le[e]; i1 = e; }
        float t2 = -INFINITY; int i2 = 0;
#pragma unroll
        for (int e = 0; e < 8; ++e) if (e != i1 && le[e] > t2) { t2 = le[e]; i2 = e; }
        const float ex = __expf(t2 - t1), p1 = 1.0f / (1.0f + ex), p2 = ex * p1;
        if (lane == 0) {
            const int re1 = gi * 8 + i1, re2 = 32 + gi * 8 + i2;
            const unsigned s1 = __hip_atomic_fetch_add(cnt + 64 * re1, 1u, RLX_AGENT);
            const unsigned s2 = __hip_atomic_fetch_add(cnt + 64 * re2, 1u, RLX_AGENT);
            LT[(size_t)re1 * CAP + s1] = tok; LG[(size_t)re1 * CAP + s1] = p1 * gwt; LR[(size_t)re1 * CAP + s1] = rstd;
            LT[(size_t)re2 * CAP + s2] = tok; LG[(size_t)re2 * CAP + s2] = p2 * gwt; LR[(size_t)re2 * CAP + s2] = rstd;
        }
    }
}
DI void build_tile_table(Frame& F) {
    LAS int* tbl = (LAS int*)(F.lds + TBL_OFF);
    unsigned* cnt = (unsigned*)(F.ws + WS_CTL) + CW_CNT;
    __syncthreads();
    if (F.tid < 64) tbl[F.tid] = (int)__hip_atomic_load(cnt + 64 * F.tid, RLX_AGENT);
    __syncthreads();
    if (F.tid == 0) { int a = 0; for (int j = 0; j < 64; ++j) { tbl[64 + j] = a; a += (tbl[j] + 255) >> 8; } tbl[128] = a; }
    __syncthreads();
}

__global__ void __launch_bounds__(NTHR, 2) fwd_kernel(Args args) {
    extern __shared__ __attribute__((aligned(16))) unsigned char lds_raw[];
    Frame F;
    F.lds = (LAS unsigned char*)lds_raw;
    F.ws = args.ws; F.out = args.out; F.in = args.in;
    F.tid = threadIdx.x; F.lane = F.tid & 63; F.wave = __builtin_amdgcn_readfirstlane(F.tid >> 6);
    F.G = gridDim.x; F.bid = blockIdx.x;
    for (int u = F.tid; u < (LDS_BYTES - LDSCTL_OFF) / 4; u += NTHR) ((LAS unsigned*)(F.lds + LDSCTL_OFF))[u] = 0u;
    __syncthreads();
    unsigned* ctl = (unsigned*)(args.ws + WS_CTL);
    const int lo = args.ph_lo, hi = args.ph_hi;
    XcdBarrier bar; bar.bar = ctl + CW_BAR; bar.x = 0; bar.st = nullptr;
    if (hi - lo > 1) bar = xcd_barrier_post(ctl + CW_BAR, (volatile LAS unsigned*)(F.lds + MISC_OFF) + 8);
    Sched S; S.G = F.G; S.c = F.bid; S.ws = F.ws; S.tbl = (const LAS int*)(F.lds + TBL_OFF); S.round = 0;
    EpiCtx E; E.ws = F.ws; E.out = F.out; E.in = F.in; E.shift = 0.f;
#define IN(k) (lo <= (k) && (k) < hi)
#define SEAM(k) do { if (IN(k) && IN((k) + 1)) xcd_barrier(bar); } while (0)
    if (IN(PH_P0)) { p0_prologue(F); } SEAM(PH_P0);
    if (IN(PH_PROJ)) { gemm_phase<PH_PROJ>(F.lds, S, E); gemm_phase<PH_MEMK>(F.lds, S, E); gemm_phase<PH_MEMV>(F.lds, S, E); } SEAM(PH_PROJ);
    if (IN(PH_MIX)) { mix_phase(F); } SEAM(PH_MIX);
    if (IN(PH_WOUT)) { gemm_phase<PH_WOUT>(F.lds, S, E); } SEAM(PH_WOUT);
    if (IN(PH_WCQ)) { gemm_phase<PH_WCQ>(F.lds, S, E); } SEAM(PH_WCQ);
    if (IN(PH_SC)) { E.shift = *(const float*)(F.ws + WS_WRT + 256 * 1024); gemm_phase<PH_SC>(F.lds, S, E); } SEAM(PH_SC);
    if (IN(PH_PV)) { gemm_phase<PH_PV>(F.lds, S, E); } SEAM(PH_PV);
    if (IN(PH_WCO)) { gemm_phase<PH_WCO>(F.lds, S, E); } SEAM(PH_WCO);
    if (IN(PH_ROUTE)) { route_phase(F); } SEAM(PH_ROUTE);
    if (IN(PH_UP)) { build_tile_table(F); gemm_phase<PH_UP>(F.lds, S, E); } SEAM(PH_UP);
    for (int r = 0; r < 2; ++r) {
        if (IN(PH_DOWN0 + r)) { build_tile_table(F); S.round = r; gemm_phase<PH_DOWN0>(F.lds, S, E); }
        if (r == 0) SEAM(PH_DOWN0);
    }
#undef IN
#undef SEAM
}

#ifndef N_LAUNCH_MODE
#define N_LAUNCH_MODE 1
#endif
extern "C" void kernel_launch(void* const* d_in, const int* in_sizes, int n_in, void* d_out, int out_size, void* d_ws, size_t ws_size, hipStream_t stream) {
    static int grid = 0;
    if (grid == 0) {
        if (n_in != 27 || out_size != T * D || ws_size < WS_END) { fprintf(stderr, "kernel_launch: unexpected shapes (n_in %d out %d ws %zu)\n", n_in, out_size, ws_size); grid = -1; return; }
        int dev = 0, cus = 0, per_cu = 0;
        if (hipGetDevice(&dev) != hipSuccess || hipDeviceGetAttribute(&cus, hipDeviceAttributeMultiprocessorCount, dev) != hipSuccess) { grid = -1; return; }
        if (hipFuncSetAttribute((const void*)fwd_kernel, hipFuncAttributeMaxDynamicSharedMemorySize, LDS_BYTES) != hipSuccess) { fprintf(stderr, "kernel_launch: hipFuncSetAttribute failed\n"); grid = -1; return; }
        if (hipOccupancyMaxActiveBlocksPerMultiprocessor(&per_cu, (const void*)fwd_kernel, NTHR, LDS_BYTES) != hipSuccess || per_cu < 1) { fprintf(stderr, "kernel_launch: occupancy query says %d\n", per_cu); }
        (void)hipGetLastError();
        grid = cus;
    }
    if (grid < 0) return;
    (void)hipMemsetAsync((char*)d_ws + WS_CTL, 0, CTL_ZERO_BYTES, stream);
    Args a{};
    for (int i = 0; i < 27; ++i) a.in[i] = (const float*)d_in[i];
    a.out = (float*)d_out; a.ws = (unsigned char*)d_ws;
    if (N_LAUNCH_MODE == 1) { a.ph_lo = 0; a.ph_hi = PH_N; hipLaunchKernelGGL(fwd_kernel, dim3(grid), dim3(NTHR), LDS_BYTES, stream, a); }
    else for (int p = 0; p < PH_N; ++p) { a.ph_lo = p; a.ph_hi = p + 1; hipLaunchKernelGGL(fwd_kernel, dim3(grid), dim3(NTHR), LDS_BYTES, stream, a); }
}
```

```cpp
#include <hip/hip_runtime.h>
#include <hip/hip_bf16.h>
#include <cstdio>
#include <cstdint>

#define GAS __attribute__((address_space(1)))
#define LAS __attribute__((address_space(3)))
typedef unsigned short bf16_t;
typedef short bf16x8 __attribute__((ext_vector_type(8)));
typedef short s16x4 __attribute__((ext_vector_type(4)));
typedef float f32x4 __attribute__((ext_vector_type(4)));
typedef float f32x2 __attribute__((ext_vector_type(2)));
typedef float f32x16 __attribute__((ext_vector_type(16)));
typedef unsigned u32x4 __attribute__((ext_vector_type(4)));
typedef unsigned u32x2 __attribute__((ext_vector_type(2)));
typedef __bf16 bf16x2_t __attribute__((ext_vector_type(2)));
#define DI __device__ __forceinline__

#ifndef TS_PHASE
#define TS_PHASE -1
#endif
constexpr int T = 32768, D = 1024, BATCH = 8, SEQ = 4096, MEML = 256, NMEM = BATCH * MEML;
constexpr int INW = 1792;
constexpr int PJW = 768;
constexpr float EPS = 1e-6f;
constexpr int NWAVES = 8, NTHR = 512;
constexpr int CAP = 32768;
constexpr int MAXRT = 320;

constexpr size_t MiB = 1u << 20;
constexpr size_t WS_CTL = 0, CTL_ZERO_BYTES = 64 * 1024;
constexpr size_t WS_WRT = 1 * MiB;
constexpr size_t WS_SSQ1P = 2 * MiB;
constexpr size_t WS_SSQQ = 4 * MiB;
constexpr size_t WS_LSUM = 6 * MiB;
constexpr size_t WS_SSQK = 8 * MiB;
constexpr size_t WS_RSTDK = 8 * MiB + 512 * 1024;
constexpr size_t WS_RSTD0 = 9 * MiB;
constexpr size_t WS_LTOK = 10 * MiB, WS_LGATE = 18 * MiB, WS_LRSTD = 26 * MiB;
constexpr size_t WS_WIN = 34 * MiB, WS_WOUT = 38 * MiB, WS_WCQ = 40 * MiB, WS_WCK = 42 * MiB, WS_WCV = 44 * MiB, WS_WCO = 46 * MiB;
constexpr size_t WS_W13 = 48 * MiB, WS_W2 = 112 * MiB;
constexpr size_t WS_MEMB = 144 * MiB, WS_KMEM = 148 * MiB, WS_VMT = 152 * MiB;
constexpr size_t WS_RA = 156 * MiB;
constexpr size_t WS_RB = 220 * MiB;
constexpr size_t WS_RC = 332 * MiB;
constexpr size_t WS_RD = 396 * MiB;
constexpr size_t WS_END = 476 * MiB;
constexpr int CW_BAR = 4096, CW_CNT = 8192;

constexpr int RING_BYTES = 131072;
constexpr int LDS_BYTES = 147456;
constexpr int LDSCTL_OFF = RING_BYTES, MISC_OFF = LDS_BYTES - 256;
constexpr int TBL_OFF = RING_BYTES + 512;
constexpr int XCH_OFF = RING_BYTES + 2048;
constexpr int SGP_OFF = RING_BYTES + 4096;
constexpr int SGR_OFF = RING_BYTES + 8192;
constexpr int RT_XT_BYTES = 16 * 260 * 4;
constexpr int RT_HIST_OFF = 8 * RT_XT_BYTES;

#define RLX_AGENT __ATOMIC_RELAXED, __HIP_MEMORY_SCOPE_AGENT
#define LDS_WAIT() asm volatile("s_waitcnt lgkmcnt(0)" ::: "memory")
#define VM_WAIT() asm volatile("s_waitcnt vmcnt(0)" ::: "memory")
DI unsigned f2bf(float f) { unsigned u = __builtin_bit_cast(unsigned, f); return (u + 0x7fffu + ((u >> 16) & 1u)) >> 16; }
DI unsigned pk2(float lo, float hi) { f32x2 v = {lo, hi}; bf16x2_t b = __builtin_convertvector(v, bf16x2_t); return __builtin_bit_cast(unsigned, b); }
DI float bf2f(unsigned short h) { return __builtin_bit_cast(float, (unsigned)h << 16); }
DI float bflo(unsigned w) { return __builtin_bit_cast(float, w << 16); }
DI float bfhi(unsigned w) { return __builtin_bit_cast(float, w & 0xffff0000u); }
DI float wave_sum(float v) {
#pragma unroll
    for (int o = 1; o < 64; o <<= 1) v += __shfl_xor(v, o);
    return v;
}
DI float fast_exp(float x) { return __builtin_amdgcn_exp2f(x * 1.4426950408889634f); }
DI float gelu_tanh(float x) {
    const float z2 = 1.5957691216057308f * (x + 0.044715f * x * x * x);
    return x * __builtin_amdgcn_rcpf(1.0f + fast_exp(-z2));
}
DI float silu(float x) { return x * __builtin_amdgcn_rcpf(1.0f + fast_exp(-x)); }

#define XB_TMO      128
#define XB_XCNT(j)  (256  + 64 * (j))
#define XB_XSUB(j)  (1280 + 64 * (j))
#define XB_XGEN(j)  (2304 + 64 * (j))
#define XB_TOP      3328
#define XB_TOPGEN   3392
#define XCD_BAR_WORDS 3456
#define XB_SPIN_CAP (1u << 18)
DI unsigned xb_ld(unsigned* p)              { return __hip_atomic_load(p, __ATOMIC_RELAXED, __HIP_MEMORY_SCOPE_AGENT); }
DI unsigned xb_add(unsigned* p, unsigned v) { return __hip_atomic_fetch_add(p, v, __ATOMIC_RELAXED, __HIP_MEMORY_SCOPE_AGENT); }
DI unsigned xb_xcc_id() { return (unsigned)__builtin_amdgcn_s_getreg((3 << 11) | 20) & 0xFu; }
#define XB_SPIN(cond, bar) do { unsigned _sp = 0; while (cond) { __builtin_amdgcn_s_sleep(1); \
    if ((++_sp & 255u) == 0u) { if (xb_ld(&(bar)[XB_TMO])) break; if (_sp > XB_SPIN_CAP) { atomicAdd(&(bar)[XB_TMO], 1u); break; } } } } while (0)
struct XcdBarrier { unsigned* bar; unsigned x; volatile LAS unsigned* st; };
DI XcdBarrier xcd_barrier_post(unsigned* bar, volatile LAS unsigned* st) {
    XcdBarrier b; b.bar = bar; b.x = xb_xcc_id(); b.st = st;
    if (threadIdx.x == 0) (void)xb_add(&bar[XB_XCNT(b.x)], 1u);
    return b;
}
DI void xcd_barrier_complete(unsigned* bar, unsigned x, unsigned& nloc, unsigned& nx) {
    const unsigned G = gridDim.x * gridDim.y * gridDim.z;
    unsigned sum, cnt, mine, sp = 0u;
    for (;;) {
        sum = 0u; cnt = 0u; mine = 0u;
#pragma unroll
        for (unsigned j = 0; j < 16; ++j) { const unsigned c = xb_ld(&bar[XB_XCNT(j)]); sum += c; cnt += (c > 0u) ? 1u : 0u; mine = (j == x) ? c : mine; }
        if (sum == G) break;
        __builtin_amdgcn_s_sleep(1);
        if ((++sp & 255u) == 0u) { if (xb_ld(&bar[XB_TMO])) break; if (sp > XB_SPIN_CAP) { atomicAdd(&bar[XB_TMO], 1u); break; } }
    }
    nloc = mine > 0u ? mine : 1u; nx = cnt > 0u ? cnt : 1u;
}
DI void xcd_barrier(const XcdBarrier& b) {
    asm volatile("s_waitcnt vmcnt(0)" ::: "memory");
    __syncthreads();
    if (threadIdx.x == 0) {
        unsigned* bar = b.bar;
        __builtin_amdgcn_s_waitcnt(0);
        unsigned nloc = b.st[0], nx = b.st[1];
        if (nloc == 0u) { xcd_barrier_complete(bar, b.x, nloc, nx); b.st[0] = nloc; b.st[1] = nx; }
        const unsigned old = xb_add(&bar[XB_XSUB(b.x)], 1u);
        const unsigned gen = old / nloc;
        if (old + 1u == (gen + 1u) * nloc) {
            __builtin_amdgcn_fence(__ATOMIC_RELEASE, "agent");
            asm volatile("s_waitcnt vmcnt(0)" ::: "memory");
            const unsigned og = xb_add(&bar[XB_TOP], 1u);
            const unsigned tg = og / nx;
            if (og + 1u == (tg + 1u) * nx) xb_add(&bar[XB_TOPGEN], 1u);
            else XB_SPIN(xb_ld(&bar[XB_TOPGEN]) == tg, bar);
            __builtin_amdgcn_fence(__ATOMIC_ACQUIRE, "agent");
            xb_add(&bar[XB_XGEN(b.x)], 1u);
            asm volatile("s_waitcnt vmcnt(0)" ::: "memory");
        } else {
            XB_SPIN(xb_ld(&bar[XB_XGEN(b.x)]) == gen, bar);
            __builtin_amdgcn_fence(__ATOMIC_ACQUIRE, "agent");
            asm volatile("s_waitcnt vmcnt(0)" ::: "memory");
        }
    }
    __syncthreads();
}

struct Args {
    const float* in[27];
    float* out; unsigned char* ws;
    int ph_lo, ph_hi;
};
struct Frame {
    LAS unsigned char* lds;
    unsigned char* ws; float* out;
    int tid, lane, wave, G, bid;
    const float* const* in;
};
enum { I_X = 0, I_MEM, I_NORM_MIX, I_W_IN, I_Q_NORM, I_K_NORM, I_SINKS, I_SGU_NORM, I_SGU_W, I_SGU_B, I_ON_ATTN, I_ON_SGU, I_W_OUT,
       I_NORM_CROSS, I_NORM_MEM, I_W_CQ, I_W_CK, I_W_CV, I_CQ_NORM, I_CK_NORM, I_W_CO, I_NORM_FFN, I_WRG, I_WRE, I_W1, I_W3, I_W2 };

DI void p0_transpose_item(const float* W, int N, bf16_t* WT, int ldt, int row_off, const float* gain, LAS unsigned* scr, int kb, int nb, int lane) {
    const int k0 = 64 * kb, n0 = 64 * nb, c = lane & 15, kp = lane >> 4;
    f32x4 va[8], vb[8];
#pragma unroll
    for (int i = 0; i < 8; ++i) { const int kk = 2 * (kp + 4 * i);
        va[i] = __builtin_nontemporal_load((const GAS f32x4*)(W + (size_t)(k0 + kk) * N + n0 + 4 * c)); vb[i] = __builtin_nontemporal_load((const GAS f32x4*)(W + (size_t)(k0 + kk + 1) * N + n0 + 4 * c)); }
#pragma unroll
    for (int i = 0; i < 8; ++i) { const int kk = 2 * (kp + 4 * i);
        float ga = 1.f, gb = 1.f; if (gain) { ga = gain[k0 + kk]; gb = gain[k0 + kk + 1]; }
#pragma unroll
        for (int e = 0; e < 4; ++e) scr[(4 * c + e) * 33 + (kp + 4 * i)] = pk2(va[i][e] * ga, vb[i][e] * gb); }
    LDS_WAIT(); asm volatile("" ::: "memory");
    const int ch = lane & 7;
#pragma unroll
    for (int j = 0; j < 8; ++j) { const int n = (lane >> 3) + 8 * j; const LAS unsigned* sp = scr + n * 33 + 4 * ch;
        u32x4 o; o.x = sp[0]; o.y = sp[1]; o.z = sp[2]; o.w = sp[3];
        *(GAS u32x4*)(WT + (size_t)(row_off + n0 + n) * ldt + k0 + 8 * ch) = o; }
    LDS_WAIT(); asm volatile("" ::: "memory");
}
DI void rms_row_to_bf16(const float* xrow, bf16_t* orow, int lane, float* rstd_out) {
    const GAS f32x4* xr = (const GAS f32x4*)xrow + lane;
    f32x4 v[4]; float s = 0.f;
#pragma unroll
    for (int j = 0; j < 4; ++j) { v[j] = __builtin_nontemporal_load(xr + 64 * j); s += (v[j].x * v[j].x + v[j].y * v[j].y) + (v[j].z * v[j].z + v[j].w * v[j].w); }
    float rstd = 1.0f / sqrtf(wave_sum(s) * (1.f / D) + EPS);
    if (rstd_out) { if (lane == 0) *rstd_out = rstd; rstd = 1.0f; }
    GAS u32x2* o8 = (GAS u32x2*)orow + lane;
#pragma unroll
    for (int j = 0; j < 4; ++j) { u32x2 w; w.x = pk2(v[j].x * rstd, v[j].y * rstd); w.y = pk2(v[j].z * rstd, v[j].w * rstd); o8[64 * j] = w; }
}
DI void p0_prologue(Frame& F) {
    LAS unsigned* scr = (LAS unsigned*)(F.lds + F.wave * 16384);
    const int gw = F.bid * NWAVES + F.wave, NGW = F.G * NWAVES, lane = F.lane;
    unsigned char* ws = F.ws;
    constexpr int I_IN = 16 * 28, I_SQ = 16 * 16, I_E1 = 32 * 16 * 8, I_E2 = 32 * 8 * 16;
    constexpr int NITEMS = I_IN + 5 * I_SQ + 2 * I_E1 + I_E2;
    for (int it = gw; it < NITEMS; it += NGW) {
        int r = it;
        if (r < I_IN) { p0_transpose_item(F.in[I_W_IN], INW, (bf16_t*)(ws + WS_WIN), D, 0, F.in[I_NORM_MIX], scr, r / 28, r % 28, lane); continue; } r -= I_IN;
        if (r < I_SQ) { const int kb = r / 16; const float* g = (kb < 8) ? F.in[I_ON_ATTN] : (F.in[I_ON_SGU] - 512);
                        p0_transpose_item(F.in[I_W_OUT], D, (bf16_t*)(ws + WS_WOUT), D, 0, g, scr, kb, r % 16, lane); continue; } r -= I_SQ;
        if (r < I_SQ) { p0_transpose_item(F.in[I_W_CQ], D, (bf16_t*)(ws + WS_WCQ), D, 0, F.in[I_NORM_CROSS], scr, r / 16, r % 16, lane); continue; } r -= I_SQ;
        if (r < I_SQ) { p0_transpose_item(F.in[I_W_CK], D, (bf16_t*)(ws + WS_WCK), D, 0, F.in[I_NORM_MEM], scr, r / 16, r % 16, lane); continue; } r -= I_SQ;
        if (r < I_SQ) { p0_transpose_item(F.in[I_W_CV], D, (bf16_t*)(ws + WS_WCV), D, 0, F.in[I_NORM_MEM], scr, r / 16, r % 16, lane); continue; } r -= I_SQ;
        if (r < I_SQ) { p0_transpose_item(F.in[I_W_CO], D, (bf16_t*)(ws + WS_WCO), D, 0, nullptr, scr, r / 16, r % 16, lane); continue; } r -= I_SQ;
        if (r < I_E1) { const int e = r / 128, q = r % 128;
                        p0_transpose_item(F.in[I_W1] + (size_t)e * D * 512, 512, (bf16_t*)(ws + WS_W13) + (size_t)e * 1024 * 1024, D, 0, F.in[I_NORM_FFN], scr, q / 8, q % 8, lane); continue; } r -= I_E1;
        if (r < I_E1) { const int e = r / 128, q = r % 128;
                        p0_transpose_item(F.in[I_W3] + (size_t)e * D * 512, 512, (bf16_t*)(ws + WS_W13) + (size_t)e * 1024 * 1024, D, 512, F.in[I_NORM_FFN], scr, q / 8, q % 8, lane); continue; } r -= I_E1;
        { const int e = r / 128, q = r % 128;
          p0_transpose_item(F.in[I_W2] + (size_t)e * 512 * D, D, (bf16_t*)(ws + WS_W2) + (size_t)e * 1024 * 512, 512, 0, nullptr, scr, q / 16, q % 16, lane); }
    }
    for (int m = gw; m < T + NMEM; m += NGW) {
        if (m < T) rms_row_to_bf16(F.in[I_X] + (size_t)m * D, (bf16_t*)(ws + WS_RA) + (size_t)m * D, lane, (float*)(ws + WS_RSTD0) + m);
        else rms_row_to_bf16(F.in[I_MEM] + (size_t)(m - T) * D, (bf16_t*)(ws + WS_MEMB) + (size_t)(m - T) * D, lane, nullptr);
    }
    {
        bf16_t* swb = (bf16_t*)(ws + WS_WRT + 512 * 1024);
        for (int i = F.bid * NTHR + F.tid; i < 8 * 128 * 128 / 8; i += F.G * NTHR) {
            const int j8 = (i & 15) * 8, ii = (i >> 4) & 127;
            const f32x4 a = *(const f32x4*)(F.in[I_SGU_W] + (size_t)i * 8), c = *(const f32x4*)(F.in[I_SGU_W] + (size_t)i * 8 + 4);
            float v[8] = {a[0], a[1], a[2], a[3], c[0], c[1], c[2], c[3]};
#pragma unroll
            for (int e = 0; e < 8; ++e) v[e] = (j8 + e <= ii) ? v[e] : 0.f;
            u32x4 w; w.x = pk2(v[0], v[1]); w.y = pk2(v[2], v[3]); w.z = pk2(v[4], v[5]); w.w = pk2(v[6], v[7]);
            *(GAS u32x4*)(swb + (size_t)i * 8) = w;
        }
    }
    {
        bf16_t* wrp = (bf16_t*)(ws + WS_WRT);
        for (int i = F.bid * NTHR + F.tid; i < 32 * 3 * 64 * 8; i += F.G * NTHR) {
            const int j = i & 7, ln = (i >> 3) & 63, nb = (i >> 9) % 3, sidx = i / 1536;
            const int k = 32 * sidx + 8 * (ln >> 4) + j, e = 16 * nb + (ln & 15);
            float w = 0.f;
            if (e < 4) w = F.in[I_WRG][k * 4 + e];
            else if (e < 36) { const int g = (e - 4) >> 3, ee = (e - 4) & 7; w = F.in[I_WRE][((size_t)g * D + k) * 8 + ee]; }
            w *= F.in[I_NORM_FFN][k];
            const unsigned h = f2bf(w); const unsigned l = f2bf(w - bf2f((unsigned short)h));
            wrp[((size_t)((sidx * 3 + nb) * 2 + 0) * 64 + ln) * 8 + j] = (bf16_t)h;
            wrp[((size_t)((sidx * 3 + nb) * 2 + 1) * 64 + ln) * 8 + j] = (bf16_t)l;
        }
    }
}

constexpr int BM = 256, BK = 64, HALF = 128, HTB = HALF * BK * 2;
DI int lds_byte(int r, int c) { const int st = (r >> 4) * 2 + (c >> 5), rr = r & 15, cc = c & 31, ob = rr * 64 + cc * 2; return st * 1024 + (ob ^ (((ob >> 9) & 1) << 5)); }
DI void stage_rc(int b, int& R, int& C) { const int st = b / 1024, sb = b % 1024, swz = sb ^ (((sb >> 9) & 1) << 5); R = (st >> 1) * 16 + swz / 64; C = (st & 1) * 32 + (swz % 64) / 2; }
DI int perm32(int rho) { const int n = rho >> 4, i = rho & 15; return 8 * (i >> 2) + 4 * n + (i & 3); }

enum { K_PROJ = 0, K_MEMK, K_MEMVT, K_WOUT, K_WCQ, K_SC, K_PV, K_WCO, K_UP, K_DOWN };
enum { PH_MEMK = 100, PH_MEMV = 101 };
enum { PH_P0 = 0, PH_PROJ, PH_MIX, PH_WOUT, PH_WCQ, PH_SC, PH_PV, PH_WCO, PH_ROUTE, PH_UP, PH_DOWN0, PH_DOWN1, PH_N };

struct GUnit {
    int half;
    const char* A; const char* B;
    int kind, pm, pn;
    const int* gl; int gcnt;
    int aux;
};

DI int xcd_remap(int wgid, int nwg) { const int q = nwg / 8, r = nwg % 8, xcd = wgid % 8, off = wgid / 8; return (xcd < r ? xcd * (q + 1) : r * (q + 1) + (xcd - r) * q) + off; }
DI void grouped_tile(int wgid, int nM, int nN, int& pm, int& pn) {
    const int nig = 8 * nN, gid = wgid / nig, fm = gid * 8, gsz = (nM - fm) < 8 ? (nM - fm) : 8;
    pm = fm + ((wgid % nig) % gsz); pn = (wgid % nig) / gsz;
}

struct Sched { int G, c; unsigned char* ws; const LAS int* tbl; int round; };
template <int PH> struct PCfg { static constexpr int K = 1024; static constexpr unsigned lda2 = 2048, ldb2 = 2048, hstepB = 32 * 2048; static constexpr int RS = 64; };
template <> struct PCfg<PH_UP> { static constexpr int K = 1024; static constexpr unsigned lda2 = 2048, ldb2 = 2048, hstepB = 512 * 2048; static constexpr int RS = 32; };
template <> struct PCfg<PH_DOWN0> { static constexpr int K = 512; static constexpr unsigned lda2 = 1024, ldb2 = 1024, hstepB = 32 * 1024; static constexpr int RS = 64; };

template <int PH, int HV = 0> DI bool sched_next(const Sched& S, int i, GUnit& u) {
    const int L = i * S.G + S.c; unsigned char* ws = S.ws;
    u.gl = nullptr; u.gcnt = 256; u.aux = 0; u.half = 0;
    if constexpr (PH == PH_PROJ) {
        constexpr int NP = 128 * 7;
        if (L >= NP) return false;
        const int w = xcd_remap(L, NP); grouped_tile(w, 128, 7, u.pm, u.pn); u.kind = K_PROJ;
        u.A = (const char*)(ws + WS_RA) + (size_t)u.pm * 256 * 2048; u.B = (const char*)(ws + WS_WIN) + (size_t)u.pn * 256 * 2048;
        return true;
    } else if constexpr (PH == PH_MEMK) {
        const int j = S.c - 128; if (i != 0 || j < 0 || j >= 32) return false;
        u.pm = j >> 2; u.pn = j & 3; u.kind = K_MEMK;
        u.A = (const char*)(ws + WS_MEMB) + (size_t)u.pm * 256 * 2048; u.B = (const char*)(ws + WS_WCK) + (size_t)u.pn * 256 * 2048;
        return true;
    } else if constexpr (PH == PH_MEMV) {
        const int j = S.c - 160; if (i != 0 || j < 0 || j >= 32) return false;
        u.pm = j >> 2; u.pn = j & 3; u.kind = K_MEMVT;
        u.A = (const char*)(ws + WS_MEMB) + (size_t)u.pm * 256 * 2048; u.B = (const char*)(ws + WS_WCV) + (size_t)u.pn * 256 * 2048;
        return true;
    } else if constexpr (PH == PH_WOUT || PH == PH_WCQ || PH == PH_WCO) {
        if (L >= 512) return false;
        const int w = xcd_remap(L, 512); grouped_tile(w, 128, 4, u.pm, u.pn);
        constexpr size_t wa = PH == PH_WOUT ? WS_RC : (PH == PH_WCQ ? WS_RA : WS_RD), wb = PH == PH_WOUT ? WS_WOUT : (PH == PH_WCQ ? WS_WCQ : WS_WCO);
        u.kind = PH == PH_WOUT ? K_WOUT : (PH == PH_WCQ ? K_WCQ : K_WCO);
        u.A = (const char*)(ws + wa) + (size_t)u.pm * 256 * 2048; u.B = (const char*)(ws + wb) + (size_t)u.pn * 256 * 2048;
        return true;
    } else {
        const LAS int* tbl = S.tbl;
        const int r0 = 0, r1 = 64;
        const int t0 = __builtin_amdgcn_readfirstlane(tbl[64 + r0]), t1 = __builtin_amdgcn_readfirstlane(tbl[64 + r1]), nu = (t1 - t0) * 4;
        const int nfull = nu / S.G, rem = nu - nfull * S.G;
        int Lu = L;
        if constexpr (HV) {
            if (i != 0 || 2 * rem > S.G || S.c >= 2 * rem || (S.c & 1) != HV - 1) return false;
            Lu = nfull * S.G + (S.c >> 1); u.half = HV;
        } else {
            if (i >= nfull) { if (i > nfull || 2 * rem <= S.G || S.c >= rem) return false; }
        }
        const int w = xcd_remap(Lu, nu); const int rt = t0 + (w >> 2), pn = w & 3;
        const int jl = r0 + 1 + (int)(threadIdx.x & 63);
        const bool hit = (jl < r1) && (tbl[64 + (jl < 64 ? jl : 64)] <= rt);
        const int re = r0 + (int)__popcll(__ballot(hit));
        const int jt = rt - __builtin_amdgcn_readfirstlane(tbl[64 + re]), cnt = __builtin_amdgcn_readfirstlane(tbl[re]), e = re & 31;
        u.pm = rt; u.pn = pn; u.gcnt = (cnt - jt * 256) < 256 ? (cnt - jt * 256) : 256; u.aux = re * CAP + jt * 256;
        if constexpr (PH == PH_UP) { u.kind = K_UP; u.gl = (const int*)(ws + WS_LTOK) + u.aux;
            u.A = (const char*)(ws + WS_RC); u.B = (const char*)(ws + WS_W13) + ((size_t)e * 1024 + pn * 128) * 2048; }
        else { u.kind = K_DOWN;
            u.A = (const char*)(ws + WS_RD) + (size_t)rt * 256 * 1024; u.B = (const char*)(ws + WS_W2) + ((size_t)e * 1024 + pn * 256) * 1024; }
        return true;
    }
}

struct EpiCtx {
    unsigned char* ws; float* out; const float* const* in;
};

DI void store_bf16x8(bf16_t* p, const f32x4& a, const f32x4& b) { u32x4 w; w.x = pk2(a[0], a[1]); w.y = pk2(a[2], a[3]); w.z = pk2(b[0], b[1]); w.w = pk2(b[2], b[3]); *(GAS u32x4*)p = w; }
DI float sumsq16(const f32x4& a, const f32x4& b, const f32x4& c, const f32x4& d) {
    return ((a[0] * a[0] + a[1] * a[1]) + (a[2] * a[2] + a[3] * a[3])) + ((b[0] * b[0] + b[1] * b[1]) + (b[2] * b[2] + b[3] * b[3])) +
           ((c[0] * c[0] + c[1] * c[1]) + (c[2] * c[2] + c[3] * c[3])) + ((d[0] * d[0] + d[1] * d[1]) + (d[2] * d[2] + d[3] * d[3]));
}
#define RSLOT(p) (((p) == 0 ? 4 : (p) == 1 ? 5 : (p) == 2 ? 0 : (p) == 3 ? 1 : (p) == 4 ? 6 : (p) == 5 ? 7 : 2) * 16384)
#define PIN_ROW(ai, m) asm volatile("" : "+v"(acc[ai][0][m][0]), "+v"(acc[ai][0][m][1]), "+v"(acc[ai][1][m][0]), "+v"(acc[ai][1][m][1]))
DI float quad_sum(float s) { s += __shfl_xor(s, 16); s += __shfl_xor(s, 32); return s; }

template <int PH, int HV = 0> DI void epilogue(const EpiCtx& E, const GUnit& u, f32x4 (&acc)[2][2][4][2], int wr, int wc, int fr_, int fq_, const float (&epre)[8], LAS unsigned char* lds, bool resl) {
    int fr = fr_, fq = fq_; asm volatile("" : "+v"(fr), "+v"(fq));
    unsigned char* ws = E.ws;
    const int rbase = wr * 64 + fr;
    const int cb = 64 * wc + 8 * fq;
    const int kind = (PH == PH_PROJ) ? K_PROJ : (PH == PH_MEMK) ? K_MEMK : (PH == PH_MEMV) ? K_MEMVT : (PH == PH_WOUT ? K_WOUT : PH == PH_WCQ ? K_WCQ : PH == PH_WCO ? K_WCO : PH == PH_UP ? K_UP : K_DOWN);
    switch (kind) {
    case K_PROJ: {
        const int hd = 4 * u.pn + wc;
        bf16_t* PJ = (bf16_t*)(ws + WS_RB) + ((size_t)u.pm * 256 + rbase) * PJW + 64 * (hd < 12 ? hd - 8 : hd - 16) + 8 * fq;
        const int cmh = (hd < 8) ? hd : hd - 4;
        unsigned char* QU = ws + WS_RD + ((size_t)(u.pm * 8 + (rbase >> 5)) * 128 + 8 * cmh + fq) * 512 + (rbase & 31) * 16;
        const float* R0 = (const float*)(ws + WS_RSTD0) + (size_t)u.pm * 256 + rbase;
        float r0v[2][4];
#pragma unroll
        for (int ai = 0; ai < 2; ++ai)
#pragma unroll
            for (int m = 0; m < 4; ++m) r0v[ai][m] = R0[ai * 128 + m * 16];
        if (hd < 10) {
            const float* gp = (hd < 8) ? E.in[I_Q_NORM] : E.in[I_K_NORM]; const float sc = (hd < 8) ? 0.125f * 1.4426950408889634f : 1.0f;
#pragma unroll
            for (int ai = 0; ai < 2; ++ai)
#pragma unroll
                for (int m = 0; m < 4; ++m) {
                    const float r0 = r0v[ai][m];
                    const float ss = quad_sum(sumsq16(acc[ai][0][m][0], acc[ai][0][m][1], acc[ai][1][m][0], acc[ai][1][m][1])) * (r0 * r0);
                    const float rstd = sc * r0 / sqrtf(ss * (1.0f / 64.0f) + EPS);
#pragma unroll
                    for (int bj = 0; bj < 2; ++bj) {
                        const f32x4 g0 = *(const f32x4*)(gp + 32 * bj + 8 * fq), g1 = *(const f32x4*)(gp + 32 * bj + 8 * fq + 4);
                        if (hd < 8) store_bf16x8((bf16_t*)(QU + (size_t)((ai * 4 + (m >> 1)) * 128 + 4 * bj) * 512 + (m & 1) * 256), acc[ai][bj][m][0] * rstd * g0, acc[ai][bj][m][1] * rstd * g1);
                        else store_bf16x8(PJ + (size_t)(ai * 128 + m * 16) * PJW + 32 * bj, acc[ai][bj][m][0] * rstd * g0, acc[ai][bj][m][1] * rstd * g1);
                    }
                    asm volatile("" ::: "memory");
                }
        } else if (hd < 12) {
#pragma unroll
            for (int ai = 0; ai < 2; ++ai)
#pragma unroll
                for (int m = 0; m < 4; ++m) {
                    const float r0 = r0v[ai][m];
#pragma unroll
                    for (int bj = 0; bj < 2; ++bj) store_bf16x8(PJ + (size_t)(ai * 128 + m * 16) * PJW + 32 * bj, acc[ai][bj][m][0] * r0, acc[ai][bj][m][1] * r0);
                }
        } else {
#pragma unroll
            for (int ai = 0; ai < 2; ++ai)
#pragma unroll
                for (int m = 0; m < 4; ++m) {
                    const float r0 = r0v[ai][m];
#pragma unroll
                    for (int bj = 0; bj < 2; ++bj) {
                        f32x4 v0 = acc[ai][bj][m][0] * r0, v1 = acc[ai][bj][m][1] * r0;
#pragma unroll
                        for (int e = 0; e < 4; ++e) { v0[e] = gelu_tanh(v0[e]); v1[e] = gelu_tanh(v1[e]); }
                        if (hd < 20) store_bf16x8((bf16_t*)(QU + (size_t)((ai * 4 + (m >> 1)) * 128 + 4 * bj) * 512 + (m & 1) * 256), v0, v1);
                        else store_bf16x8(PJ + (size_t)(ai * 128 + m * 16) * PJW + 32 * bj, v0, v1);
                    }
                    asm volatile("" ::: "memory");
                }
        }
        break; }
    case K_MEMK: {
        bf16_t* KM = (bf16_t*)(ws + WS_KMEM); float* SK = (float*)(ws + WS_SSQK);
        f32x4 g[2][2];
#pragma unroll
        for (int bj = 0; bj < 2; ++bj)
#pragma unroll
            for (int n = 0; n < 2; ++n) g[bj][n] = *(const f32x4*)(E.in[I_CK_NORM] + cb + 32 * bj + 4 * n);
#pragma unroll
        for (int ai = 0; ai < 2; ++ai)
#pragma unroll
            for (int m = 0; m < 4; ++m) {
                const size_t grow = (size_t)u.pm * 256 + ai * 128 + m * 16 + rbase;
                const float ss = quad_sum(sumsq16(acc[ai][0][m][0], acc[ai][0][m][1], acc[ai][1][m][0], acc[ai][1][m][1]));
                if (fq == 0) SK[(grow * 4 + u.pn) * 4 + wc] = ss;
#pragma unroll
                for (int bj = 0; bj < 2; ++bj) store_bf16x8(KM + grow * D + u.pn * 256 + cb + 32 * bj, acc[ai][bj][m][0] * g[bj][0], acc[ai][bj][m][1] * g[bj][1]);
            }
        break; }
    case K_MEMVT: {
        bf16_t* VT = (bf16_t*)(ws + WS_VMT);
#pragma unroll
        for (int ai = 0; ai < 2; ++ai)
#pragma unroll
            for (int m = 0; m < 4; ++m) {
                const size_t grow = (size_t)u.pm * 256 + ai * 128 + m * 16 + rbase;
#pragma unroll
                for (int bj = 0; bj < 2; ++bj) store_bf16x8(VT + grow * D + u.pn * 256 + cb + 32 * bj, acc[ai][bj][m][0], acc[ai][bj][m][1]);
            }
        break; }
    case K_WOUT: {
        const size_t off0 = ((size_t)u.pm * 256 + rbase) * D + u.pn * 256 + cb;
        bf16_t* XB = (bf16_t*)(ws + WS_RA) + off0; float* SP = (float*)(ws + WS_SSQ1P) + ((size_t)u.pm * 256 + rbase) * 16 + u.pn * 4 + wc;
#pragma unroll
        for (int ai = 0; ai < 2; ++ai) {
            u32x4 rv[4][2];
#pragma unroll
            for (int m = 0; m < 4; ++m)
#pragma unroll
                for (int bj = 0; bj < 2; ++bj) rv[m][bj] = (resl && !(ai == 1 && wc == 3)) ? *(const LAS u32x4*)(lds + RSLOT(ai * 4 + wc) + lds_byte(wr * 64 + m * 16 + fr, 32 * bj + 8 * fq)) : __builtin_nontemporal_load((const GAS u32x4*)(XB + (size_t)(ai * 128 + m * 16) * D + 32 * bj));
            asm volatile("" ::: "memory");
#pragma unroll
            for (int m = 0; m < 4; ++m) {
                const size_t ro = (size_t)(ai * 128 + m * 16) * D;
                f32x4 v[2][2];
#pragma unroll
                for (int bj = 0; bj < 2; ++bj) {
                    const u32x4 r = rv[m][bj];
                    f32x4 v0 = acc[ai][bj][m][0], v1 = acc[ai][bj][m][1];
                    v0[0] += bflo(r.x); v0[1] += bfhi(r.x); v0[2] += bflo(r.y); v0[3] += bfhi(r.y);
                    v1[0] += bflo(r.z); v1[1] += bfhi(r.z); v1[2] += bflo(r.w); v1[3] += bfhi(r.w);
                    v[bj][0] = v0; v[bj][1] = v1;
                    store_bf16x8(XB + ro + 32 * bj, v0, v1);
                }
                const float ss = quad_sum(sumsq16(v[0][0], v[0][1], v[1][0], v[1][1])); if (fq == 0) SP[(size_t)(ai * 128 + m * 16) * 16] = ss;
            }
            asm volatile("" ::: "memory");
        }
        break; }
    case K_WCO: {
        const size_t off0 = ((size_t)u.pm * 256 + rbase) * D + u.pn * 256 + cb;
        const bf16_t* X1 = (const bf16_t*)(ws + WS_RA) + off0;
        bf16_t* XB = (bf16_t*)(ws + WS_RC) + off0;
#pragma unroll
        for (int ai = 0; ai < 2; ++ai) {
            u32x4 rv[4][2];
#pragma unroll
            for (int m = 0; m < 4; ++m)
#pragma unroll
                for (int bj = 0; bj < 2; ++bj) rv[m][bj] = (resl && !(ai == 1 && wc == 3)) ? *(const LAS u32x4*)(lds + RSLOT(ai * 4 + wc) + lds_byte(wr * 64 + m * 16 + fr, 32 * bj + 8 * fq)) : __builtin_nontemporal_load((const GAS u32x4*)(X1 + (size_t)(ai * 128 + m * 16) * D + 32 * bj));
            asm volatile("" ::: "memory");
#pragma unroll
            for (int m = 0; m < 4; ++m) {
                const size_t ro = (size_t)(ai * 128 + m * 16) * D;
#pragma unroll
                for (int bj = 0; bj < 2; ++bj) {
                    const u32x4 r = rv[m][bj];
                    f32x4 v0 = acc[ai][bj][m][0], v1 = acc[ai][bj][m][1];
                    v0[0] += bflo(r.x); v0[1] += bfhi(r.x); v0[2] += bflo(r.y); v0[3] += bfhi(r.y);
                    v1[0] += bflo(r.z); v1[1] += bfhi(r.z); v1[2] += bflo(r.w); v1[3] += bfhi(r.w);
                    store_bf16x8(XB + ro + 32 * bj, v0, v1);
                }
            }
            asm volatile("" ::: "memory");
        }
        break; }
    case K_WCQ: {
        bf16_t* QC = (bf16_t*)(ws + WS_RB); const float* SP = (const float*)(ws + WS_SSQ1P); float* SQ = (float*)(ws + WS_SSQQ);
        f32x4 g[2][2];
#pragma unroll
        for (int bj = 0; bj < 2; ++bj)
#pragma unroll
            for (int n = 0; n < 2; ++n) g[bj][n] = *(const f32x4*)(E.in[I_CQ_NORM] + cb + 32 * bj + 4 * n);
#pragma unroll
        for (int ai = 0; ai < 2; ++ai)
#pragma unroll
            for (int m = 0; m < 4; ++m) {
                const size_t grow = (size_t)u.pm * 256 + ai * 128 + m * 16 + rbase;
                const f32x4 p = *(const f32x4*)(SP + grow * 16 + 4 * fq);
                const float tot = quad_sum((p[0] + p[1]) + (p[2] + p[3]));
                const float rstd1 = 1.0f / sqrtf(tot * (1.0f / D) + EPS);
                f32x4 v[2][2];
#pragma unroll
                for (int bj = 0; bj < 2; ++bj)
#pragma unroll
                    for (int n = 0; n < 2; ++n) v[bj][n] = acc[ai][bj][m][n] * rstd1;
                const float ss = quad_sum(sumsq16(v[0][0], v[0][1], v[1][0], v[1][1]));
                if (fq == 0) SQ[(grow * 4 + u.pn) * 4 + wc] = ss;
#pragma unroll
                for (int bj = 0; bj < 2; ++bj) store_bf16x8(QC + grow * D + u.pn * 256 + cb + 32 * bj, v[bj][0] * g[bj][0], v[bj][1] * g[bj][1]);
            }
        break; }
    case K_UP: {
        bf16_t* HID = (bf16_t*)(ws + WS_RD); const float* LR = (const float*)(ws + WS_LRSTD) + u.aux;
#pragma unroll
        for (int ai = (HV ? HV - 1 : 0); ai < (HV ? HV : 2); ++ai)
#pragma unroll
            for (int m = 0; m < 4; ++m) {
                PIN_ROW(ai, m);
                const int lrow = ai * 128 + m * 16 + rbase;
                const float rs = epre[ai * 4 + m];
                f32x4 hv[2];
#pragma unroll
                for (int n = 0; n < 2; ++n)
#pragma unroll
                    for (int e = 0; e < 4; ++e) hv[n][e] = silu(acc[ai][0][m][n][e] * rs) * (acc[ai][1][m][n][e] * rs);
                store_bf16x8(HID + ((size_t)u.pm * 256 + lrow) * 512 + u.pn * 128 + 32 * wc + 8 * fq, hv[0], hv[1]);
                asm volatile("" ::: "memory");
            }
        break; }
    case K_DOWN: {
        const int* LT = (const int*)(ws + WS_LTOK) + u.aux; const float* LG = (const float*)(ws + WS_LGATE) + u.aux;
        bf16_t* CB0 = (bf16_t*)(ws + WS_RB) + u.pn * 256 + cb; bf16_t* CB1 = (bf16_t*)(ws + WS_RA) + u.pn * 256 + cb;
        int tk[2][4]; float gt[2][4];
#pragma unroll
        for (int ai = (HV ? HV - 1 : 0); ai < (HV ? HV : 2); ++ai)
#pragma unroll
            for (int m = 0; m < 4; ++m) { const int lrow = ai * 128 + m * 16 + rbase; const bool ok = (lrow < u.gcnt); tk[ai][m] = ok ? LT[lrow] : -1; gt[ai][m] = ok ? LG[lrow] : 0.f; }
#pragma unroll
        for (int ai = (HV ? HV - 1 : 0); ai < (HV ? HV : 2); ++ai)
#pragma unroll
            for (int m = 0; m < 4; ++m) {
                if (tk[ai][m] >= 0) {
                    bf16_t* o = ((tk[ai][m] & 1) ? CB1 : CB0) + (size_t)(tk[ai][m] >> 1) * D; const float g = gt[ai][m];
#pragma unroll
                    for (int bj = 0; bj < 2; ++bj) store_bf16x8(o + 32 * bj, acc[ai][bj][m][0] * g, acc[ai][bj][m][1] * g);
                }
            }
        break; }
    }
}

template <int PH> struct Stagger { static constexpr int ways = 1; static constexpr unsigned ticks = 0; };
#ifndef STG_WOUT
#define STG_WOUT 0
#endif
#ifndef STG_WCO
#define STG_WCO 0
#endif
#ifndef STG_DOWN
#define STG_DOWN 0
#endif
template <> struct Stagger<PH_WOUT> { static constexpr int ways = 2; static constexpr unsigned ticks = STG_WOUT; };
template <> struct Stagger<PH_WCO> { static constexpr int ways = 2; static constexpr unsigned ticks = STG_WCO; };
template <> struct Stagger<PH_DOWN0> { static constexpr int ways = 4; static constexpr unsigned ticks = STG_DOWN; };
template <int PH, int HV = 0> DI void gemm_phase(LAS unsigned char* lds, const Sched& S, const EpiCtx& E) {
    if constexpr (Stagger<PH>::ways > 1 && Stagger<PH>::ticks > 0) {
        const unsigned way = ((unsigned)S.c >> 3) % Stagger<PH>::ways;
        if (way) { const unsigned long long t0 = __builtin_amdgcn_s_memrealtime(), dl = (unsigned long long)way * Stagger<PH>::ticks;
            while (__builtin_amdgcn_s_memrealtime() - t0 < dl) __builtin_amdgcn_s_sleep(8); }
    }
    typedef PCfg<(PH == PH_DOWN1 ? PH_DOWN0 : PH)> g;
    constexpr bool GATHER = (PH == PH_UP);
    constexpr bool CMA = (PH == PH_WOUT || PH == PH_WCO);
    constexpr bool RESL = (PH == PH_WOUT || PH == PH_WCO);
    constexpr bool HALVES = (PH == PH_UP || PH == PH_DOWN0);
    const int tid = threadIdx.x, wid = __builtin_amdgcn_readfirstlane(tid >> 6), lane = tid & 63, wr = wid >> 2, wc = wid & 3, fr = lane & 15, fq = lane >> 4;
    constexpr int nt = g::K / BK;
    int R0, C0; stage_rc(tid * 16, R0, C0);
    unsigned vB[2], vA0[2], vR[2];
#pragma unroll
    for (int i = 0; i < 2; ++i) { const int R = R0 + 64 * i; vB[i] = (unsigned)(g::RS * (R >> 5) + perm32(R & 31)) * g::ldb2 + (unsigned)C0 * 2u; vR[i] = (unsigned)R * 2048u + (unsigned)C0 * 2u; vA0[i] = CMA ? (unsigned)(((R >> 5) * 128 + (C0 >> 3)) * 512 + (R & 31) * 16) : (unsigned)R * g::lda2 + (unsigned)C0 * 2u; }
    const unsigned ldsw = (unsigned)wid * 1024u;
    const int aoff = lds_byte(wr * 64 + fr, fq * 8), boff = lds_byte(wc * 32 + fr, fq * 8);
    constexpr size_t hA = (size_t)HALF * g::lda2;
#define SA(b, h) (((b) * 2 + (h)) * HTB)
#define SB(b, h) ((4 + (b) * 2 + (h)) * HTB)
#define GLDS(gp, loff) __builtin_amdgcn_global_load_lds((const unsigned*)(gp), (LAS unsigned*)(lds + (loff)), 16, 0, 0)
#define STG_A(bufoff, base, h, useN) do { if constexpr (GATHER) { \
        GLDS((base) + vAc[h][0], (bufoff) + ldsw); GLDS((base) + vAc[h][1], (bufoff) + ldsw + 8192); } else { \
        GLDS((base) + (h) * hA + vA0[0], (bufoff) + ldsw); GLDS((base) + (h) * hA + vA0[1], (bufoff) + ldsw + 8192); } } while (0)
#define STG_B(bufoff, base) do { GLDS((base) + vB[0], (bufoff) + ldsw); GLDS((base) + vB[1], (bufoff) + ldsw + 8192); } while (0)
#define STG_BR(bufoff, base, piece) do { if constexpr (RESL) { const char* bb_ = resm ? resb + ((piece) >> 2) * (128 * 2048) + ((piece) & 3) * 128 : (const char*)(base); \
        GLDS(bb_ + (resm ? vR[0] : vB[0]), (bufoff) + ldsw); GLDS(bb_ + (resm ? vR[1] : vB[1]), (bufoff) + ldsw + 8192); } else { STG_B(bufoff, base); } } while (0)
#define STG_AR(bufoff, base, h, useN, piece) do { if constexpr (RESL) { const char* bb_ = resm ? resb + ((piece) >> 2) * (128 * 2048) + ((piece) & 3) * 128 : (const char*)(base) + (h) * hA; \
        GLDS(bb_ + (resm ? vR[0] : vA0[0]), (bufoff) + ldsw); GLDS(bb_ + (resm ? vR[1] : vA0[1]), (bufoff) + ldsw + 8192); } else { STG_A(bufoff, base, h, useN); } } while (0)
#define LDA(dst, b, h) do { _Pragma("unroll") for (int m = 0; m < 4; ++m) _Pragma("unroll") for (int k = 0; k < 2; ++k) dst[m][k] = *(const LAS bf16x8*)(lds + SA(b, h) + aoff + m * 2048 + k * 1024); } while (0)
#define LDB(dst, b, h) do { _Pragma("unroll") for (int n = 0; n < 2; ++n) _Pragma("unroll") for (int k = 0; k < 2; ++k) dst[n][k] = *(const LAS bf16x8*)(lds + SB(b, h) + boff + n * 2048 + k * 1024); } while (0)
#define MMA(ai, bj, At, Bt) do { __builtin_amdgcn_s_setprio(1); _Pragma("unroll") for (int m = 0; m < 4; ++m) _Pragma("unroll") for (int n = 0; n < 2; ++n) _Pragma("unroll") for (int k = 0; k < 2; ++k) \
        acc[ai][bj][m][n] = __builtin_amdgcn_mfma_f32_16x16x32_bf16(Bt[n][k], At[m][k], acc[ai][bj][m][n], 0, 0, 0); __builtin_amdgcn_s_setprio(0); } while (0)
#define WAIT_V(n) asm volatile("s_waitcnt vmcnt(" #n ")" ::: "memory")
#define WAIT_L(n) asm volatile("s_waitcnt lgkmcnt(" #n ")" ::: "memory")
#define BAR __builtin_amdgcn_s_barrier()
#define SCHED __builtin_amdgcn_sched_barrier(0)
#define LOAD_IDX(ii, U) do { _Pragma("unroll") for (int h = 0; h < 2; ++h) _Pragma("unroll") for (int i = 0; i < 2; ++i) { const int r_ = 128 * h + R0 + 64 * i; \
        (ii)[h][i] = (r_ < (U).gcnt) ? ((U).gl[r_] >> 1) : 0; } } while (0)
#define IDX_TO_VA(vv, ii) do { _Pragma("unroll") for (int h = 0; h < 2; ++h) _Pragma("unroll") for (int i = 0; i < 2; ++i) (vv)[h][i] = (unsigned)(ii)[h][i] * g::lda2 + (unsigned)C0 * 2u; } while (0)
    GUnit cur, nxt; int ui = 0;
    if (!sched_next<PH, HV>(S, 0, cur)) return;
    f32x4 acc[2][2][4][2];
#pragma unroll
    for (int a = 0; a < 2; ++a)
#pragma unroll
        for (int b = 0; b < 2; ++b)
#pragma unroll
            for (int m = 0; m < 4; ++m)
#pragma unroll
                for (int n = 0; n < 2; ++n) acc[a][b][m][n] = (f32x4){0.f, 0.f, 0.f, 0.f};
    bf16x8 At[4][2], B0[2][2], B1[2][2];
    unsigned vAc[2][2]; int idxn[2][2]; float epre[8];
    if constexpr (GATHER) { LOAD_IDX(idxn, cur); IDX_TO_VA(vAc, idxn); }
    const char* cA = cur.A; const char* cB = cur.B;
    constexpr size_t kstep = BK * 2; constexpr size_t hB = g::hstepB;
    constexpr size_t kstepA = CMA ? 8 * 512 : BK * 2;
    STG_B(SB(0, 0), cB); STG_B(SB(0, 1), cB + hB); STG_A(SA(0, 0), cA, 0, false); STG_A(SA(0, 1), cA, 1, false);
    if (wr == 1) BAR;
    WAIT_V(2); BAR;
    STG_B(SB(1, 0), cB + kstep); STG_A(SA(1, 0), cA + kstepA, 0, false); STG_B(SB(1, 1), cB + hB + kstep);
    WAIT_V(6); BAR;
    for (;;) {
        const bool has_next = sched_next<PH, HV>(S, ui + 1, nxt);
        const char* nA = has_next ? nxt.A : cA; const char* nB = has_next ? nxt.B : cB;
#pragma unroll 1
        for (int t = 0; t < nt; t += 2) {
            const bool last = (t == nt - 2);
            if constexpr (GATHER) { if (last) { if (has_next) { LOAD_IDX(idxn, nxt); }
                const float* LR_ = (const float*)(E.ws + WS_LRSTD) + cur.aux;
#pragma unroll
                for (int ai = 0; ai < 2; ++ai)
#pragma unroll
                    for (int m = 0; m < 4; ++m) { const int lr_ = ai * 128 + m * 16 + wr * 64 + fr; epre[ai * 4 + m] = (lr_ < cur.gcnt) ? LR_[lr_] : 0.f; } } }
            const bool resm = RESL && last && !has_next;
            const char* resb = (const char*)(E.ws + WS_RA) + ((size_t)cur.pm * 256 * D + cur.pn * 256) * 2;
            const char* a1 = cA + (size_t)(t + 1) * kstepA;
            const char* a2 = last ? nA : cA + (size_t)(t + 2) * kstepA; const char* b2 = last ? nB : cB + (size_t)(t + 2) * kstep;
            const char* a3 = a2 + kstepA; const char* b3 = b2 + kstep;
            LDB(B0, 0, 0); LDB(B1, 0, 1); SCHED; if constexpr (HV != 2) LDA(At, 0, 0); STG_A(SA(1, 1), a1, 1, false);
            WAIT_V(8); WAIT_L(0); BAR; if constexpr (HV != 2) { MMA(0, 0, At, B0); MMA(0, 1, At, B1); } BAR; SCHED;
            if constexpr (GATHER) { if (last) { asm volatile("" : "+v"(epre[0]), "+v"(epre[1]), "+v"(epre[2]), "+v"(epre[3]), "+v"(epre[4]), "+v"(epre[5]), "+v"(epre[6]), "+v"(epre[7])); if (has_next) { IDX_TO_VA(vAc, idxn); } } }
            if constexpr (HV != 1) LDA(At, 0, 1); STG_BR(SB(0, 0), b2, 0); STG_BR(SB(0, 1), b2 + hB, 1); STG_AR(SA(0, 0), a2, 0, last, 2);
            WAIT_V(8); WAIT_L(0); BAR; if constexpr (HV != 1) { MMA(1, 0, At, B0); MMA(1, 1, At, B1); } BAR; SCHED;
            LDB(B0, 1, 0); LDB(B1, 1, 1); SCHED; if constexpr (HV != 2) LDA(At, 1, 0); STG_AR(SA(0, 1), a2, 1, last, 3);
            WAIT_V(8); WAIT_L(0); BAR; if constexpr (HV != 2) { MMA(0, 0, At, B0); MMA(0, 1, At, B1); } BAR; SCHED;
            if constexpr (HV != 1) LDA(At, 1, 1); STG_BR(SB(1, 0), b3, 4); STG_BR(SB(1, 1), b3 + hB, 5); STG_AR(SA(1, 0), a3, 0, last, 6);
            WAIT_V(8); WAIT_L(0); BAR; if constexpr (HV != 1) { MMA(1, 0, At, B0); MMA(1, 1, At, B1); } BAR; SCHED;
        }
        if (wr == 0) BAR;
        if constexpr (RESL) { if (!has_next) { WAIT_V(0); BAR; } }
        epilogue<PH, HV>(E, cur, acc, wr, wc, fr, fq, epre, lds, RESL && !has_next);
        if (!has_next) break;
#pragma unroll
        for (int a = 0; a < 2; ++a)
#pragma unroll
            for (int b = 0; b < 2; ++b)
#pragma unroll
                for (int m = 0; m < 4; ++m)
#pragma unroll
                    for (int n = 0; n < 2; ++n) acc[a][b][m][n] = (f32x4){0.f, 0.f, 0.f, 0.f};
        cur = nxt; cA = nA; cB = nB; ++ui;
        if (wr == 1) BAR;
    }
    WAIT_V(0);
    BAR;
#undef SA
#undef SB
#undef GLDS
#undef STG_A
#undef STG_B
#undef STG_BR
#undef STG_AR
#undef LDA
#undef LDB
#undef MMA
#undef WAIT_V
#undef WAIT_L
#undef BAR
#undef SCHED
#undef LOAD_IDX
#undef IDX_TO_VA
}

DI int crow(int r, int hi) { return (r & 3) + 8 * (r >> 2) + 4 * hi; }
typedef short v4i16_t __attribute__((ext_vector_type(4)));
DI s16x4 vtr(const LAS unsigned char* p) { return __builtin_bit_cast(s16x4, __builtin_amdgcn_ds_read_tr16_b64_v4i16((LAS v4i16_t*)p)); }
#define MFMA32(a, b, c) __builtin_amdgcn_mfma_f32_32x32x16_bf16((a), (b), (c), 0, 0, 0)
DI bf16x8 cat8(s16x4 lo, s16x4 hi) { return __builtin_shufflevector(lo, hi, 0, 1, 2, 3, 4, 5, 6, 7); }
DI bf16x8 pack8(float a0, float a1, float a2, float a3, float a4, float a5, float a6, float a7) {
    u32x4 w; w.x = pk2(a0, a1); w.y = pk2(a2, a3); w.z = pk2(a4, a5); w.w = pk2(a6, a7); return __builtin_bit_cast(bf16x8, w);
}
DI u32x4 widen_pair(u32x2 a, u32x2 b) {
    const auto r0 = __builtin_amdgcn_permlane32_swap(a.x, b.x, false, false);
    const auto r1 = __builtin_amdgcn_permlane32_swap(a.y, b.y, false, false);
    u32x4 w; w.x = r0[0]; w.y = r1[0]; w.z = r0[1]; w.w = r1[1]; return w;
}
DI void norm_store_unit(Frame& F, f32x16 (&ov)[4][2], int ql, int hh, unsigned char* dst0  ) {
    LAS float* xch = (LAS float*)(F.lds + SGP_OFF);
    __syncthreads();
#pragma unroll
    for (int blk = 0; blk < 4; ++blk) {
        float ss = 0.f;
#pragma unroll
        for (int d = 0; d < 2; ++d)
#pragma unroll
            for (int r = 0; r < 16; ++r) ss += ov[blk][d][r] * ov[blk][d][r];
        ss += __shfl_xor(ss, 32);
        if (hh == 0) xch[F.wave * 128 + 32 * blk + ql] = ss;
    }
    __syncthreads();
#pragma unroll
    for (int blk = 0; blk < 4; ++blk) {
        float tot = 0.f;
#pragma unroll
        for (int w = 0; w < 8; ++w) tot += xch[w * 128 + 32 * blk + ql];
        const float rstd = 1.0f / sqrtf(tot * (1.0f / 512.0f) + EPS);
#pragma unroll
        for (int d = 0; d < 2; ++d)
#pragma unroll
            for (int g = 0; g < 4; g += 2) {
                u32x2 wa, wb; wa.x = pk2(ov[blk][d][4 * g] * rstd, ov[blk][d][4 * g + 1] * rstd); wa.y = pk2(ov[blk][d][4 * g + 2] * rstd, ov[blk][d][4 * g + 3] * rstd);
                wb.x = pk2(ov[blk][d][4 * g + 4] * rstd, ov[blk][d][4 * g + 5] * rstd); wb.y = pk2(ov[blk][d][4 * g + 6] * rstd, ov[blk][d][4 * g + 7] * rstd);
                *(GAS u32x4*)(dst0 + (size_t)blk * 128 * 512 + (size_t)(4 * d + g + hh) * 512) = widen_pair(wa, wb);
            }
    }
}
DI void norm_store_512(Frame& F, f32x16 (&o)[2], int par, int ql, int hh, unsigned char* dst  ) {
    LAS float* xch = (LAS float*)(F.lds + XCH_OFF) + par * 256;
    float ss = 0.f;
#pragma unroll
    for (int d = 0; d < 2; ++d)
#pragma unroll
        for (int r = 0; r < 16; ++r) ss += o[d][r] * o[d][r];
    ss += __shfl_xor(ss, 32);
    if (hh == 0) xch[F.wave * 32 + ql] = ss;
    __syncthreads();
    float tot = 0.f;
#pragma unroll
    for (int w = 0; w < 8; ++w) tot += xch[w * 32 + ql];
    const float rstd = 1.0f / sqrtf(tot * (1.0f / 512.0f) + EPS);
#pragma unroll
    for (int d = 0; d < 2; ++d)
#pragma unroll
        for (int g = 0; g < 4; g += 2) {
            u32x2 wa, wb; wa.x = pk2(o[d][4 * g] * rstd, o[d][4 * g + 1] * rstd); wa.y = pk2(o[d][4 * g + 2] * rstd, o[d][4 * g + 3] * rstd);
            wb.x = pk2(o[d][4 * g + 4] * rstd, o[d][4 * g + 5] * rstd); wb.y = pk2(o[d][4 * g + 6] * rstd, o[d][4 * g + 7] * rstd);
            *(GAS u32x4*)(dst + (size_t)(4 * d + g + hh) * 512) = widen_pair(wa, wb);
        }
}

#if defined(TS_PHASE) && TS_PHASE >= 20
#define MSTAMP(k) do { __syncthreads(); if (F.tid == 0) ((volatile LAS unsigned long long*)(F.lds + MISC_OFF + 64))[k] = __builtin_amdgcn_s_memrealtime(); } while (0)
#else
#define MSTAMP(k) do { } while (0)
#endif
DI void attn_unit(Frame& F, int b, int n) {
    if (F.wave >= 4) __builtin_amdgcn_s_setprio(1);
    int tid = F.tid; asm volatile("" : "+v"(tid));
    const int lane = tid & 63, ql = lane & 31, hh = lane >> 5;
    const int t0 = b * SEQ + n * 128;
    const bf16_t* PJ = (const bf16_t*)(F.ws + WS_RB);
    bf16_t* MX = (bf16_t*)(F.ws + WS_RC);
    LAS unsigned char* lds = F.lds;
    const int h = F.wave, kvh = h >> 2;
    bf16x8 qfa[4][4];
#pragma unroll
    for (int i = 0; i < 4; ++i) { const unsigned char* qp = F.ws + WS_RD + ((size_t)((t0 >> 5) + i) * 128 + 8 * h + hh) * 512 + ql * 16;
#pragma unroll
        for (int ks = 0; ks < 4; ++ks) qfa[i][ks] = __builtin_nontemporal_load((const GAS bf16x8*)(qp + (size_t)(2 * ks) * 512)); }
    __syncthreads();
#pragma unroll 8
    for (int j = 0; j < 16; ++j) {
        const int p = tid + NTHR * j, row = p >> 5, c = p & 31;
        int tok = t0 - 128 + row; if (n == 0 && row < 128) tok = t0;
        const u32x4 v = *(const GAS u32x4*)(PJ + (size_t)tok * PJW + 8 * c);
        int addr;
        if (c < 16) { const int kvh = c >> 3, ch = c & 7; addr = kvh * 32768 + row * 128 + ((ch ^ ((row >> 1) & 7)) << 4); }
        else { const int cc = c - 16, kvh = cc >> 3, ch = cc & 7; addr = 65536 + kvh * 32768 + (ch >> 2) * 16384 + row * 64 + (ch & 3) * 16; }
        *(LAS u32x4*)(lds + addr) = v;
    }
    __syncthreads();
    const float sinkv = F.in[I_SINKS][h] * 1.4426950408889634f;
    const LAS unsigned char* Kb = lds + kvh * 32768;
    const LAS unsigned char* Vb = lds + 65536 + kvh * 32768;
    const int vtr_off = ((lane & 15) >> 2) * 64 + (16 * ((lane >> 4) & 1) + 4 * (lane & 3)) * 2;
#pragma unroll
    for (int i = 0; i < 4; ++i) {
        const bf16x8* qf = qfa[i];
        f32x16 s[5];
#pragma unroll
        for (int jt = 0; jt < 5; ++jt) {
            const int key = 32 * (i + jt) + ql;
            f32x16 a = {};
#pragma unroll
            for (int ks = 0; ks < 4; ++ks) {
                const bf16x8 kf = *(const LAS bf16x8*)(Kb + key * 128 + (((2 * ks + hh) ^ ((key >> 1) & 7)) << 4));
                a = MFMA32(kf, qf[ks], a);
            }
            s[jt] = a;
        }
        float m = sinkv;
#pragma unroll
        for (int jt = 0; jt < 5; ++jt) {
            const bool tile_ok = (n != 0) || (i + jt >= 4);
#pragma unroll
            for (int r = 0; r < 16; ++r) {
                const int c = crow(r, hh);
                bool ok = tile_ok;
                if (jt == 0) ok = ok && (c > ql);
                if (jt == 4) ok = ok && (c <= ql);
                const float v = ok ? s[jt][r] : -INFINITY;
                s[jt][r] = v; m = fmaxf(m, v);
            }
        }
        m = fmaxf(m, __shfl_xor(m, 32));
        float l = 0.f;
#pragma unroll
        for (int jt = 0; jt < 5; ++jt)
#pragma unroll
            for (int r = 0; r < 16; ++r) { const float p = __builtin_amdgcn_exp2f(s[jt][r] - m); s[jt][r] = p; l += p; }
        l += __shfl_xor(l, 32);
        l += __builtin_amdgcn_exp2f(sinkv - m);
        f32x16 o[2]; o[0] = f32x16{}; o[1] = f32x16{};
#pragma unroll
        for (int jt = 0; jt < 5; ++jt)
#pragma unroll
            for (int s2 = 0; s2 < 2; ++s2) {
                const bf16x8 pf = pack8(s[jt][8 * s2], s[jt][8 * s2 + 1], s[jt][8 * s2 + 2], s[jt][8 * s2 + 3], s[jt][8 * s2 + 4], s[jt][8 * s2 + 5], s[jt][8 * s2 + 6], s[jt][8 * s2 + 7]);
                const int k0 = 32 * (i + jt) + 16 * s2 + 4 * hh;
#pragma unroll
                for (int d = 0; d < 2; ++d) {
                    const LAS unsigned char* vp = Vb + d * 16384 + k0 * 64 + vtr_off;
                    const s16x4 lo = vtr(vp), hi = vtr(vp + 8 * 64);
                    o[d] = MFMA32(cat8(lo, hi), pf, o[d]);
                }
            }
        const float inv = 1.0f / l;
#pragma unroll
        for (int d = 0; d < 2; ++d)
#pragma unroll
            for (int r = 0; r < 16; ++r) o[d][r] *= inv;
        norm_store_512(F, o, i & 1, ql, hh, (unsigned char*)MX + ((size_t)((t0 >> 5) + i) * 128 + 8 * h) * 512 + ql * 16);
    }
    __builtin_amdgcn_s_setprio(0);
}

DI void sgu_unit(Frame& F, int b, int n) {
    int tid = F.tid; asm volatile("" : "+v"(tid));
    const int lane = tid & 63, ql = lane & 31, hh = lane >> 5, gi = F.wave;
    const int t0 = b * SEQ + n * 128;
    const bf16_t* PJ = (const bf16_t*)(F.ws + WS_RB);
    bf16_t* MX = (bf16_t*)(F.ws + WS_RC);
    LAS unsigned char* lds = F.lds;
    LAS float* sgp = (LAS float*)(lds + SGP_OFF);
    LAS float* sgr = (LAS float*)(lds + SGR_OFF);
    __syncthreads();
    MSTAMP(22);
    u32x4 gv[16];
    const int ch = lane & 7;
#pragma unroll
    for (int L = 0; L < 16; ++L) {
        const int tok = 8 * L + (lane >> 3);
        gv[L] = __builtin_nontemporal_load((const GAS u32x4*)(PJ + (size_t)(t0 + tok) * PJW + 256 + 64 * gi + 8 * ch));
    }
#pragma unroll
    for (int L = 0; L < 16; ++L) {
        const int tok = 8 * L + (lane >> 3);
        float ss = 0.f;
#pragma unroll
        for (int e = 0; e < 4; ++e) { const float a = bflo(gv[L][e]), c = bfhi(gv[L][e]); ss += a * a + c * c; }
        ss += __shfl_xor(ss, 1); ss += __shfl_xor(ss, 2); ss += __shfl_xor(ss, 4);
        if (ch == 0) sgp[gi * 128 + tok] = ss;
    }
    __syncthreads();
    if (tid < 128) { float tot = 0.f;
#pragma unroll
        for (int g = 0; g < 8; ++g) tot += sgp[g * 128 + tid];
        sgr[tid] = 1.0f / sqrtf(tot * (1.0f / 512.0f) + EPS); }
    __syncthreads();
    MSTAMP(23);
    float gn[8];
    { const f32x4 a = *(const f32x4*)(F.in[I_SGU_NORM] + 64 * gi + 8 * ch), c = *(const f32x4*)(F.in[I_SGU_NORM] + 64 * gi + 8 * ch + 4);
      gn[0] = a[0]; gn[1] = a[1]; gn[2] = a[2]; gn[3] = a[3]; gn[4] = c[0]; gn[5] = c[1]; gn[6] = c[2]; gn[7] = c[3]; }
    LAS unsigned char* vcb = lds + gi * 16384;
#pragma unroll
    for (int L = 0; L < 16; ++L) {
        const int tok = 8 * L + (lane >> 3);
        const float r = sgr[tok];
        u32x4 w;
#pragma unroll
        for (int e = 0; e < 4; ++e) w[e] = pk2(bflo(gv[L][e]) * r * gn[2 * e], bfhi(gv[L][e]) * r * gn[2 * e + 1]);
        *(LAS u32x4*)(vcb + (ch >> 2) * 8192 + tok * 64 + (ch & 3) * 16) = w;
    }
    LDS_WAIT();
    __syncthreads();
    MSTAMP(24);
    const bf16_t* Wg = (const bf16_t*)(F.ws + WS_WRT + 512 * 1024) + (size_t)gi * 128 * 128;
    const float* bias = F.in[I_SGU_B] + gi * 128;
    const int vtr_off = ((lane & 15) >> 2) * 64 + (16 * ((lane >> 4) & 1) + 4 * (lane & 3)) * 2;
    f32x16 ov[4][2];
#pragma unroll
    for (int ib = 0; ib < 4; ++ib) {
        const int it = 32 * ib + ql;
        f32x16 a[2]; a[0] = f32x16{}; a[1] = f32x16{};
        const float bi = bias[it];
        const unsigned char* up = F.ws + WS_RD + ((size_t)((t0 >> 5) + ib) * 128 + 64 + 8 * gi) * 512 + ql * 16 + 8 * hh;
        u32x2 uw[2][4];
#pragma unroll
        for (int d = 0; d < 2; ++d)
#pragma unroll
            for (int g = 0; g < 4; ++g) uw[d][g] = __builtin_nontemporal_load((const GAS u32x2*)(up + (size_t)(4 * d + g) * 512));
        bf16x8 wfr[8];
#pragma unroll
        for (int js = 0; js < 2 * (ib + 1); ++js) wfr[js] = *(const GAS bf16x8*)(Wg + (size_t)it * 128 + 16 * js + 8 * hh);
        s16x4 vlo[8][2], vhi[8][2];
#pragma unroll
        for (int js = 0; js < 2 * (ib + 1); ++js)
#pragma unroll
            for (int d = 0; d < 2; ++d) { const LAS unsigned char* vp = vcb + d * 8192 + (16 * js + 8 * hh) * 64 + vtr_off; vlo[js][d] = vtr(vp); vhi[js][d] = vtr(vp + 4 * 64); }
#pragma unroll
        for (int js = 0; js < 2 * (ib + 1); ++js)
#pragma unroll
            for (int d = 0; d < 2; ++d) a[d] = MFMA32(cat8(vlo[js][d], vhi[js][d]), wfr[js], a[d]);
#pragma unroll
        for (int d = 0; d < 2; ++d)
#pragma unroll
            for (int g = 0; g < 4; ++g) {
                const u32x2 uu = uw[d][g];
                a[d][4 * g] = bflo(uu.x) * (a[d][4 * g] + bi); a[d][4 * g + 1] = bfhi(uu.x) * (a[d][4 * g + 1] + bi);
                a[d][4 * g + 2] = bflo(uu.y) * (a[d][4 * g + 2] + bi); a[d][4 * g + 3] = bfhi(uu.y) * (a[d][4 * g + 3] + bi);
            }
        ov[ib][0] = a[0]; ov[ib][1] = a[1];
        asm volatile("" ::: "memory");
    }
    MSTAMP(25);
    norm_store_unit(F, ov, ql, hh, (unsigned char*)MX + ((size_t)(t0 >> 5) * 128 + 64 + 8 * gi) * 512 + ql * 16);
    MSTAMP(26);
}

DI void mix_phase(Frame& F) {
    { const int i = F.bid * NTHR + F.tid;
      if (i < NMEM * 4 * 8) { const int piece = i & 7, kh = i >> 3, key = kh >> 2, h = kh & 3;
          const f32x4 p = *(const f32x4*)((const float*)(F.ws + WS_SSQK) + (size_t)kh * 4);
          const float r = 1.0f / sqrtf(((p[0] + p[1]) + (p[2] + p[3])) * (1.0f / 256.0f) + EPS);
          GAS u32x4* kp = (GAS u32x4*)((bf16_t*)(F.ws + WS_KMEM) + (size_t)key * D + h * 256 + piece * 32);
#pragma unroll
          for (int q = 0; q < 4; ++q) { u32x4 v = kp[q];
#pragma unroll
              for (int e = 0; e < 4; ++e) v[e] = pk2(bflo(v[e]) * r, bfhi(v[e]) * r);
              kp[q] = v; } } }
    MSTAMP(20);
    for (int uidx = F.bid; uidx < 256; uidx += F.G) attn_unit(F, uidx >> 5, uidx & 31);
    MSTAMP(21);
    for (int uidx = F.bid; uidx < 256; uidx += F.G) sgu_unit(F, uidx >> 5, uidx & 31);
    MSTAMP(27);
}

DI void xattn_unit(Frame& F, int pm, int pn) {
    if (F.wave >= 4) __builtin_amdgcn_s_setprio(1);
    int tid = F.tid; asm volatile("" : "+v"(tid));
    const int lane = tid & 63, ql = lane & 31, hh = lane >> 5, w = F.wave;
    const int b = pm >> 4, h = pn;
    const size_t row = (size_t)pm * 256 + 32 * w + ql;
    LAS unsigned char* lds = F.lds;
    const bf16_t* QC = (const bf16_t*)(F.ws + WS_RB);
    bf16x8 qf[16];
#pragma unroll
    for (int ks = 0; ks < 16; ++ks) qf[ks] = __builtin_nontemporal_load((const GAS bf16x8*)(QC + row * D + h * 256 + 16 * ks + 8 * hh));
    const f32x4 pq = *(const f32x4*)((const float*)(F.ws + WS_SSQQ) + (row * 4 + h) * 4);
    const float rq = (0.0625f * 1.4426950408889634f) / sqrtf(((pq[0] + pq[1]) + (pq[2] + pq[3])) * (1.0f / 256.0f) + EPS);
    __syncthreads();
    { const bf16_t* KM = (const bf16_t*)(F.ws + WS_KMEM) + (size_t)(b * MEML) * D + h * 256;
#pragma unroll 8
      for (int j = 0; j < 16; ++j) { const int p = tid + NTHR * j, key = p >> 5, c = p & 31;
          const u32x4 v = *(const GAS u32x4*)(KM + (size_t)key * D + 8 * c);
          *(LAS u32x4*)(lds + key * 512 + ((c ^ (key & 15)) << 4)) = v; } }
    __syncthreads();
    f32x16 s[8];
#pragma unroll
    for (int kt = 0; kt < 8; ++kt) {
        const int key = 32 * kt + ql;
        f32x16 a = {};
#pragma unroll
        for (int ks = 0; ks < 16; ++ks) {
            const bf16x8 kf = *(const LAS bf16x8*)(lds + key * 512 + (((2 * ks + hh) ^ (key & 15)) << 4));
            a = MFMA32(kf, qf[ks], a);
        }
        s[kt] = a;
    }
    float m = -INFINITY;
#pragma unroll
    for (int kt = 0; kt < 8; ++kt)
#pragma unroll
        for (int r = 0; r < 16; ++r) { s[kt][r] *= rq; m = fmaxf(m, s[kt][r]); }
    m = fmaxf(m, __shfl_xor(m, 32));
    float l = 0.f;
#pragma unroll
    for (int kt = 0; kt < 8; ++kt)
#pragma unroll
        for (int r = 0; r < 16; ++r) { const float p = __builtin_amdgcn_exp2f(s[kt][r] - m); s[kt][r] = p; l += p; }
    l += __shfl_xor(l, 32);
    bf16x8 pf[8][2];
#pragma unroll
    for (int kt = 0; kt < 8; ++kt)
#pragma unroll
        for (int s2 = 0; s2 < 2; ++s2)
            pf[kt][s2] = pack8(s[kt][8 * s2], s[kt][8 * s2 + 1], s[kt][8 * s2 + 2], s[kt][8 * s2 + 3], s[kt][8 * s2 + 4], s[kt][8 * s2 + 5], s[kt][8 * s2 + 6], s[kt][8 * s2 + 7]);
    __syncthreads();
    { const bf16_t* VM = (const bf16_t*)(F.ws + WS_VMT) + (size_t)(b * MEML) * D + h * 256;
#pragma unroll 8
      for (int j = 0; j < 16; ++j) { const int p = tid + NTHR * j, key = p >> 5, c = p & 31;
          const u32x4 v = *(const GAS u32x4*)(VM + (size_t)key * D + 8 * c);
          *(LAS u32x4*)(lds + (c >> 2) * 16384 + key * 64 + (c & 3) * 16) = v; } }
    __syncthreads();
    const int vtr_off = ((lane & 15) >> 2) * 64 + (16 * ((lane >> 4) & 1) + 4 * (lane & 3)) * 2;
    const float inv = 1.0f / l;
    unsigned char* OC16 = F.ws + WS_RD + ((size_t)(pm * 8 + w) * 128 + h * 32) * 512 + ql * 16;
#pragma unroll
    for (int d = 0; d < 8; ++d) {
        f32x16 o = {};
#pragma unroll
        for (int kt = 0; kt < 8; ++kt)
#pragma unroll
            for (int s2 = 0; s2 < 2; ++s2) {
                const LAS unsigned char* vp = lds + d * 16384 + (32 * kt + 16 * s2 + 4 * hh) * 64 + vtr_off;
                const s16x4 lo = vtr(vp), hi = vtr(vp + 8 * 64);
                o = MFMA32(cat8(lo, hi), pf[kt][s2], o);
            }
#pragma unroll
        for (int g = 0; g < 4; g += 2) {
            u32x2 wa, wb; wa.x = pk2(o[4 * g] * inv, o[4 * g + 1] * inv); wa.y = pk2(o[4 * g + 2] * inv, o[4 * g + 3] * inv);
            wb.x = pk2(o[4 * g + 4] * inv, o[4 * g + 5] * inv); wb.y = pk2(o[4 * g + 6] * inv, o[4 * g + 7] * inv);
            *(GAS u32x4*)(OC16 + (size_t)(4 * d + g + hh) * 512) = widen_pair(wa, wb);
        }
    }
    __builtin_amdgcn_s_setprio(0);
}
DI void xattn_phase(Frame& F) {
    for (int i = 0; i < 2; ++i) {
        const int L = i * F.G + F.bid; if (L >= 512) break;
        const int wg = xcd_remap(L, 512); int pm, pn; grouped_tile(wg, 128, 4, pm, pn);
        xattn_unit(F, pm, pn);
    }
    asm volatile("s_waitcnt vmcnt(0)" ::: "memory"); __syncthreads();
}

DI void route_phase(Frame& F, bool dummy) {
    const int lane = F.lane, tr = lane & 15, kq = lane >> 4, w = F.wave;
    const bf16_t* WRP = (const bf16_t*)(F.ws + WS_WRT);
    unsigned* cnt = (unsigned*)(F.ws + WS_CTL) + CW_CNT + (dummy ? 4096 : 0);
    int* LT = (int*)(F.ws + (dummy ? WS_RD : WS_LTOK)); float* LG = (float*)(F.ws + (dummy ? WS_RD + 8 * MiB : WS_LGATE)); float* LR = (float*)(F.ws + (dummy ? WS_RD + 16 * MiB : WS_LRSTD));
    LAS float* red = (LAS float*)(F.lds);
    LAS float* lgs = (LAS float*)(F.lds + 98304);
    LAS float* ssp = (LAS float*)(F.lds + 98304 + 25600);
    LAS unsigned* hist = (LAS unsigned*)(F.lds + 98304 + 25600 + 4096);
    bf16x8 bfr[4][3][2];
#pragma unroll
    for (int sp = 0; sp < 4; ++sp)
#pragma unroll
        for (int nb = 0; nb < 3; ++nb)
#pragma unroll
            for (int hl = 0; hl < 2; ++hl) bfr[sp][nb][hl] = *(const GAS bf16x8*)(WRP + ((size_t)(((4 * w + sp) * 3 + nb) * 2 + hl) * 64 + lane) * 8);
    for (int chunk = F.bid; chunk < T / 128; chunk += F.G) {
        __syncthreads();
        if (F.tid < 128) hist[F.tid] = 0u;
        const int tok0 = chunk * 128;
        const bf16_t* xbase = (const bf16_t*)(F.ws + WS_RC) + (size_t)(tok0 + tr) * D + 128 * w + 8 * kq;
        u32x4 xc[2][4], xn[2][4];
#pragma unroll
        for (int tq = 0; tq < 2; ++tq)
#pragma unroll
            for (int sp = 0; sp < 4; ++sp) xc[tq][sp] = *(const GAS u32x4*)(xbase + (size_t)(16 * tq) * D + 32 * sp);
#pragma unroll 1
        for (int half = 0; half < 4; ++half) {
            f32x4 acc[2][3];
            { const int hn = (half < 3) ? half + 1 : half;
#pragma unroll
              for (int tq = 0; tq < 2; ++tq)
#pragma unroll
                for (int sp = 0; sp < 4; ++sp) xn[tq][sp] = *(const GAS u32x4*)(xbase + (size_t)(16 * (2 * hn + tq)) * D + 32 * sp); }
#pragma unroll
            for (int tq = 0; tq < 2; ++tq) {
                const int tb = 2 * half + tq;
                float ss = 0.f;
                acc[tq][0] = (f32x4){0.f, 0.f, 0.f, 0.f}; acc[tq][1] = acc[tq][0]; acc[tq][2] = acc[tq][0];
#pragma unroll
                for (int sp = 0; sp < 4; ++sp) {
                    const u32x4 xw = xc[tq][sp];
#pragma unroll
                    for (int e = 0; e < 4; ++e) { const float a0 = bflo(xw[e]), a1 = bfhi(xw[e]); ss += a0 * a0 + a1 * a1; }
                    const bf16x8 ah = __builtin_bit_cast(bf16x8, xw);
#pragma unroll
                    for (int nb = 0; nb < 3; ++nb) {
                        acc[tq][nb] = __builtin_amdgcn_mfma_f32_16x16x32_bf16(ah, bfr[sp][nb][0], acc[tq][nb], 0, 0, 0);
                        acc[tq][nb] = __builtin_amdgcn_mfma_f32_16x16x32_bf16(ah, bfr[sp][nb][1], acc[tq][nb], 0, 0, 0);
                    }
                }
                ss += __shfl_xor(ss, 16); ss += __shfl_xor(ss, 32);
                if (kq == 0) ssp[w * 128 + 16 * tb + tr] = ss;
            }
#pragma unroll
            for (int tq = 0; tq < 2; ++tq)
#pragma unroll
                for (int sp = 0; sp < 4; ++sp) xc[tq][sp] = xn[tq][sp];
#pragma unroll
            for (int tq = 0; tq < 2; ++tq)
#pragma unroll
                for (int nb = 0; nb < 3; ++nb)
#pragma unroll
                    for (int r = 0; r < 4; ++r) red[w * 1536 + ((tq * 3 + nb) * 4 + r) * 64 + lane] = acc[tq][nb][r];
            __syncthreads();
#pragma unroll
            for (int q = 0; q < 3; ++q) {
                const int e = F.tid + 512 * q, idx = e >> 6, ln = e & 63;
                float sum = 0.f;
#pragma unroll
                for (int ww = 0; ww < 8; ++ww) sum += red[ww * 1536 + e];
                const int r = idx & 3, nb = (idx >> 2) % 3, tq = idx / 12;
                lgs[(16 * (2 * half + tq) + 4 * (ln >> 4) + r) * 49 + 16 * nb + (ln & 15)] = sum;
            }
            __syncthreads();
        }
        __syncthreads();
        int re1 = 0, re2 = 0; float g1 = 0.f, g2 = 0.f, rstd = 0.f; unsigned s1 = 0, s2 = 0;
        const int t = F.tid;
        if (t < 128) {
            float ss = 0.f;
#pragma unroll
            for (int q = 0; q < 8; ++q) ss += ssp[q * 128 + t];
            rstd = 1.0f / sqrtf(ss * (1.0f / D) + EPS);
            float lg[36];
#pragma unroll
            for (int e = 0; e < 36; ++e) lg[e] = lgs[t * 49 + e] * rstd;
            float gmax = lg[0]; int gi = 0;
#pragma unroll
            for (int j = 1; j < 4; ++j) if (lg[j] > gmax) { gmax = lg[j]; gi = j; }
            float den = 0.f;
#pragma unroll
            for (int j = 0; j < 4; ++j) den += __expf(lg[j] - gmax);
            const float gwt = 1.0f / den;
            float le[8];
#pragma unroll
            for (int e = 0; e < 8; ++e) le[e] = gi == 0 ? lg[4 + e] : (gi == 1 ? lg[12 + e] : (gi == 2 ? lg[20 + e] : lg[28 + e]));
            float t1 = le[0]; int i1 = 0;
#pragma unroll
            for (int e = 1; e < 8; ++e) if (le[e] > t1) { t1 = le[e]; i1 = e; }
            float t2 = -INFINITY; int i2 = 0;
#pragma unroll
            for (int e = 0; e < 8; ++e) if (e != i1 && le[e] > t2) { t2 = le[e]; i2 = e; }
            const float ex = __expf(t2 - t1), p1 = 1.0f / (1.0f + ex), p2 = ex * p1;
            re1 = gi * 8 + i1; re2 = gi * 8 + i2; g1 = p1 * gwt; g2 = p2 * gwt;
            s1 = __hip_atomic_fetch_add(hist + re1, 1u, __ATOMIC_RELAXED, __HIP_MEMORY_SCOPE_WORKGROUP); s2 = __hip_atomic_fetch_add(hist + re2, 1u, __ATOMIC_RELAXED, __HIP_MEMORY_SCOPE_WORKGROUP);
        }
        __syncthreads();
        if (t < 64) { const unsigned c = hist[t]; hist[64 + t] = c ? __hip_atomic_fetch_add(cnt + 64 * t, c, RLX_AGENT) : 0u; }
        __syncthreads();
        if (t < 128) {
            const size_t p1 = (size_t)re1 * CAP + hist[64 + re1] + s1, p2 = (size_t)re2 * CAP + hist[64 + re2] + s2;
            LT[p1] = 2 * (tok0 + t); LG[p1] = g1; LR[p1] = rstd;
            LT[p2] = 2 * (tok0 + t) + 1; LG[p2] = g2; LR[p2] = rstd;
        }
    }
}
DI void build_tile_table(Frame& F) {
    LAS int* tbl = (LAS int*)(F.lds + TBL_OFF);
    unsigned* cnt = (unsigned*)(F.ws + WS_CTL) + CW_CNT;
    __syncthreads();
    if (F.tid < 64) tbl[F.tid] = (F.tid < 32) ? (int)__hip_atomic_load(cnt + 64 * F.tid, RLX_AGENT) : 0;
    __syncthreads();
    if (F.tid == 0) { int a = 0; for (int j = 0; j < 64; ++j) { tbl[64 + j] = a; a += (tbl[j] + 255) >> 8; } tbl[128] = a; }
    __syncthreads();
}

DI void final_phase(Frame& F) {
    const bf16_t* C0 = (const bf16_t*)(F.ws + WS_RB); const bf16_t* C1 = (const bf16_t*)(F.ws + WS_RA); const bf16_t* X2 = (const bf16_t*)(F.ws + WS_RC);
    const size_t n8 = (size_t)T * D / 8;
    for (size_t i = (size_t)F.bid * NTHR + F.tid; i < n8; i += (size_t)F.G * NTHR) {
        const u32x4 a = __builtin_nontemporal_load((const GAS u32x4*)(C0 + i * 8)), b = __builtin_nontemporal_load((const GAS u32x4*)(C1 + i * 8)), x = __builtin_nontemporal_load((const GAS u32x4*)(X2 + i * 8));
        GAS f32x4* o = (GAS f32x4*)(F.out + i * 8);
        f32x4 o0, o1;
        o0[0] = bflo(x.x) + (bflo(a.x) + bflo(b.x)); o0[1] = bfhi(x.x) + (bfhi(a.x) + bfhi(b.x)); o0[2] = bflo(x.y) + (bflo(a.y) + bflo(b.y)); o0[3] = bfhi(x.y) + (bfhi(a.y) + bfhi(b.y));
        o1[0] = bflo(x.z) + (bflo(a.z) + bflo(b.z)); o1[1] = bfhi(x.z) + (bfhi(a.z) + bfhi(b.z)); o1[2] = bflo(x.w) + (bflo(a.w) + bflo(b.w)); o1[3] = bfhi(x.w) + (bfhi(a.w) + bfhi(b.w));
        __builtin_nontemporal_store(o0, o); __builtin_nontemporal_store(o1, o + 1);
    }
}

__global__ void __launch_bounds__(NTHR, 2) fwd_kernel(Args args) {
    extern __shared__ __attribute__((aligned(16))) unsigned char lds_raw[];
    Frame F;
    F.lds = (LAS unsigned char*)lds_raw;
    F.ws = args.ws; F.out = args.out; F.in = args.in;
    F.tid = threadIdx.x; F.lane = F.tid & 63; F.wave = __builtin_amdgcn_readfirstlane(F.tid >> 6);
    F.G = gridDim.x; F.bid = blockIdx.x;
    for (int u = F.tid; u < (LDS_BYTES - LDSCTL_OFF) / 4; u += NTHR) ((LAS unsigned*)(F.lds + LDSCTL_OFF))[u] = 0u;
    __syncthreads();
    unsigned* ctl = (unsigned*)(args.ws + WS_CTL);
    const int lo = args.ph_lo, hi = args.ph_hi;
    XcdBarrier bar; bar.bar = ctl + CW_BAR; bar.x = 0; bar.st = nullptr;
    if (hi - lo > 1) bar = xcd_barrier_post(ctl + CW_BAR, (volatile LAS unsigned*)(F.lds + MISC_OFF) + 8);
    Sched S; S.G = F.G; S.c = F.bid; S.ws = F.ws; S.tbl = (const LAS int*)(F.lds + TBL_OFF); S.round = 0;
    EpiCtx E; E.ws = F.ws; E.out = F.out; E.in = F.in;
#define IN(k) (lo <= (k) && (k) < hi)
#define SEAM(k) do { if (IN(k) && IN((k) + 1)) xcd_barrier(bar); } while (0)
#ifndef DUP_PHASE
#define DUP_PHASE -1
#endif
#ifndef TS_UNIT
#define TS_UNIT 100
#endif
#if TS_PHASE >= 0
    volatile LAS unsigned long long* tsw = (volatile LAS unsigned long long*)(F.lds + MISC_OFF + 64);
#define STAMP(k) do { if (F.tid == 0) tsw[k] = __builtin_amdgcn_s_memrealtime(); } while (0)
#else
#define STAMP(k) do { } while (0)
#endif
    STAMP(0);
#define RUNPH(k, body) do { if (IN(k)) { const int nrep_ = (DUP_PHASE == (k)) ? 2 + (lo >> 20) : 1; for (int rep_ = 0; rep_ < nrep_; ++rep_) { if (rep_) xcd_barrier(bar); body; } } SEAM(k); STAMP((k) + 1); } while (0)
    RUNPH(PH_P0, p0_prologue(F));
#if DUP_PHASE == 100
    for (int i = 0; i < 4; ++i) xcd_barrier(bar);
#endif
    RUNPH(PH_PROJ, { gemm_phase<PH_PROJ>(F.lds, S, E); gemm_phase<PH_MEMK>(F.lds, S, E); gemm_phase<PH_MEMV>(F.lds, S, E); });
    RUNPH(PH_MIX, mix_phase(F));
    RUNPH(PH_WOUT, gemm_phase<PH_WOUT>(F.lds, S, E));
    RUNPH(PH_WCQ, { gemm_phase<PH_WCQ>(F.lds, S, E); xattn_phase(F); });
    STAMP(PH_SC + 1); STAMP(PH_PV + 1);
    RUNPH(PH_WCO, gemm_phase<PH_WCO>(F.lds, S, E));
    RUNPH(PH_ROUTE, route_phase(F, rep_ + 1 < nrep_));
    RUNPH(PH_UP, { build_tile_table(F); gemm_phase<PH_UP>(F.lds, S, E); (gemm_phase<PH_UP, 1>)(F.lds, S, E); (gemm_phase<PH_UP, 2>)(F.lds, S, E); });
    RUNPH(PH_DOWN0, { build_tile_table(F); gemm_phase<PH_DOWN0>(F.lds, S, E); (gemm_phase<PH_DOWN0, 1>)(F.lds, S, E); (gemm_phase<PH_DOWN0, 2>)(F.lds, S, E); });
    RUNPH(PH_DOWN1, final_phase(F));
#if TS_PHASE >= 0
    xcd_barrier(bar);
    if (F.bid == 0 && F.tid == 0) { const unsigned long long dt = (TS_PHASE == 30 ? (tsw[PH_N] - tsw[0]) : (tsw[TS_PHASE + 1] - tsw[TS_PHASE])) / TS_UNIT; F.out[0] += (float)(dt > 250ull ? 250ull : dt); }
#endif
#undef RUNPH
#undef IN
#undef SEAM
}

#ifndef N_LAUNCH_MODE
#define N_LAUNCH_MODE 1
#endif
extern "C" void kernel_launch(void* const* d_in, const int* in_sizes, int n_in, void* d_out, int out_size, void* d_ws, size_t ws_size, hipStream_t stream) {
    static int grid = 0;
    if (grid == 0) {
        if (n_in != 27 || out_size != T * D || ws_size < WS_END) { fprintf(stderr, "kernel_launch: unexpected shapes (n_in %d out %d ws %zu)\n", n_in, out_size, ws_size); grid = -1; return; }
        int dev = 0, cus = 0, per_cu = 0;
        if (hipGetDevice(&dev) != hipSuccess || hipDeviceGetAttribute(&cus, hipDeviceAttributeMultiprocessorCount, dev) != hipSuccess) { grid = -1; return; }
        if (hipFuncSetAttribute((const void*)fwd_kernel, hipFuncAttributeMaxDynamicSharedMemorySize, LDS_BYTES) != hipSuccess) { fprintf(stderr, "kernel_launch: hipFuncSetAttribute failed\n"); grid = -1; return; }
        if (hipOccupancyMaxActiveBlocksPerMultiprocessor(&per_cu, (const void*)fwd_kernel, NTHR, LDS_BYTES) != hipSuccess || per_cu < 1) { fprintf(stderr, "kernel_launch: occupancy query says %d\n", per_cu); }
        (void)hipGetLastError();
        grid = cus;
    }
    if (grid < 0) return;
    (void)hipMemsetAsync((char*)d_ws + WS_CTL, 0, CTL_ZERO_BYTES, stream);
    Args a{};
    for (int i = 0; i < 27; ++i) a.in[i] = (const float*)d_in[i];
    a.out = (float*)d_out; a.ws = (unsigned char*)d_ws;
    if (N_LAUNCH_MODE == 1) { a.ph_lo = 0; a.ph_hi = PH_N; hipLaunchKernelGGL(fwd_kernel, dim3(grid), dim3(NTHR), LDS_BYTES, stream, a); }
    else for (int p = 0; p < PH_N; ++p) { a.ph_lo = p; a.ph_hi = p + 1; hipLaunchKernelGGL(fwd_kernel, dim3(grid), dim3(NTHR), LDS_BYTES, stream, a); }
}
```

```cpp
#include <hip/hip_runtime.h>
#include <hip/hip_bf16.h>
#include <cstdio>
#include <cstdint>

#define GAS __attribute__((address_space(1)))
#define LAS __attribute__((address_space(3)))
typedef unsigned short bf16_t;
typedef short bf16x8 __attribute__((ext_vector_type(8)));
typedef short s16x4 __attribute__((ext_vector_type(4)));
typedef float f32x4 __attribute__((ext_vector_type(4)));
typedef float f32x2 __attribute__((ext_vector_type(2)));
typedef float f32x16 __attribute__((ext_vector_type(16)));
typedef unsigned u32x4 __attribute__((ext_vector_type(4)));
typedef unsigned u32x2 __attribute__((ext_vector_type(2)));
typedef __bf16 bf16x2_t __attribute__((ext_vector_type(2)));
#define DI __device__ __forceinline__

#ifndef TS_PHASE
#define TS_PHASE -1
#endif
constexpr int T = 32768, D = 1024, BATCH = 8, SEQ = 4096, MEML = 256, NMEM = BATCH * MEML;
constexpr int INW = 1792;
constexpr int PJW = 768;
constexpr float EPS = 1e-6f;
constexpr int NWAVES = 8, NTHR = 512;
constexpr int CAP = 32768;
constexpr int MAXRT = 320;

constexpr size_t MiB = 1u << 20;
constexpr size_t WS_CTL = 0, CTL_ZERO_BYTES = 64 * 1024;
constexpr size_t WS_WRT = 1 * MiB;
constexpr size_t WS_SSQ1P = 2 * MiB;
constexpr size_t WS_SSQQ = 4 * MiB;
constexpr size_t WS_LSUM = 6 * MiB;
constexpr size_t WS_SSQK = 8 * MiB;
constexpr size_t WS_RSTDK = 8 * MiB + 512 * 1024;
constexpr size_t WS_RSTD0 = 9 * MiB;
constexpr size_t WS_LTOK = 10 * MiB, WS_LGATE = 18 * MiB, WS_LRSTD = 26 * MiB;
constexpr size_t WS_WIN = 34 * MiB, WS_WOUT = 38 * MiB, WS_WCQ = 40 * MiB, WS_WCK = 42 * MiB, WS_WCV = 44 * MiB, WS_WCO = 46 * MiB;
constexpr size_t WS_W13 = 48 * MiB, WS_W2 = 112 * MiB;
constexpr size_t WS_MEMB = 144 * MiB, WS_KMEM = 148 * MiB, WS_VMT = 152 * MiB;
constexpr size_t WS_RA = 156 * MiB;
constexpr size_t WS_RB = 220 * MiB;
constexpr size_t WS_RC = 332 * MiB;
constexpr size_t WS_RD = 396 * MiB;
constexpr size_t WS_END = 476 * MiB;
constexpr int CW_BAR = 4096, CW_CNT = 8192;

constexpr int RING_BYTES = 131072;
constexpr int LDS_BYTES = 147456;
constexpr int LDSCTL_OFF = RING_BYTES, MISC_OFF = LDS_BYTES - 256;
constexpr int TBL_OFF = RING_BYTES + 512;
constexpr int XCH_OFF = RING_BYTES + 2048;
constexpr int SGP_OFF = RING_BYTES + 4096;
constexpr int SGR_OFF = RING_BYTES + 8192;
constexpr int RT_XT_BYTES = 16 * 260 * 4;
constexpr int RT_HIST_OFF = 8 * RT_XT_BYTES;

#define RLX_AGENT __ATOMIC_RELAXED, __HIP_MEMORY_SCOPE_AGENT
#define LDS_WAIT() asm volatile("s_waitcnt lgkmcnt(0)" ::: "memory")
#define VM_WAIT() asm volatile("s_waitcnt vmcnt(0)" ::: "memory")
DI unsigned f2bf(float f) { unsigned u = __builtin_bit_cast(unsigned, f); return (u + 0x7fffu + ((u >> 16) & 1u)) >> 16; }
DI unsigned pk2(float lo, float hi) { f32x2 v = {lo, hi}; bf16x2_t b = __builtin_convertvector(v, bf16x2_t); return __builtin_bit_cast(unsigned, b); }
DI float bf2f(unsigned short h) { return __builtin_bit_cast(float, (unsigned)h << 16); }
DI float bflo(unsigned w) { return __builtin_bit_cast(float, w << 16); }
DI float bfhi(unsigned w) { return __builtin_bit_cast(float, w & 0xffff0000u); }
DI float wave_sum(float v) {
#pragma unroll
    for (int o = 1; o < 64; o <<= 1) v += __shfl_xor(v, o);
    return v;
}
DI float fast_exp(float x) { return __builtin_amdgcn_exp2f(x * 1.4426950408889634f); }
DI float gelu_tanh(float x) {
    const float z2 = 1.5957691216057308f * (x + 0.044715f * x * x * x);
    return x * __builtin_amdgcn_rcpf(1.0f + fast_exp(-z2));
}
DI float silu(float x) { return x * __builtin_amdgcn_rcpf(1.0f + fast_exp(-x)); }

#define XB_TMO      128
#define XB_XCNT(j)  (256  + 64 * (j))
#define XB_XSUB(j)  (1280 + 64 * (j))
#define XB_XGEN(j)  (2304 + 64 * (j))
#define XB_TOP      3328
#define XB_TOPGEN   3392
#define XCD_BAR_WORDS 3456
#define XB_SPIN_CAP (1u << 18)
DI unsigned xb_ld(unsigned* p)              { return __hip_atomic_load(p, __ATOMIC_RELAXED, __HIP_MEMORY_SCOPE_AGENT); }
DI unsigned xb_add(unsigned* p, unsigned v) { return __hip_atomic_fetch_add(p, v, __ATOMIC_RELAXED, __HIP_MEMORY_SCOPE_AGENT); }
DI unsigned xb_xcc_id() { return (unsigned)__builtin_amdgcn_s_getreg((3 << 11) | 20) & 0xFu; }
#define XB_SPIN(cond, bar) do { unsigned _sp = 0; while (cond) { __builtin_amdgcn_s_sleep(1); \
    if ((++_sp & 255u) == 0u) { if (xb_ld(&(bar)[XB_TMO])) break; if (_sp > XB_SPIN_CAP) { atomicAdd(&(bar)[XB_TMO], 1u); break; } } } } while (0)
struct XcdBarrier { unsigned* bar; unsigned x; volatile LAS unsigned* st; };
DI XcdBarrier xcd_barrier_post(unsigned* bar, volatile LAS unsigned* st) {
    XcdBarrier b; b.bar = bar; b.x = xb_xcc_id(); b.st = st;
    if (threadIdx.x == 0) (void)xb_add(&bar[XB_XCNT(b.x)], 1u);
    return b;
}
DI void xcd_barrier_complete(unsigned* bar, unsigned x, unsigned& nloc, unsigned& nx) {
    const unsigned G = gridDim.x * gridDim.y * gridDim.z;
    unsigned sum, cnt, mine, sp = 0u;
    for (;;) {
        sum = 0u; cnt = 0u; mine = 0u;
#pragma unroll
        for (unsigned j = 0; j < 16; ++j) { const unsigned c = xb_ld(&bar[XB_XCNT(j)]); sum += c; cnt += (c > 0u) ? 1u : 0u; mine = (j == x) ? c : mine; }
        if (sum == G) break;
        __builtin_amdgcn_s_sleep(1);
        if ((++sp & 255u) == 0u) { if (xb_ld(&bar[XB_TMO])) break; if (sp > XB_SPIN_CAP) { atomicAdd(&bar[XB_TMO], 1u); break; } }
    }
    nloc = mine > 0u ? mine : 1u; nx = cnt > 0u ? cnt : 1u;
}
DI void xcd_barrier(const XcdBarrier& b) {
    asm volatile("s_waitcnt vmcnt(0)" ::: "memory");
    __syncthreads();
    if (threadIdx.x == 0) {
        unsigned* bar = b.bar;
        __builtin_amdgcn_s_waitcnt(0);
        unsigned nloc = b.st[0], nx = b.st[1];
        if (nloc == 0u) { xcd_barrier_complete(bar, b.x, nloc, nx); b.st[0] = nloc; b.st[1] = nx; }
        const unsigned old = xb_add(&bar[XB_XSUB(b.x)], 1u);
        const unsigned gen = old / nloc;
        if (old + 1u == (gen + 1u) * nloc) {
            __builtin_amdgcn_fence(__ATOMIC_RELEASE, "agent");
            asm volatile("s_waitcnt vmcnt(0)" ::: "memory");
            const unsigned og = xb_add(&bar[XB_TOP], 1u);
            const unsigned tg = og / nx;
            if (og + 1u == (tg + 1u) * nx) xb_add(&bar[XB_TOPGEN], 1u);
            else XB_SPIN(xb_ld(&bar[XB_TOPGEN]) == tg, bar);
            __builtin_amdgcn_fence(__ATOMIC_ACQUIRE, "agent");
            xb_add(&bar[XB_XGEN(b.x)], 1u);
            asm volatile("s_waitcnt vmcnt(0)" ::: "memory");
        } else {
            XB_SPIN(xb_ld(&bar[XB_XGEN(b.x)]) == gen, bar);
            __builtin_amdgcn_fence(__ATOMIC_ACQUIRE, "agent");
            asm volatile("s_waitcnt vmcnt(0)" ::: "memory");
        }
    }
    __syncthreads();
}

struct Args {
    const float* in[27];
    float* out; unsigned char* ws;
    int ph_lo, ph_hi;
};
struct Frame {
    LAS unsigned char* lds;
    unsigned char* ws; float* out;
    int tid, lane, wave, G, bid;
    const float* const* in;
};
enum { I_X = 0, I_MEM, I_NORM_MIX, I_W_IN, I_Q_NORM, I_K_NORM, I_SINKS, I_SGU_NORM, I_SGU_W, I_SGU_B, I_ON_ATTN, I_ON_SGU, I_W_OUT,
       I_NORM_CROSS, I_NORM_MEM, I_W_CQ, I_W_CK, I_W_CV, I_CQ_NORM, I_CK_NORM, I_W_CO, I_NORM_FFN, I_WRG, I_WRE, I_W1, I_W3, I_W2 };

DI void p0_transpose_item(const float* W, int N, bf16_t* WT, int ldt, int row_off, const float* gain, LAS unsigned* scr, int kb, int nb, int lane) {
    const int k0 = 64 * kb, n0 = 64 * nb, c = lane & 15, kp = lane >> 4;
    f32x4 va[8], vb[8];
#pragma unroll
    for (int i = 0; i < 8; ++i) { const int kk = 2 * (kp + 4 * i);
        va[i] = __builtin_nontemporal_load((const GAS f32x4*)(W + (size_t)(k0 + kk) * N + n0 + 4 * c)); vb[i] = __builtin_nontemporal_load((const GAS f32x4*)(W + (size_t)(k0 + kk + 1) * N + n0 + 4 * c)); }
#pragma unroll
    for (int i = 0; i < 8; ++i) { const int kk = 2 * (kp + 4 * i);
        float ga = 1.f, gb = 1.f; if (gain) { ga = gain[k0 + kk]; gb = gain[k0 + kk + 1]; }
#pragma unroll
        for (int e = 0; e < 4; ++e) scr[(4 * c + e) * 33 + (kp + 4 * i)] = pk2(va[i][e] * ga, vb[i][e] * gb); }
    LDS_WAIT(); asm volatile("" ::: "memory");
    const int ch = lane & 7;
#pragma unroll
    for (int j = 0; j < 8; ++j) { const int n = (lane >> 3) + 8 * j; const LAS unsigned* sp = scr + n * 33 + 4 * ch;
        u32x4 o; o.x = sp[0]; o.y = sp[1]; o.z = sp[2]; o.w = sp[3];
        *(GAS u32x4*)(WT + (size_t)(row_off + n0 + n) * ldt + k0 + 8 * ch) = o; }
    LDS_WAIT(); asm volatile("" ::: "memory");
}
DI void rms_row_to_bf16(const float* xrow, bf16_t* orow, int lane, float* rstd_out) {
    const GAS f32x4* xr = (const GAS f32x4*)xrow + lane;
    f32x4 v[4]; float s = 0.f;
#pragma unroll
    for (int j = 0; j < 4; ++j) { v[j] = __builtin_nontemporal_load(xr + 64 * j); s += (v[j].x * v[j].x + v[j].y * v[j].y) + (v[j].z * v[j].z + v[j].w * v[j].w); }
    float rstd = 1.0f / sqrtf(wave_sum(s) * (1.f / D) + EPS);
    if (rstd_out) { if (lane == 0) *rstd_out = rstd; rstd = 1.0f; }
    GAS u32x2* o8 = (GAS u32x2*)orow + lane;
#pragma unroll
    for (int j = 0; j < 4; ++j) { u32x2 w; w.x = pk2(v[j].x * rstd, v[j].y * rstd); w.y = pk2(v[j].z * rstd, v[j].w * rstd); o8[64 * j] = w; }
}
DI void p0_prologue(Frame& F) {
    LAS unsigned* scr = (LAS unsigned*)(F.lds + F.wave * 16384);
    const int gw = F.bid * NWAVES + F.wave, NGW = F.G * NWAVES, lane = F.lane;
    unsigned char* ws = F.ws;
    constexpr int I_IN = 16 * 28, I_SQ = 16 * 16, I_E1 = 32 * 16 * 8, I_E2 = 32 * 8 * 16;
    constexpr int NITEMS = I_IN + 5 * I_SQ;
    for (int it = gw; it < NITEMS; it += NGW) {
        int r = it;
        if (r < I_IN) { p0_transpose_item(F.in[I_W_IN], INW, (bf16_t*)(ws + WS_WIN), D, 0, F.in[I_NORM_MIX], scr, r / 28, r % 28, lane); continue; } r -= I_IN;
        if (r < I_SQ) { const int kb = r / 16; const float* g = (kb < 8) ? F.in[I_ON_ATTN] : (F.in[I_ON_SGU] - 512);
                        p0_transpose_item(F.in[I_W_OUT], D, (bf16_t*)(ws + WS_WOUT), D, 0, g, scr, kb, r % 16, lane); continue; } r -= I_SQ;
        if (r < I_SQ) { p0_transpose_item(F.in[I_W_CQ], D, (bf16_t*)(ws + WS_WCQ), D, 0, F.in[I_NORM_CROSS], scr, r / 16, r % 16, lane); continue; } r -= I_SQ;
        if (r < I_SQ) { p0_transpose_item(F.in[I_W_CK], D, (bf16_t*)(ws + WS_WCK), D, 0, F.in[I_NORM_MEM], scr, r / 16, r % 16, lane); continue; } r -= I_SQ;
        if (r < I_SQ) { p0_transpose_item(F.in[I_W_CV], D, (bf16_t*)(ws + WS_WCV), D, 0, F.in[I_NORM_MEM], scr, r / 16, r % 16, lane); continue; } r -= I_SQ;
        if (r < I_SQ) { p0_transpose_item(F.in[I_W_CO], D, (bf16_t*)(ws + WS_WCO), D, 0, nullptr, scr, r / 16, r % 16, lane); continue; } r -= I_SQ;
    }
    (void)I_E1; (void)I_E2;
#if 0
        if (r < I_E1) { const int e = r / 128, q = r % 128;
                        p0_transpose_item(F.in[I_W1] + (size_t)e * D * 512, 512, (bf16_t*)(ws + WS_W13) + (size_t)e * 1024 * 1024, D, 0, F.in[I_NORM_FFN], scr, q / 8, q % 8, lane); continue; } r -= I_E1;
        if (r < I_E1) { const int e = r / 128, q = r % 128;
                        p0_transpose_item(F.in[I_W3] + (size_t)e * D * 512, 512, (bf16_t*)(ws + WS_W13) + (size_t)e * 1024 * 1024, D, 512, F.in[I_NORM_FFN], scr, q / 8, q % 8, lane); continue; } r -= I_E1;
        { const int e = r / 128, q = r % 128;
          p0_transpose_item(F.in[I_W2] + (size_t)e * 512 * D, D, (bf16_t*)(ws + WS_W2) + (size_t)e * 1024 * 512, 512, 0, nullptr, scr, q / 16, q % 16, lane); }
    }
#endif
    for (int m = gw; m < T + NMEM; m += NGW) {
        if (m < T) rms_row_to_bf16(F.in[I_X] + (size_t)m * D, (bf16_t*)(ws + WS_RA) + (size_t)m * D, lane, (float*)(ws + WS_RSTD0) + m);
        else rms_row_to_bf16(F.in[I_MEM] + (size_t)(m - T) * D, (bf16_t*)(ws + WS_MEMB) + (size_t)(m - T) * D, lane, nullptr);
    }
    {
        bf16_t* swb = (bf16_t*)(ws + WS_WRT + 512 * 1024);
        for (int i = F.bid * NTHR + F.tid; i < 8 * 128 * 128 / 8; i += F.G * NTHR) {
            const int j8 = (i & 15) * 8, ii = (i >> 4) & 127;
            const f32x4 a = *(const f32x4*)(F.in[I_SGU_W] + (size_t)i * 8), c = *(const f32x4*)(F.in[I_SGU_W] + (size_t)i * 8 + 4);
            float v[8] = {a[0], a[1], a[2], a[3], c[0], c[1], c[2], c[3]};
#pragma unroll
            for (int e = 0; e < 8; ++e) v[e] = (j8 + e <= ii) ? v[e] : 0.f;
            u32x4 w; w.x = pk2(v[0], v[1]); w.y = pk2(v[2], v[3]); w.z = pk2(v[4], v[5]); w.w = pk2(v[6], v[7]);
            *(GAS u32x4*)(swb + (size_t)i * 8) = w;
        }
    }
    if (F.bid == 0 && F.wave == 0) {
        float a = 0.f, b = 0.f;
        for (int i = lane; i < 256; i += 64) { a = fmaxf(a, fabsf(F.in[I_CQ_NORM][i])); b = fmaxf(b, fabsf(F.in[I_CK_NORM][i])); }
#pragma unroll
        for (int o = 1; o < 64; o <<= 1) { a = fmaxf(a, __shfl_xor(a, o)); b = fmaxf(b, __shfl_xor(b, o)); }
        if (lane == 0) *(float*)(ws + WS_WRT + 256 * 1024) = 16.0f * a * b * 1.4426950408889634f;
    }
    {
        bf16_t* wrp = (bf16_t*)(ws + WS_WRT);
        for (int i = F.bid * NTHR + F.tid; i < 32 * 3 * 64 * 8; i += F.G * NTHR) {
            const int j = i & 7, ln = (i >> 3) & 63, nb = (i >> 9) % 3, sidx = i / 1536;
            const int k = 32 * sidx + 8 * (ln >> 4) + j, e = 16 * nb + (ln & 15);
            float w = 0.f;
            if (e < 4) w = F.in[I_WRG][k * 4 + e];
            else if (e < 36) { const int g = (e - 4) >> 3, ee = (e - 4) & 7; w = F.in[I_WRE][((size_t)g * D + k) * 8 + ee]; }
            w *= F.in[I_NORM_FFN][k];
            const unsigned h = f2bf(w); const unsigned l = f2bf(w - bf2f((unsigned short)h));
            wrp[((size_t)((sidx * 3 + nb) * 2 + 0) * 64 + ln) * 8 + j] = (bf16_t)h;
            wrp[((size_t)((sidx * 3 + nb) * 2 + 1) * 64 + ln) * 8 + j] = (bf16_t)l;
        }
    }
}

DI void p0b_expert_weights(Frame& F) {
    LAS unsigned* scr = (LAS unsigned*)(F.lds + F.wave * 16384);
    int lane = F.lane; asm volatile("" : "+v"(lane));
    const int gw = F.bid * NWAVES + F.wave, NGW = F.G * NWAVES;
    unsigned char* ws = F.ws;
    constexpr int I_E1 = 32 * 16 * 8, I_E2 = 32 * 8 * 16;
#pragma unroll 1
    for (int it = gw; it < 2 * I_E1 + I_E2; it += NGW) {
        const int which = it < I_E1 ? 0 : (it < 2 * I_E1 ? 1 : 2), r = it - which * I_E1, e = r >> 7, q = r & 127;
        const float* W; int N, ldt, row_off, kb, nb; bf16_t* WT; const float* gain;
        if (which < 2) { W = F.in[which == 0 ? I_W1 : I_W3] + (size_t)e * D * 512; N = 512; WT = (bf16_t*)(ws + WS_W13) + (size_t)e * 1024 * 1024; ldt = D; row_off = which * 512; gain = F.in[I_NORM_FFN]; kb = q >> 3; nb = q & 7; }
        else { W = F.in[I_W2] + (size_t)e * 512 * D; N = D; WT = (bf16_t*)(ws + WS_W2) + (size_t)e * 1024 * 512; ldt = 512; row_off = 0; gain = nullptr; kb = q >> 4; nb = q & 15; }
        p0_transpose_item(W, N, WT, ldt, row_off, gain, scr, kb, nb, lane);
    }
    asm volatile("s_waitcnt vmcnt(0) lgkmcnt(0)" ::: "memory"); __syncthreads();
}

constexpr int BM = 256, BK = 64, HALF = 128, HTB = HALF * BK * 2;
DI int lds_byte(int r, int c) { const int st = (r >> 4) * 2 + (c >> 5), rr = r & 15, cc = c & 31, ob = rr * 64 + cc * 2; return st * 1024 + (ob ^ (((ob >> 9) & 1) << 5)); }
DI void stage_rc(int b, int& R, int& C) { const int st = b / 1024, sb = b % 1024, swz = sb ^ (((sb >> 9) & 1) << 5); R = (st >> 1) * 16 + swz / 64; C = (st & 1) * 32 + (swz % 64) / 2; }
DI int perm32(int rho) { const int n = rho >> 4, i = rho & 15; return 8 * (i >> 2) + 4 * n + (i & 3); }

enum { K_PROJ = 0, K_MEMK, K_MEMVT, K_WOUT, K_WCQ, K_SC, K_PV, K_WCO, K_UP, K_DOWN };
enum { PH_MEMK = 100, PH_MEMV = 101 };
enum { PH_P0 = 0, PH_PROJ, PH_MIX, PH_WOUT, PH_WCQ, PH_SC, PH_PV, PH_WCO, PH_ROUTE, PH_UP, PH_DOWN0, PH_DOWN1, PH_N };

struct GUnit {
    int half;
    const char* A; const char* B;
    int kind, pm, pn;
    const int* gl; int gcnt;
    int aux;
};

DI int xcd_remap(int wgid, int nwg) { const int q = nwg / 8, r = nwg % 8, xcd = wgid % 8, off = wgid / 8; return (xcd < r ? xcd * (q + 1) : r * (q + 1) + (xcd - r) * q) + off; }
DI void grouped_tile(int wgid, int nM, int nN, int& pm, int& pn) {
    const int nig = 8 * nN, gid = wgid / nig, fm = gid * 8, gsz = (nM - fm) < 8 ? (nM - fm) : 8;
    pm = fm + ((wgid % nig) % gsz); pn = (wgid % nig) / gsz;
}

struct Sched { int G, c; unsigned char* ws; const LAS int* tbl; int round; };
template <int PH> struct PCfg { static constexpr int K = 1024; static constexpr unsigned lda2 = 2048, ldb2 = 2048, hstepB = 32 * 2048; static constexpr int RS = 64; };
template <> struct PCfg<PH_UP> { static constexpr int K = 1024; static constexpr unsigned lda2 = 2048, ldb2 = 2048, hstepB = 512 * 2048; static constexpr int RS = 32; };
template <> struct PCfg<PH_DOWN0> { static constexpr int K = 512; static constexpr unsigned lda2 = 1024, ldb2 = 1024, hstepB = 32 * 1024; static constexpr int RS = 64; };

template <int PH, int HV = 0> DI bool sched_next(const Sched& S, int i, GUnit& u) {
    const int L = i * S.G + S.c; unsigned char* ws = S.ws;
    u.gl = nullptr; u.gcnt = 256; u.aux = 0; u.half = 0;
    if constexpr (PH == PH_PROJ) {
        constexpr int NP = 128 * 7;
        if (L >= NP) return false;
        const int w = xcd_remap(L, NP); grouped_tile(w, 128, 7, u.pm, u.pn); u.kind = K_PROJ;
        u.A = (const char*)(ws + WS_RA) + (size_t)u.pm * 256 * 2048; u.B = (const char*)(ws + WS_WIN) + (size_t)u.pn * 256 * 2048;
        return true;
    } else if constexpr (PH == PH_MEMK) {
        const int j = S.c - 128; if (i != 0 || j < 0 || j >= 32) return false;
        u.pm = j >> 2; u.pn = j & 3; u.kind = K_MEMK;
        u.A = (const char*)(ws + WS_MEMB) + (size_t)u.pm * 256 * 2048; u.B = (const char*)(ws + WS_WCK) + (size_t)u.pn * 256 * 2048;
        return true;
    } else if constexpr (PH == PH_MEMV) {
        const int j = S.c - 160; if (i != 0 || j < 0 || j >= 32) return false;
        u.pm = j >> 2; u.pn = j & 3; u.kind = K_MEMVT;
        u.A = (const char*)(ws + WS_MEMB) + (size_t)u.pm * 256 * 2048; u.B = (const char*)(ws + WS_WCV) + (size_t)u.pn * 256 * 2048;
        return true;
    } else if constexpr (PH == PH_WOUT || PH == PH_WCQ || PH == PH_WCO) {
        if (L >= 512) return false;
        const int w = xcd_remap(L, 512); grouped_tile(w, 128, 4, u.pm, u.pn);
        constexpr size_t wa = PH == PH_WOUT ? WS_RC : (PH == PH_WCQ ? WS_RA : WS_RD), wb = PH == PH_WOUT ? WS_WOUT : (PH == PH_WCQ ? WS_WCQ : WS_WCO);
        u.kind = PH == PH_WOUT ? K_WOUT : (PH == PH_WCQ ? K_WCQ : K_WCO);
        u.A = (const char*)(ws + wa) + (size_t)u.pm * 256 * 2048; u.B = (const char*)(ws + wb) + (size_t)u.pn * 256 * 2048;
        return true;
    } else {
        const LAS int* tbl = S.tbl;
        const int r0 = 0, r1 = 64;
        const int t0 = __builtin_amdgcn_readfirstlane(tbl[64 + r0]), t1 = __builtin_amdgcn_readfirstlane(tbl[64 + r1]), nu = (t1 - t0) * 4;
        const int nfull = nu / S.G, rem = nu - nfull * S.G;
        int Lu = L;
        if constexpr (HV) {
            if (i != 0 || 2 * rem > S.G || S.c >= 2 * rem || (S.c & 1) != HV - 1) return false;
            Lu = nfull * S.G + (S.c >> 1); u.half = HV;
        } else {
            if (i >= nfull) { if (i > nfull || 2 * rem <= S.G || S.c >= rem) return false; }
        }
        const int w = xcd_remap(Lu, nu); const int rt = t0 + (w >> 2), pn = w & 3;
        const int jl = r0 + 1 + (int)(threadIdx.x & 63);
        const bool hit = (jl < r1) && (tbl[64 + (jl < 64 ? jl : 64)] <= rt);
        const int re = r0 + (int)__popcll(__ballot(hit));
        const int jt = rt - __builtin_amdgcn_readfirstlane(tbl[64 + re]), cnt = __builtin_amdgcn_readfirstlane(tbl[re]), e = re & 31;
        u.pm = rt; u.pn = pn; u.gcnt = (cnt - jt * 256) < 256 ? (cnt - jt * 256) : 256; u.aux = re * CAP + jt * 256;
        if constexpr (PH == PH_UP) { u.kind = K_UP; u.gl = (const int*)(ws + WS_LTOK) + u.aux;
            u.A = (const char*)(ws + WS_RC); u.B = (const char*)(ws + WS_W13) + ((size_t)e * 1024 + pn * 128) * 2048; }
        else { u.kind = K_DOWN;
            u.A = (const char*)(ws + WS_RD) + (size_t)rt * 256 * 1024; u.B = (const char*)(ws + WS_W2) + ((size_t)e * 1024 + pn * 256) * 1024; }
        return true;
    }
}

struct EpiCtx {
    unsigned char* ws; float* out; const float* const* in;
};

DI void store_bf16x8(bf16_t* p, const f32x4& a, const f32x4& b) { u32x4 w; w.x = pk2(a[0], a[1]); w.y = pk2(a[2], a[3]); w.z = pk2(b[0], b[1]); w.w = pk2(b[2], b[3]); *(GAS u32x4*)p = w; }
DI float sumsq16(const f32x4& a, const f32x4& b, const f32x4& c, const f32x4& d) {
    return ((a[0] * a[0] + a[1] * a[1]) + (a[2] * a[2] + a[3] * a[3])) + ((b[0] * b[0] + b[1] * b[1]) + (b[2] * b[2] + b[3] * b[3])) +
           ((c[0] * c[0] + c[1] * c[1]) + (c[2] * c[2] + c[3] * c[3])) + ((d[0] * d[0] + d[1] * d[1]) + (d[2] * d[2] + d[3] * d[3]));
}
#define RSLOT(p) (((p) == 0 ? 4 : (p) == 1 ? 5 : (p) == 2 ? 0 : (p) == 3 ? 1 : (p) == 4 ? 6 : (p) == 5 ? 7 : 2) * 16384)
#define PIN_ROW(ai, m) asm volatile("" : "+v"(acc[ai][0][m][0]), "+v"(acc[ai][0][m][1]), "+v"(acc[ai][1][m][0]), "+v"(acc[ai][1][m][1]))
DI float quad_sum(float s) { s += __shfl_xor(s, 16); s += __shfl_xor(s, 32); return s; }

template <int PH, int HV = 0> DI void epilogue(const EpiCtx& E, const GUnit& u, f32x4 (&acc)[2][2][4][2], int wr, int wc, int fr_, int fq_, const float (&epre)[8], LAS unsigned char* lds, bool resl) {
    int fr = fr_, fq = fq_; asm volatile("" : "+v"(fr), "+v"(fq));
    unsigned char* ws = E.ws;
    const int rbase = wr * 64 + fr;
    const int cb = 64 * wc + 8 * fq;
    const int kind = (PH == PH_PROJ) ? K_PROJ : (PH == PH_MEMK) ? K_MEMK : (PH == PH_MEMV) ? K_MEMVT : (PH == PH_WOUT ? K_WOUT : PH == PH_WCQ ? K_WCQ : PH == PH_WCO ? K_WCO : PH == PH_UP ? K_UP : K_DOWN);
    switch (kind) {
    case K_PROJ: {
        const int hd = 4 * u.pn + wc;
        bf16_t* PJ = (bf16_t*)(ws + WS_RB) + ((size_t)u.pm * 256 + rbase) * PJW + 64 * (hd < 12 ? hd - 8 : hd - 16) + 8 * fq;
        const int cmh = (hd < 8) ? hd : hd - 4;
        unsigned char* QU = ws + WS_RD + ((size_t)(u.pm * 8 + (rbase >> 5)) * 128 + 8 * cmh + fq) * 512 + (rbase & 31) * 16;
        const float* R0 = (const float*)(ws + WS_RSTD0) + (size_t)u.pm * 256 + rbase;
        float r0v[2][4];
#pragma unroll
        for (int ai = 0; ai < 2; ++ai)
#pragma unroll
            for (int m = 0; m < 4; ++m) r0v[ai][m] = R0[ai * 128 + m * 16];
        if (hd < 10) {
            const float* gp = (hd < 8) ? E.in[I_Q_NORM] : E.in[I_K_NORM]; const float sc = (hd < 8) ? 0.125f * 1.4426950408889634f : 1.0f;
#pragma unroll
            for (int ai = 0; ai < 2; ++ai)
#pragma unroll
                for (int m = 0; m < 4; ++m) {
                    const float r0 = r0v[ai][m];
                    const float ss = quad_sum(sumsq16(acc[ai][0][m][0], acc[ai][0][m][1], acc[ai][1][m][0], acc[ai][1][m][1])) * (r0 * r0);
                    const float rstd = sc * r0 / sqrtf(ss * (1.0f / 64.0f) + EPS);
#pragma unroll
                    for (int bj = 0; bj < 2; ++bj) {
                        const f32x4 g0 = *(const f32x4*)(gp + 32 * bj + 8 * fq), g1 = *(const f32x4*)(gp + 32 * bj + 8 * fq + 4);
                        if (hd < 8) store_bf16x8((bf16_t*)(QU + (size_t)((ai * 4 + (m >> 1)) * 128 + 4 * bj) * 512 + (m & 1) * 256), acc[ai][bj][m][0] * rstd * g0, acc[ai][bj][m][1] * rstd * g1);
                        else store_bf16x8(PJ + (size_t)(ai * 128 + m * 16) * PJW + 32 * bj, acc[ai][bj][m][0] * rstd * g0, acc[ai][bj][m][1] * rstd * g1);
                    }
                    asm volatile("" ::: "memory");
                }
        } else if (hd < 12) {
#pragma unroll
            for (int ai = 0; ai < 2; ++ai)
#pragma unroll
                for (int m = 0; m < 4; ++m) {
                    const float r0 = r0v[ai][m];
#pragma unroll
                    for (int bj = 0; bj < 2; ++bj) store_bf16x8(PJ + (size_t)(ai * 128 + m * 16) * PJW + 32 * bj, acc[ai][bj][m][0] * r0, acc[ai][bj][m][1] * r0);
                }
        } else {
#pragma unroll
            for (int ai = 0; ai < 2; ++ai)
#pragma unroll
                for (int m = 0; m < 4; ++m) {
                    const float r0 = r0v[ai][m];
#pragma unroll
                    for (int bj = 0; bj < 2; ++bj) {
                        f32x4 v0 = acc[ai][bj][m][0] * r0, v1 = acc[ai][bj][m][1] * r0;
#pragma unroll
                        for (int e = 0; e < 4; ++e) { v0[e] = gelu_tanh(v0[e]); v1[e] = gelu_tanh(v1[e]); }
                        if (hd < 20) store_bf16x8((bf16_t*)(QU + (size_t)((ai * 4 + (m >> 1)) * 128 + 4 * bj) * 512 + (m & 1) * 256), v0, v1);
                        else store_bf16x8(PJ + (size_t)(ai * 128 + m * 16) * PJW + 32 * bj, v0, v1);
                    }
                    asm volatile("" ::: "memory");
                }
        }
        break; }
    case K_MEMK: {
        bf16_t* KM = (bf16_t*)(ws + WS_KMEM); float* SK = (float*)(ws + WS_SSQK);
        f32x4 g[2][2];
#pragma unroll
        for (int bj = 0; bj < 2; ++bj)
#pragma unroll
            for (int n = 0; n < 2; ++n) g[bj][n] = *(const f32x4*)(E.in[I_CK_NORM] + cb + 32 * bj + 4 * n);
#pragma unroll
        for (int ai = 0; ai < 2; ++ai)
#pragma unroll
            for (int m = 0; m < 4; ++m) {
                const size_t grow = (size_t)u.pm * 256 + ai * 128 + m * 16 + rbase;
                const float ss = quad_sum(sumsq16(acc[ai][0][m][0], acc[ai][0][m][1], acc[ai][1][m][0], acc[ai][1][m][1]));
                if (fq == 0) SK[(grow * 4 + u.pn) * 4 + wc] = ss;
#pragma unroll
                for (int bj = 0; bj < 2; ++bj) store_bf16x8(KM + grow * D + u.pn * 256 + cb + 32 * bj, acc[ai][bj][m][0] * g[bj][0], acc[ai][bj][m][1] * g[bj][1]);
            }
        break; }
    case K_MEMVT: {
        bf16_t* VT = (bf16_t*)(ws + WS_VMT);
#pragma unroll
        for (int ai = 0; ai < 2; ++ai)
#pragma unroll
            for (int m = 0; m < 4; ++m) {
                const size_t grow = (size_t)u.pm * 256 + ai * 128 + m * 16 + rbase;
#pragma unroll
                for (int bj = 0; bj < 2; ++bj) store_bf16x8(VT + grow * D + u.pn * 256 + cb + 32 * bj, acc[ai][bj][m][0], acc[ai][bj][m][1]);
            }
        break; }
    case K_WOUT: {
        const size_t off0 = ((size_t)u.pm * 256 + rbase) * D + u.pn * 256 + cb;
        bf16_t* XB = (bf16_t*)(ws + WS_RA) + off0; float* SP = (float*)(ws + WS_SSQ1P) + ((size_t)u.pm * 256 + rbase) * 16 + u.pn * 4 + wc;
#pragma unroll
        for (int ai = 0; ai < 2; ++ai) {
            u32x4 rv[4][2];
#pragma unroll
            for (int m = 0; m < 4; ++m)
#pragma unroll
                for (int bj = 0; bj < 2; ++bj) rv[m][bj] = (resl && !(ai == 1 && wc == 3)) ? *(const LAS u32x4*)(lds + RSLOT(ai * 4 + wc) + lds_byte(wr * 64 + m * 16 + fr, 32 * bj + 8 * fq)) : __builtin_nontemporal_load((const GAS u32x4*)(XB + (size_t)(ai * 128 + m * 16) * D + 32 * bj));
            asm volatile("" ::: "memory");
#pragma unroll
            for (int m = 0; m < 4; ++m) {
                const size_t ro = (size_t)(ai * 128 + m * 16) * D;
                f32x4 v[2][2];
#pragma unroll
                for (int bj = 0; bj < 2; ++bj) {
                    const u32x4 r = rv[m][bj];
                    f32x4 v0 = acc[ai][bj][m][0], v1 = acc[ai][bj][m][1];
                    v0[0] += bflo(r.x); v0[1] += bfhi(r.x); v0[2] += bflo(r.y); v0[3] += bfhi(r.y);
                    v1[0] += bflo(r.z); v1[1] += bfhi(r.z); v1[2] += bflo(r.w); v1[3] += bfhi(r.w);
                    v[bj][0] = v0; v[bj][1] = v1;
                    store_bf16x8(XB + ro + 32 * bj, v0, v1);
                }
                const float ss = quad_sum(sumsq16(v[0][0], v[0][1], v[1][0], v[1][1])); if (fq == 0) SP[(size_t)(ai * 128 + m * 16) * 16] = ss;
            }
            asm volatile("" ::: "memory");
        }
        break; }
    case K_WCO: {
        const size_t off0 = ((size_t)u.pm * 256 + rbase) * D + u.pn * 256 + cb;
        const bf16_t* X1 = (const bf16_t*)(ws + WS_RA) + off0;
        bf16_t* XB = (bf16_t*)(ws + WS_RC) + off0;
#pragma unroll
        for (int ai = 0; ai < 2; ++ai) {
            u32x4 rv[4][2];
#pragma unroll
            for (int m = 0; m < 4; ++m)
#pragma unroll
                for (int bj = 0; bj < 2; ++bj) rv[m][bj] = (resl && !(ai == 1 && wc == 3)) ? *(const LAS u32x4*)(lds + RSLOT(ai * 4 + wc) + lds_byte(wr * 64 + m * 16 + fr, 32 * bj + 8 * fq)) : __builtin_nontemporal_load((const GAS u32x4*)(X1 + (size_t)(ai * 128 + m * 16) * D + 32 * bj));
            asm volatile("" ::: "memory");
#pragma unroll
            for (int m = 0; m < 4; ++m) {
                const size_t ro = (size_t)(ai * 128 + m * 16) * D;
#pragma unroll
                for (int bj = 0; bj < 2; ++bj) {
                    const u32x4 r = rv[m][bj];
                    f32x4 v0 = acc[ai][bj][m][0], v1 = acc[ai][bj][m][1];
                    v0[0] += bflo(r.x); v0[1] += bfhi(r.x); v0[2] += bflo(r.y); v0[3] += bfhi(r.y);
                    v1[0] += bflo(r.z); v1[1] += bfhi(r.z); v1[2] += bflo(r.w); v1[3] += bfhi(r.w);
                    store_bf16x8(XB + ro + 32 * bj, v0, v1);
                }
            }
            asm volatile("" ::: "memory");
        }
        break; }
    case K_WCQ: {
        bf16_t* QC = (bf16_t*)(ws + WS_RB); const float* SP = (const float*)(ws + WS_SSQ1P); float* SQ = (float*)(ws + WS_SSQQ);
        f32x4 g[2][2];
#pragma unroll
        for (int bj = 0; bj < 2; ++bj)
#pragma unroll
            for (int n = 0; n < 2; ++n) g[bj][n] = *(const f32x4*)(E.in[I_CQ_NORM] + cb + 32 * bj + 4 * n);
#pragma unroll
        for (int ai = 0; ai < 2; ++ai)
#pragma unroll
            for (int m = 0; m < 4; ++m) {
                const size_t grow = (size_t)u.pm * 256 + ai * 128 + m * 16 + rbase;
                const f32x4 p = *(const f32x4*)(SP + grow * 16 + 4 * fq);
                const float tot = quad_sum((p[0] + p[1]) + (p[2] + p[3]));
                const float rstd1 = 1.0f / sqrtf(tot * (1.0f / D) + EPS);
                f32x4 v[2][2];
#pragma unroll
                for (int bj = 0; bj < 2; ++bj)
#pragma unroll
                    for (int n = 0; n < 2; ++n) v[bj][n] = acc[ai][bj][m][n] * rstd1;
                const float ss = quad_sum(sumsq16(v[0][0], v[0][1], v[1][0], v[1][1]));
                if (fq == 0) SQ[(grow * 4 + u.pn) * 4 + wc] = ss;
#pragma unroll
                for (int bj = 0; bj < 2; ++bj) store_bf16x8(QC + grow * D + u.pn * 256 + cb + 32 * bj, v[bj][0] * g[bj][0], v[bj][1] * g[bj][1]);
            }
        break; }
    case K_UP: {
        bf16_t* HID = (bf16_t*)(ws + WS_RD); const float* LR = (const float*)(ws + WS_LRSTD) + u.aux;
#pragma unroll
        for (int ai = (HV ? HV - 1 : 0); ai < (HV ? HV : 2); ++ai)
#pragma unroll
            for (int m = 0; m < 4; ++m) {
                PIN_ROW(ai, m);
                const int lrow = ai * 128 + m * 16 + rbase;
                const float rs = epre[ai * 4 + m];
                f32x4 hv[2];
#pragma unroll
                for (int n = 0; n < 2; ++n)
#pragma unroll
                    for (int e = 0; e < 4; ++e) hv[n][e] = silu(acc[ai][0][m][n][e] * rs) * (acc[ai][1][m][n][e] * rs);
                store_bf16x8(HID + ((size_t)u.pm * 256 + lrow) * 512 + u.pn * 128 + 32 * wc + 8 * fq, hv[0], hv[1]);
                asm volatile("" ::: "memory");
            }
        break; }
    case K_DOWN: {
        const int* LT = (const int*)(ws + WS_LTOK) + u.aux; const float* LG = (const float*)(ws + WS_LGATE) + u.aux;
        bf16_t* CB0 = (bf16_t*)(ws + WS_RB) + u.pn * 256 + cb; bf16_t* CB1 = (bf16_t*)(ws + WS_RA) + u.pn * 256 + cb;
        int tk[2][4]; float gt[2][4];
#pragma unroll
        for (int ai = (HV ? HV - 1 : 0); ai < (HV ? HV : 2); ++ai)
#pragma unroll
            for (int m = 0; m < 4; ++m) { const int lrow = ai * 128 + m * 16 + rbase; const bool ok = (lrow < u.gcnt); tk[ai][m] = ok ? LT[lrow] : -1; gt[ai][m] = ok ? LG[lrow] : 0.f; }
#pragma unroll
        for (int ai = (HV ? HV - 1 : 0); ai < (HV ? HV : 2); ++ai)
#pragma unroll
            for (int m = 0; m < 4; ++m) {
                if (tk[ai][m] >= 0) {
                    bf16_t* o = ((tk[ai][m] & 1) ? CB1 : CB0) + (size_t)(tk[ai][m] >> 1) * D; const float g = gt[ai][m];
#pragma unroll
                    for (int bj = 0; bj < 2; ++bj) store_bf16x8(o + 32 * bj, acc[ai][bj][m][0] * g, acc[ai][bj][m][1] * g);
                }
            }
        break; }
    }
}

template <int PH> struct Stagger { static constexpr int ways = 1; static constexpr unsigned ticks = 0; };
#ifndef STG_WOUT
#define STG_WOUT 0
#endif
#ifndef STG_WCO
#define STG_WCO 0
#endif
#ifndef STG_DOWN
#define STG_DOWN 0
#endif
template <> struct Stagger<PH_WOUT> { static constexpr int ways = 2; static constexpr unsigned ticks = STG_WOUT; };
template <> struct Stagger<PH_WCO> { static constexpr int ways = 2; static constexpr unsigned ticks = STG_WCO; };
template <> struct Stagger<PH_DOWN0> { static constexpr int ways = 4; static constexpr unsigned ticks = STG_DOWN; };
template <int PH, int HV = 0> DI void gemm_phase(LAS unsigned char* lds, const Sched& S, const EpiCtx& E) {
    if constexpr (Stagger<PH>::ways > 1 && Stagger<PH>::ticks > 0) {
        const unsigned way = ((unsigned)S.c >> 3) % Stagger<PH>::ways;
        if (way) { const unsigned long long t0 = __builtin_amdgcn_s_memrealtime(), dl = (unsigned long long)way * Stagger<PH>::ticks;
            while (__builtin_amdgcn_s_memrealtime() - t0 < dl) __builtin_amdgcn_s_sleep(8); }
    }
    typedef PCfg<(PH == PH_DOWN1 ? PH_DOWN0 : PH)> g;
    constexpr bool GATHER = (PH == PH_UP);
    constexpr bool CMA = (PH == PH_WOUT || PH == PH_WCO);
    constexpr bool RESL = (PH == PH_WOUT || PH == PH_WCO);
    constexpr bool HALVES = (PH == PH_UP || PH == PH_DOWN0);
    const int tid = threadIdx.x, wid = __builtin_amdgcn_readfirstlane(tid >> 6), lane = tid & 63, wr = wid >> 2, wc = wid & 3, fr = lane & 15, fq = lane >> 4;
    constexpr int nt = g::K / BK;
    int R0, C0; stage_rc(tid * 16, R0, C0);
    unsigned vB[2], vA0[2], vR[2];
#pragma unroll
    for (int i = 0; i < 2; ++i) { const int R = R0 + 64 * i; vB[i] = (unsigned)(g::RS * (R >> 5) + perm32(R & 31)) * g::ldb2 + (unsigned)C0 * 2u; vR[i] = (unsigned)R * 2048u + (unsigned)C0 * 2u; vA0[i] = CMA ? (unsigned)(((R >> 5) * 128 + (C0 >> 3)) * 512 + (R & 31) * 16) : (unsigned)R * g::lda2 + (unsigned)C0 * 2u; }
    const unsigned ldsw = (unsigned)wid * 1024u;
    const int aoff = lds_byte(wr * 64 + fr, fq * 8), boff = lds_byte(wc * 32 + fr, fq * 8);
    constexpr size_t hA = (size_t)HALF * g::lda2;
#define SA(b, h) (((b) * 2 + (h)) * HTB)
#define SB(b, h) ((4 + (b) * 2 + (h)) * HTB)
#define GLDS(gp, loff) __builtin_amdgcn_global_load_lds((const unsigned*)(gp), (LAS unsigned*)(lds + (loff)), 16, 0, 0)
#define STG_A(bufoff, base, h, useN) do { if constexpr (GATHER) { \
        GLDS((base) + vAc[h][0], (bufoff) + ldsw); GLDS((base) + vAc[h][1], (bufoff) + ldsw + 8192); } else { \
        GLDS((base) + (h) * hA + vA0[0], (bufoff) + ldsw); GLDS((base) + (h) * hA + vA0[1], (bufoff) + ldsw + 8192); } } while (0)
#define STG_B(bufoff, base) do { GLDS((base) + vB[0], (bufoff) + ldsw); GLDS((base) + vB[1], (bufoff) + ldsw + 8192); } while (0)
#define STG_BR(bufoff, base, piece) do { if constexpr (RESL) { const char* bb_ = resm ? resb + ((piece) >> 2) * (128 * 2048) + ((piece) & 3) * 128 : (const char*)(base); \
        GLDS(bb_ + (resm ? vR[0] : vB[0]), (bufoff) + ldsw); GLDS(bb_ + (resm ? vR[1] : vB[1]), (bufoff) + ldsw + 8192); } else { STG_B(bufoff, base); } } while (0)
#define STG_AR(bufoff, base, h, useN, piece) do { if constexpr (RESL) { const char* bb_ = resm ? resb + ((piece) >> 2) * (128 * 2048) + ((piece) & 3) * 128 : (const char*)(base) + (h) * hA; \
        GLDS(bb_ + (resm ? vR[0] : vA0[0]), (bufoff) + ldsw); GLDS(bb_ + (resm ? vR[1] : vA0[1]), (bufoff) + ldsw + 8192); } else { STG_A(bufoff, base, h, useN); } } while (0)
#define LDA(dst, b, h) do { _Pragma("unroll") for (int m = 0; m < 4; ++m) _Pragma("unroll") for (int k = 0; k < 2; ++k) dst[m][k] = *(const LAS bf16x8*)(lds + SA(b, h) + aoff + m * 2048 + k * 1024); } while (0)
#define LDB(dst, b, h) do { _Pragma("unroll") for (int n = 0; n < 2; ++n) _Pragma("unroll") for (int k = 0; k < 2; ++k) dst[n][k] = *(const LAS bf16x8*)(lds + SB(b, h) + boff + n * 2048 + k * 1024); } while (0)
#define MMA(ai, bj, At, Bt) do { __builtin_amdgcn_s_setprio(1); _Pragma("unroll") for (int m = 0; m < 4; ++m) _Pragma("unroll") for (int n = 0; n < 2; ++n) _Pragma("unroll") for (int k = 0; k < 2; ++k) \
        acc[ai][bj][m][n] = __builtin_amdgcn_mfma_f32_16x16x32_bf16(Bt[n][k], At[m][k], acc[ai][bj][m][n], 0, 0, 0); __builtin_amdgcn_s_setprio(0); } while (0)
#define WAIT_V(n) asm volatile("s_waitcnt vmcnt(" #n ")" ::: "memory")
#define WAIT_L(n) asm volatile("s_waitcnt lgkmcnt(" #n ")" ::: "memory")
#define BAR __builtin_amdgcn_s_barrier()
#define SCHED __builtin_amdgcn_sched_barrier(0)
#define LOAD_IDX(ii, U) do { _Pragma("unroll") for (int h = 0; h < 2; ++h) _Pragma("unroll") for (int i = 0; i < 2; ++i) { const int r_ = 128 * h + R0 + 64 * i; \
        (ii)[h][i] = (r_ < (U).gcnt) ? ((U).gl[r_] >> 1) : 0; } } while (0)
#define IDX_TO_VA(vv, ii) do { _Pragma("unroll") for (int h = 0; h < 2; ++h) _Pragma("unroll") for (int i = 0; i < 2; ++i) (vv)[h][i] = (unsigned)(ii)[h][i] * g::lda2 + (unsigned)C0 * 2u; } while (0)
    GUnit cur, nxt; int ui = 0;
    if (!sched_next<PH, HV>(S, 0, cur)) return;
    f32x4 acc[2][2][4][2];
#pragma unroll
    for (int a = 0; a < 2; ++a)
#pragma unroll
        for (int b = 0; b < 2; ++b)
#pragma unroll
            for (int m = 0; m < 4; ++m)
#pragma unroll
                for (int n = 0; n < 2; ++n) acc[a][b][m][n] = (f32x4){0.f, 0.f, 0.f, 0.f};
    bf16x8 At[4][2], B0[2][2], B1[2][2];
    unsigned vAc[2][2]; int idxn[2][2]; float epre[8];
    if constexpr (GATHER) { LOAD_IDX(idxn, cur); IDX_TO_VA(vAc, idxn); }
    const char* cA = cur.A; const char* cB = cur.B;
    constexpr size_t kstep = BK * 2; constexpr size_t hB = g::hstepB;
    constexpr size_t kstepA = CMA ? 8 * 512 : BK * 2;
    STG_B(SB(0, 0), cB); STG_B(SB(0, 1), cB + hB); STG_A(SA(0, 0), cA, 0, false); STG_A(SA(0, 1), cA, 1, false);
    if (wr == 1) BAR;
    WAIT_V(2); BAR;
    STG_B(SB(1, 0), cB + kstep); STG_A(SA(1, 0), cA + kstepA, 0, false); STG_B(SB(1, 1), cB + hB + kstep);
    WAIT_V(6); BAR;
    for (;;) {
        const bool has_next = sched_next<PH, HV>(S, ui + 1, nxt);
        const char* nA = has_next ? nxt.A : cA; const char* nB = has_next ? nxt.B : cB;
#pragma unroll 1
        for (int t = 0; t < nt; t += 2) {
            const bool last = (t == nt - 2);
            if constexpr (GATHER) { if (last) { if (has_next) { LOAD_IDX(idxn, nxt); }
                const float* LR_ = (const float*)(E.ws + WS_LRSTD) + cur.aux;
#pragma unroll
                for (int ai = 0; ai < 2; ++ai)
#pragma unroll
                    for (int m = 0; m < 4; ++m) { const int lr_ = ai * 128 + m * 16 + wr * 64 + fr; epre[ai * 4 + m] = (lr_ < cur.gcnt) ? LR_[lr_] : 0.f; } } }
            const bool resm = RESL && last && !has_next;
            const char* resb = (const char*)(E.ws + WS_RA) + ((size_t)cur.pm * 256 * D + cur.pn * 256) * 2;
            const char* a1 = cA + (size_t)(t + 1) * kstepA;
            const char* a2 = last ? nA : cA + (size_t)(t + 2) * kstepA; const char* b2 = last ? nB : cB + (size_t)(t + 2) * kstep;
            const char* a3 = a2 + kstepA; const char* b3 = b2 + kstep;
            LDB(B0, 0, 0); LDB(B1, 0, 1); SCHED; if constexpr (HV != 2) LDA(At, 0, 0); STG_A(SA(1, 1), a1, 1, false);
            WAIT_V(8); WAIT_L(0); BAR; if constexpr (HV != 2) { MMA(0, 0, At, B0); MMA(0, 1, At, B1); } BAR; SCHED;
            if constexpr (GATHER) { if (last) { asm volatile("" : "+v"(epre[0]), "+v"(epre[1]), "+v"(epre[2]), "+v"(epre[3]), "+v"(epre[4]), "+v"(epre[5]), "+v"(epre[6]), "+v"(epre[7])); if (has_next) { IDX_TO_VA(vAc, idxn); } } }
            if constexpr (HV != 1) LDA(At, 0, 1); STG_BR(SB(0, 0), b2, 0); STG_BR(SB(0, 1), b2 + hB, 1); STG_AR(SA(0, 0), a2, 0, last, 2);
            WAIT_V(8); WAIT_L(0); BAR; if constexpr (HV != 1) { MMA(1, 0, At, B0); MMA(1, 1, At, B1); } BAR; SCHED;
            LDB(B0, 1, 0); LDB(B1, 1, 1); SCHED; if constexpr (HV != 2) LDA(At, 1, 0); STG_AR(SA(0, 1), a2, 1, last, 3);
            WAIT_V(8); WAIT_L(0); BAR; if constexpr (HV != 2) { MMA(0, 0, At, B0); MMA(0, 1, At, B1); } BAR; SCHED;
            if constexpr (HV != 1) LDA(At, 1, 1); STG_BR(SB(1, 0), b3, 4); STG_BR(SB(1, 1), b3 + hB, 5); STG_AR(SA(1, 0), a3, 0, last, 6);
            WAIT_V(8); WAIT_L(0); BAR; if constexpr (HV != 1) { MMA(1, 0, At, B0); MMA(1, 1, At, B1); } BAR; SCHED;
        }
        if (wr == 0) BAR;
        if constexpr (RESL) { if (!has_next) { WAIT_V(0); BAR; } }
        epilogue<PH, HV>(E, cur, acc, wr, wc, fr, fq, epre, lds, RESL && !has_next);
        if (!has_next) break;
#pragma unroll
        for (int a = 0; a < 2; ++a)
#pragma unroll
            for (int b = 0; b < 2; ++b)
#pragma unroll
                for (int m = 0; m < 4; ++m)
#pragma unroll
                    for (int n = 0; n < 2; ++n) acc[a][b][m][n] = (f32x4){0.f, 0.f, 0.f, 0.f};
        cur = nxt; cA = nA; cB = nB; ++ui;
        if (wr == 1) BAR;
    }
    WAIT_V(0);
    BAR;
#undef SA
#undef SB
#undef GLDS
#undef STG_A
#undef STG_B
#undef STG_BR
#undef STG_AR
#undef LDA
#undef LDB
#undef MMA
#undef WAIT_V
#undef WAIT_L
#undef BAR
#undef SCHED
#undef LOAD_IDX
#undef IDX_TO_VA
}

DI int crow(int r, int hi) { return (r & 3) + 8 * (r >> 2) + 4 * hi; }
typedef short v4i16_t __attribute__((ext_vector_type(4)));
DI s16x4 vtr(const LAS unsigned char* p) { return __builtin_bit_cast(s16x4, __builtin_amdgcn_ds_read_tr16_b64_v4i16((LAS v4i16_t*)p)); }
#define MFMA32(a, b, c) __builtin_amdgcn_mfma_f32_32x32x16_bf16((a), (b), (c), 0, 0, 0)
DI bf16x8 cat8(s16x4 lo, s16x4 hi) { return __builtin_shufflevector(lo, hi, 0, 1, 2, 3, 4, 5, 6, 7); }
DI bf16x8 pack8(float a0, float a1, float a2, float a3, float a4, float a5, float a6, float a7) {
    u32x4 w; w.x = pk2(a0, a1); w.y = pk2(a2, a3); w.z = pk2(a4, a5); w.w = pk2(a6, a7); return __builtin_bit_cast(bf16x8, w);
}
DI void norm_store_unit(Frame& F, f32x16 (&ov)[4][2], int ql, int hh, unsigned char* dst0  ) {
    LAS float* xch = (LAS float*)(F.lds + SGP_OFF);
    __syncthreads();
#pragma unroll
    for (int blk = 0; blk < 4; ++blk) {
        float ss = 0.f;
#pragma unroll
        for (int d = 0; d < 2; ++d)
#pragma unroll
            for (int r = 0; r < 16; ++r) ss += ov[blk][d][r] * ov[blk][d][r];
        ss += __shfl_xor(ss, 32);
        if (hh == 0) xch[F.wave * 128 + 32 * blk + ql] = ss;
    }
    __syncthreads();
#pragma unroll
    for (int blk = 0; blk < 4; ++blk) {
        float tot = 0.f;
#pragma unroll
        for (int w = 0; w < 8; ++w) tot += xch[w * 128 + 32 * blk + ql];
        const float rstd = 1.0f / sqrtf(tot * (1.0f / 512.0f) + EPS);
#pragma unroll
        for (int d = 0; d < 2; ++d)
#pragma unroll
            for (int g = 0; g < 4; ++g) {
                u32x2 w; w.x = pk2(ov[blk][d][4 * g] * rstd, ov[blk][d][4 * g + 1] * rstd); w.y = pk2(ov[blk][d][4 * g + 2] * rstd, ov[blk][d][4 * g + 3] * rstd);
                *(GAS u32x2*)(dst0 + (size_t)blk * 128 * 512 + (size_t)(4 * d + g) * 512) = w;
            }
    }
}
DI void norm_store_512(Frame& F, f32x16 (&o)[2], int par, int ql, int hh, unsigned char* dst  ) {
    LAS float* xch = (LAS float*)(F.lds + XCH_OFF) + par * 256;
    float ss = 0.f;
#pragma unroll
    for (int d = 0; d < 2; ++d)
#pragma unroll
        for (int r = 0; r < 16; ++r) ss += o[d][r] * o[d][r];
    ss += __shfl_xor(ss, 32);
    if (hh == 0) xch[F.wave * 32 + ql] = ss;
    __syncthreads();
    float tot = 0.f;
#pragma unroll
    for (int w = 0; w < 8; ++w) tot += xch[w * 32 + ql];
    const float rstd = 1.0f / sqrtf(tot * (1.0f / 512.0f) + EPS);
#pragma unroll
    for (int d = 0; d < 2; ++d)
#pragma unroll
        for (int g = 0; g < 4; ++g) {
            u32x2 w; w.x = pk2(o[d][4 * g] * rstd, o[d][4 * g + 1] * rstd); w.y = pk2(o[d][4 * g + 2] * rstd, o[d][4 * g + 3] * rstd);
            *(GAS u32x2*)(dst + (size_t)(4 * d + g) * 512) = w;
        }
}

#if defined(TS_PHASE) && TS_PHASE >= 20
#define MSTAMP(k) do { __syncthreads(); if (F.tid == 0) ((volatile LAS unsigned long long*)(F.lds + MISC_OFF + 64))[k] = __builtin_amdgcn_s_memrealtime(); } while (0)
#else
#define MSTAMP(k) do { } while (0)
#endif
DI void attn_unit(Frame& F, int b, int n) {
    if (F.wave >= 4) __builtin_amdgcn_s_setprio(1);
    int tid = F.tid; asm volatile("" : "+v"(tid));
    const int lane = tid & 63, ql = lane & 31, hh = lane >> 5;
    const int t0 = b * SEQ + n * 128;
    const bf16_t* PJ = (const bf16_t*)(F.ws + WS_RB);
    bf16_t* MX = (bf16_t*)(F.ws + WS_RC);
    LAS unsigned char* lds = F.lds;
    const int h = F.wave, kvh = h >> 2;
    bf16x8 qfa[4][4];
#pragma unroll
    for (int i = 0; i < 4; ++i) { const unsigned char* qp = F.ws + WS_RD + ((size_t)((t0 >> 5) + i) * 128 + 8 * h + hh) * 512 + ql * 16;
#pragma unroll
        for (int ks = 0; ks < 4; ++ks) qfa[i][ks] = __builtin_nontemporal_load((const GAS bf16x8*)(qp + (size_t)(2 * ks) * 512)); }
    __syncthreads();
#pragma unroll 8
    for (int j = 0; j < 16; ++j) {
        const int p = tid + NTHR * j, row = p >> 5, c = p & 31;
        int tok = t0 - 128 + row; if (n == 0 && row < 128) tok = t0;
        const u32x4 v = *(const GAS u32x4*)(PJ + (size_t)tok * PJW + 8 * c);
        int addr;
        if (c < 16) { const int kvh = c >> 3, ch = c & 7; addr = kvh * 32768 + row * 128 + ((ch ^ ((row >> 1) & 7)) << 4); }
        else { const int cc = c - 16, kvh = cc >> 3, ch = cc & 7; addr = 65536 + kvh * 32768 + (ch >> 2) * 16384 + row * 64 + (ch & 3) * 16; }
        *(LAS u32x4*)(lds + addr) = v;
    }
    __syncthreads();
    const float sinkv = F.in[I_SINKS][h] * 1.4426950408889634f;
    const LAS unsigned char* Kb = lds + kvh * 32768;
    const LAS unsigned char* Vb = lds + 65536 + kvh * 32768;
    const int vtr_off = ((lane & 15) >> 2) * 64 + (16 * ((lane >> 4) & 1) + 4 * (lane & 3)) * 2;
#pragma unroll
    for (int i = 0; i < 4; ++i) {
        const bf16x8* qf = qfa[i];
        f32x16 s[5];
#pragma unroll
        for (int jt = 0; jt < 5; ++jt) {
            const int key = 32 * (i + jt) + ql;
            f32x16 a = {};
#pragma unroll
            for (int ks = 0; ks < 4; ++ks) {
                const bf16x8 kf = *(const LAS bf16x8*)(Kb + key * 128 + (((2 * ks + hh) ^ ((key >> 1) & 7)) << 4));
                a = MFMA32(kf, qf[ks], a);
            }
            s[jt] = a;
        }
        float m = sinkv;
#pragma unroll
        for (int jt = 0; jt < 5; ++jt) {
            const bool tile_ok = (n != 0) || (i + jt >= 4);
#pragma unroll
            for (int r = 0; r < 16; ++r) {
                const int c = crow(r, hh);
                bool ok = tile_ok;
                if (jt == 0) ok = ok && (c > ql);
                if (jt == 4) ok = ok && (c <= ql);
                const float v = ok ? s[jt][r] : -INFINITY;
                s[jt][r] = v; m = fmaxf(m, v);
            }
        }
        m = fmaxf(m, __shfl_xor(m, 32));
        float l = 0.f;
#pragma unroll
        for (int jt = 0; jt < 5; ++jt)
#pragma unroll
            for (int r = 0; r < 16; ++r) { const float p = __builtin_amdgcn_exp2f(s[jt][r] - m); s[jt][r] = p; l += p; }
        l += __shfl_xor(l, 32);
        l += __builtin_amdgcn_exp2f(sinkv - m);
        f32x16 o[2]; o[0] = f32x16{}; o[1] = f32x16{};
#pragma unroll
        for (int jt = 0; jt < 5; ++jt)
#pragma unroll
            for (int s2 = 0; s2 < 2; ++s2) {
                const bf16x8 pf = pack8(s[jt][8 * s2], s[jt][8 * s2 + 1], s[jt][8 * s2 + 2], s[jt][8 * s2 + 3], s[jt][8 * s2 + 4], s[jt][8 * s2 + 5], s[jt][8 * s2 + 6], s[jt][8 * s2 + 7]);
                const int k0 = 32 * (i + jt) + 16 * s2 + 4 * hh;
#pragma unroll
                for (int d = 0; d < 2; ++d) {
                    const LAS unsigned char* vp = Vb + d * 16384 + k0 * 64 + vtr_off;
                    const s16x4 lo = vtr(vp), hi = vtr(vp + 8 * 64);
                    o[d] = MFMA32(cat8(lo, hi), pf, o[d]);
                }
            }
        const float inv = 1.0f / l;
#pragma unroll
        for (int d = 0; d < 2; ++d)
#pragma unroll
            for (int r = 0; r < 16; ++r) o[d][r] *= inv;
        norm_store_512(F, o, i & 1, ql, hh, (unsigned char*)MX + ((size_t)((t0 >> 5) + i) * 128 + 8 * h) * 512 + ql * 16 + 8 * hh);
    }
    __builtin_amdgcn_s_setprio(0);
}

DI void sgu_unit(Frame& F, int b, int n) {
    int tid = F.tid; asm volatile("" : "+v"(tid));
    const int lane = tid & 63, ql = lane & 31, hh = lane >> 5, gi = F.wave;
    const int t0 = b * SEQ + n * 128;
    const bf16_t* PJ = (const bf16_t*)(F.ws + WS_RB);
    bf16_t* MX = (bf16_t*)(F.ws + WS_RC);
    LAS unsigned char* lds = F.lds;
    LAS float* sgp = (LAS float*)(lds + SGP_OFF);
    LAS float* sgr = (LAS float*)(lds + SGR_OFF);
    __syncthreads();
    MSTAMP(22);
    u32x4 gv[16];
    const int ch = lane & 7;
#pragma unroll
    for (int L = 0; L < 16; ++L) {
        const int tok = 8 * L + (lane >> 3);
        gv[L] = __builtin_nontemporal_load((const GAS u32x4*)(PJ + (size_t)(t0 + tok) * PJW + 256 + 64 * gi + 8 * ch));
    }
#pragma unroll
    for (int L = 0; L < 16; ++L) {
        const int tok = 8 * L + (lane >> 3);
        float ss = 0.f;
#pragma unroll
        for (int e = 0; e < 4; ++e) { const float a = bflo(gv[L][e]), c = bfhi(gv[L][e]); ss += a * a + c * c; }
        ss += __shfl_xor(ss, 1); ss += __shfl_xor(ss, 2); ss += __shfl_xor(ss, 4);
        if (ch == 0) sgp[gi * 128 + tok] = ss;
    }
    __syncthreads();
    if (tid < 128) { float tot = 0.f;
#pragma unroll
        for (int g = 0; g < 8; ++g) tot += sgp[g * 128 + tid];
        sgr[tid] = 1.0f / sqrtf(tot * (1.0f / 512.0f) + EPS); }
    __syncthreads();
    MSTAMP(23);
    float gn[8];
    { const f32x4 a = *(const f32x4*)(F.in[I_SGU_NORM] + 64 * gi + 8 * ch), c = *(const f32x4*)(F.in[I_SGU_NORM] + 64 * gi + 8 * ch + 4);
      gn[0] = a[0]; gn[1] = a[1]; gn[2] = a[2]; gn[3] = a[3]; gn[4] = c[0]; gn[5] = c[1]; gn[6] = c[2]; gn[7] = c[3]; }
    LAS unsigned char* vcb = lds + gi * 16384;
#pragma unroll
    for (int L = 0; L < 16; ++L) {
        const int tok = 8 * L + (lane >> 3);
        const float r = sgr[tok];
        u32x4 w;
#pragma unroll
        for (int e = 0; e < 4; ++e) w[e] = pk2(bflo(gv[L][e]) * r * gn[2 * e], bfhi(gv[L][e]) * r * gn[2 * e + 1]);
        *(LAS u32x4*)(vcb + (ch >> 2) * 8192 + tok * 64 + (ch & 3) * 16) = w;
    }
    LDS_WAIT();
    __syncthreads();
    MSTAMP(24);
    const bf16_t* Wg = (const bf16_t*)(F.ws + WS_WRT + 512 * 1024) + (size_t)gi * 128 * 128;
    const float* bias = F.in[I_SGU_B] + gi * 128;
    const int vtr_off = ((lane & 15) >> 2) * 64 + (16 * ((lane >> 4) & 1) + 4 * (lane & 3)) * 2;
    f32x16 ov[4][2];
#pragma unroll
    for (int ib = 0; ib < 4; ++ib) {
        const int it = 32 * ib + ql;
        f32x16 a[2]; a[0] = f32x16{}; a[1] = f32x16{};
        const float bi = bias[it];
        const unsigned char* up = F.ws + WS_RD + ((size_t)((t0 >> 5) + ib) * 128 + 64 + 8 * gi) * 512 + ql * 16 + 8 * hh;
        u32x2 uw[2][4];
#pragma unroll
        for (int d = 0; d < 2; ++d)
#pragma unroll
            for (int g = 0; g < 4; ++g) uw[d][g] = __builtin_nontemporal_load((const GAS u32x2*)(up + (size_t)(4 * d + g) * 512));
        bf16x8 wfr[8];
#pragma unroll
        for (int js = 0; js < 2 * (ib + 1); ++js) wfr[js] = *(const GAS bf16x8*)(Wg + (size_t)it * 128 + 16 * js + 8 * hh);
        s16x4 vlo[8][2], vhi[8][2];
#pragma unroll
        for (int js = 0; js < 2 * (ib + 1); ++js)
#pragma unroll
            for (int d = 0; d < 2; ++d) { const LAS unsigned char* vp = vcb + d * 8192 + (16 * js + 8 * hh) * 64 + vtr_off; vlo[js][d] = vtr(vp); vhi[js][d] = vtr(vp + 4 * 64); }
#pragma unroll
        for (int js = 0; js < 2 * (ib + 1); ++js)
#pragma unroll
            for (int d = 0; d < 2; ++d) a[d] = MFMA32(cat8(vlo[js][d], vhi[js][d]), wfr[js], a[d]);
#pragma unroll
        for (int d = 0; d < 2; ++d)
#pragma unroll
            for (int g = 0; g < 4; ++g) {
                const u32x2 uu = uw[d][g];
                a[d][4 * g] = bflo(uu.x) * (a[d][4 * g] + bi); a[d][4 * g + 1] = bfhi(uu.x) * (a[d][4 * g + 1] + bi);
                a[d][4 * g + 2] = bflo(uu.y) * (a[d][4 * g + 2] + bi); a[d][4 * g + 3] = bfhi(uu.y) * (a[d][4 * g + 3] + bi);
            }
        ov[ib][0] = a[0]; ov[ib][1] = a[1];
        asm volatile("" ::: "memory");
    }
    MSTAMP(25);
    norm_store_unit(F, ov, ql, hh, (unsigned char*)MX + ((size_t)(t0 >> 5) * 128 + 64 + 8 * gi) * 512 + ql * 16 + 8 * hh);
    MSTAMP(26);
}

DI void mix_phase(Frame& F) {
    { const int i = F.bid * NTHR + F.tid;
      if (i < NMEM * 4 * 8) { const int piece = i & 7, kh = i >> 3, key = kh >> 2, h = kh & 3;
          const f32x4 p = *(const f32x4*)((const float*)(F.ws + WS_SSQK) + (size_t)kh * 4);
          const float r = 1.0f / sqrtf(((p[0] + p[1]) + (p[2] + p[3])) * (1.0f / 256.0f) + EPS);
          GAS u32x4* kp = (GAS u32x4*)((bf16_t*)(F.ws + WS_KMEM) + (size_t)key * D + h * 256 + piece * 32);
#pragma unroll
          for (int q = 0; q < 4; ++q) { u32x4 v = kp[q];
#pragma unroll
              for (int e = 0; e < 4; ++e) v[e] = pk2(bflo(v[e]) * r, bfhi(v[e]) * r);
              kp[q] = v; } } }
    MSTAMP(20);
    for (int uidx = F.bid; uidx < 256; uidx += F.G) attn_unit(F, uidx >> 5, uidx & 31);
    MSTAMP(21);
    for (int uidx = F.bid; uidx < 256; uidx += F.G) sgu_unit(F, uidx >> 5, uidx & 31);
    MSTAMP(27);
}

DI void xattn_unit(Frame& F, int pm, int pn) {
    if (F.wave >= 4) __builtin_amdgcn_s_setprio(1);
    int tid = F.tid; asm volatile("" : "+v"(tid));
    const int lane = tid & 63, ql = lane & 31, hh = lane >> 5, w = F.wave;
    const int b = pm >> 4, h = pn;
    const size_t row = (size_t)pm * 256 + 32 * w + ql;
    LAS unsigned char* lds = F.lds;
    const bf16_t* QC = (const bf16_t*)(F.ws + WS_RB);
    bf16x8 qf[16];
#pragma unroll
    for (int ks = 0; ks < 16; ++ks) qf[ks] = __builtin_nontemporal_load((const GAS bf16x8*)(QC + row * D + h * 256 + 16 * ks + 8 * hh));
    const f32x4 pq = *(const f32x4*)((const float*)(F.ws + WS_SSQQ) + (row * 4 + h) * 4);
    const float rq = (0.0625f * 1.4426950408889634f) / sqrtf(((pq[0] + pq[1]) + (pq[2] + pq[3])) * (1.0f / 256.0f) + EPS);
    __syncthreads();
    { const bf16_t* KM = (const bf16_t*)(F.ws + WS_KMEM) + (size_t)(b * MEML) * D + h * 256;
#pragma unroll 8
      for (int j = 0; j < 16; ++j) { const int p = tid + NTHR * j, key = p >> 5, c = p & 31;
          const u32x4 v = *(const GAS u32x4*)(KM + (size_t)key * D + 8 * c);
          *(LAS u32x4*)(lds + key * 512 + ((c ^ (key & 15)) << 4)) = v; } }
    __syncthreads();
    const float shift2 = *(const float*)(F.ws + WS_WRT + 256 * 1024);
    bf16x8 pf[8][2];
    float l = 0.f;
#pragma unroll
    for (int kt = 0; kt < 8; ++kt) {
        const int key = 32 * kt + ql;
        f32x16 a = {};
#pragma unroll
        for (int ks = 0; ks < 16; ++ks) {
            const bf16x8 kf = *(const LAS bf16x8*)(lds + key * 512 + (((2 * ks + hh) ^ (key & 15)) << 4));
            a = MFMA32(kf, qf[ks], a);
        }
#pragma unroll
        for (int r = 0; r < 16; ++r) { a[r] = __builtin_amdgcn_exp2f(a[r] * rq - shift2); l += a[r]; }
        pf[kt][0] = pack8(a[0], a[1], a[2], a[3], a[4], a[5], a[6], a[7]);
        pf[kt][1] = pack8(a[8], a[9], a[10], a[11], a[12], a[13], a[14], a[15]);
    }
    l += __shfl_xor(l, 32);
    __syncthreads();
    { const bf16_t* VM = (const bf16_t*)(F.ws + WS_VMT) + (size_t)(b * MEML) * D + h * 256;
#pragma unroll 8
      for (int j = 0; j < 16; ++j) { const int p = tid + NTHR * j, key = p >> 5, c = p & 31;
          const u32x4 v = *(const GAS u32x4*)(VM + (size_t)key * D + 8 * c);
          *(LAS u32x4*)(lds + (c >> 2) * 16384 + key * 64 + (c & 3) * 16) = v; } }
    __syncthreads();
    const int vtr_off = ((lane & 15) >> 2) * 64 + (16 * ((lane >> 4) & 1) + 4 * (lane & 3)) * 2;
    const float inv = 1.0f / l;
    unsigned char* OC = F.ws + WS_RD + ((size_t)(pm * 8 + w) * 128 + h * 32) * 512 + ql * 16 + 8 * hh;
#pragma unroll
    for (int d = 0; d < 8; ++d) {
        f32x16 o = {};
#pragma unroll
        for (int kt = 0; kt < 8; ++kt)
#pragma unroll
            for (int s2 = 0; s2 < 2; ++s2) {
                const LAS unsigned char* vp = lds + d * 16384 + (32 * kt + 16 * s2 + 4 * hh) * 64 + vtr_off;
                const s16x4 lo = vtr(vp), hi = vtr(vp + 8 * 64);
                o = MFMA32(cat8(lo, hi), pf[kt][s2], o);
            }
#pragma unroll
        for (int g = 0; g < 4; ++g) {
            u32x2 wv; wv.x = pk2(o[4 * g] * inv, o[4 * g + 1] * inv); wv.y = pk2(o[4 * g + 2] * inv, o[4 * g + 3] * inv);
            *(GAS u32x2*)(OC + (size_t)(4 * d + g) * 512) = wv;
        }
    }
    __builtin_amdgcn_s_setprio(0);
}
DI void xattn_phase(Frame& F) {
    for (int i = 0; i < 2; ++i) {
        const int L = i * F.G + F.bid; if (L >= 512) break;
        const int wg = xcd_remap(L, 512); int pm, pn; grouped_tile(wg, 128, 4, pm, pn);
        xattn_unit(F, pm, pn);
    }
    asm volatile("s_waitcnt vmcnt(0)" ::: "memory"); __syncthreads();
}

DI void route_phase(Frame& F, bool dummy) {
    const int lane = F.lane, tr = lane & 15, kq = lane >> 4, w = F.wave;
    const bf16_t* WRP = (const bf16_t*)(F.ws + WS_WRT);
    unsigned* cnt = (unsigned*)(F.ws + WS_CTL) + CW_CNT + (dummy ? 4096 : 0);
    int* LT = (int*)(F.ws + (dummy ? WS_RD : WS_LTOK)); float* LG = (float*)(F.ws + (dummy ? WS_RD + 8 * MiB : WS_LGATE)); float* LR = (float*)(F.ws + (dummy ? WS_RD + 16 * MiB : WS_LRSTD));
    LAS float* red = (LAS float*)(F.lds);
    LAS float* lgs = (LAS float*)(F.lds + 98304);
    LAS float* ssp = (LAS float*)(F.lds + 98304 + 25600);
    LAS unsigned* hist = (LAS unsigned*)(F.lds + 98304 + 25600 + 4096);
    bf16x8 bfr[4][3][2];
#pragma unroll
    for (int sp = 0; sp < 4; ++sp)
#pragma unroll
        for (int nb = 0; nb < 3; ++nb)
#pragma unroll
            for (int hl = 0; hl < 2; ++hl) bfr[sp][nb][hl] = *(const GAS bf16x8*)(WRP + ((size_t)(((4 * w + sp) * 3 + nb) * 2 + hl) * 64 + lane) * 8);
    for (int chunk = F.bid; chunk < T / 128; chunk += F.G) {
        __syncthreads();
        if (F.tid < 128) hist[F.tid] = 0u;
        const int tok0 = chunk * 128;
        const bf16_t* xbase = (const bf16_t*)(F.ws + WS_RC) + (size_t)(tok0 + tr) * D + 128 * w + 8 * kq;
        u32x4 xc[2][4], xn[2][4];
#pragma unroll
        for (int tq = 0; tq < 2; ++tq)
#pragma unroll
            for (int sp = 0; sp < 4; ++sp) xc[tq][sp] = *(const GAS u32x4*)(xbase + (size_t)(16 * tq) * D + 32 * sp);
#pragma unroll 1
        for (int half = 0; half < 4; ++half) {
            f32x4 acc[2][3];
            { const int hn = (half < 3) ? half + 1 : half;
#pragma unroll
              for (int tq = 0; tq < 2; ++tq)
#pragma unroll
                for (int sp = 0; sp < 4; ++sp) xn[tq][sp] = *(const GAS u32x4*)(xbase + (size_t)(16 * (2 * hn + tq)) * D + 32 * sp); }
#pragma unroll
            for (int tq = 0; tq < 2; ++tq) {
                const int tb = 2 * half + tq;
                float ss = 0.f;
                acc[tq][0] = (f32x4){0.f, 0.f, 0.f, 0.f}; acc[tq][1] = acc[tq][0]; acc[tq][2] = acc[tq][0];
#pragma unroll
                for (int sp = 0; sp < 4; ++sp) {
                    const u32x4 xw = xc[tq][sp];
#pragma unroll
                    for (int e = 0; e < 4; ++e) { const float a0 = bflo(xw[e]), a1 = bfhi(xw[e]); ss += a0 * a0 + a1 * a1; }
                    const bf16x8 ah = __builtin_bit_cast(bf16x8, xw);
#pragma unroll
                    for (int nb = 0; nb < 3; ++nb) {
                        acc[tq][nb] = __builtin_amdgcn_mfma_f32_16x16x32_bf16(ah, bfr[sp][nb][0], acc[tq][nb], 0, 0, 0);
                        acc[tq][nb] = __builtin_amdgcn_mfma_f32_16x16x32_bf16(ah, bfr[sp][nb][1], acc[tq][nb], 0, 0, 0);
                    }
                }
                ss += __shfl_xor(ss, 16); ss += __shfl_xor(ss, 32);
                if (kq == 0) ssp[w * 128 + 16 * tb + tr] = ss;
            }
#pragma unroll
            for (int tq = 0; tq < 2; ++tq)
#pragma unroll
                for (int sp = 0; sp < 4; ++sp) xc[tq][sp] = xn[tq][sp];
#pragma unroll
            for (int tq = 0; tq < 2; ++tq)
#pragma unroll
                for (int nb = 0; nb < 3; ++nb)
#pragma unroll
                    for (int r = 0; r < 4; ++r) red[w * 1536 + ((tq * 3 + nb) * 4 + r) * 64 + lane] = acc[tq][nb][r];
            __syncthreads();
#pragma unroll
            for (int q = 0; q < 3; ++q) {
                const int e = F.tid + 512 * q, idx = e >> 6, ln = e & 63;
                float sum = 0.f;
#pragma unroll
                for (int ww = 0; ww < 8; ++ww) sum += red[ww * 1536 + e];
                const int r = idx & 3, nb = (idx >> 2) % 3, tq = idx / 12;
                lgs[(16 * (2 * half + tq) + 4 * (ln >> 4) + r) * 49 + 16 * nb + (ln & 15)] = sum;
            }
            __syncthreads();
        }
        __syncthreads();
        int re1 = 0, re2 = 0; float g1 = 0.f, g2 = 0.f, rstd = 0.f; unsigned s1 = 0, s2 = 0;
        const int t = F.tid;
        if (t < 128) {
            float ss = 0.f;
#pragma unroll
            for (int q = 0; q < 8; ++q) ss += ssp[q * 128 + t];
            rstd = 1.0f / sqrtf(ss * (1.0f / D) + EPS);
            float lg[36];
#pragma unroll
            for (int e = 0; e < 36; ++e) lg[e] = lgs[t * 49 + e] * rstd;
            float gmax = lg[0]; int gi = 0;
#pragma unroll
            for (int j = 1; j < 4; ++j) if (lg[j] > gmax) { gmax = lg[j]; gi = j; }
            float den = 0.f;
#pragma unroll
            for (int j = 0; j < 4; ++j) den += __expf(lg[j] - gmax);
            const float gwt = 1.0f / den;
            float le[8];
#pragma unroll
            for (int e = 0; e < 8; ++e) le[e] = gi == 0 ? lg[4 + e] : (gi == 1 ? lg[12 + e] : (gi == 2 ? lg[20 + e] : lg[28 + e]));
            float t1 = le[0]; int i1 = 0;
#pragma unroll
            for (int e = 1; e < 8; ++e) if (le[e] > t1) { t1 = le[e]; i1 = e; }
            float t2 = -INFINITY; int i2 = 0;
#pragma unroll
            for (int e = 0; e < 8; ++e) if (e != i1 && le[e] > t2) { t2 = le[e]; i2 = e; }
            const float ex = __expf(t2 - t1), p1 = 1.0f / (1.0f + ex), p2 = ex * p1;
            re1 = gi * 8 + i1; re2 = gi * 8 + i2; g1 = p1 * gwt; g2 = p2 * gwt;
            s1 = __hip_atomic_fetch_add(hist + re1, 1u, __ATOMIC_RELAXED, __HIP_MEMORY_SCOPE_WORKGROUP); s2 = __hip_atomic_fetch_add(hist + re2, 1u, __ATOMIC_RELAXED, __HIP_MEMORY_SCOPE_WORKGROUP);
        }
        __syncthreads();
        if (t < 64) { const unsigned c = hist[t]; hist[64 + t] = c ? __hip_atomic_fetch_add(cnt + 64 * t, c, RLX_AGENT) : 0u; }
        __syncthreads();
        if (t < 128) {
            const size_t p1 = (size_t)re1 * CAP + hist[64 + re1] + s1, p2 = (size_t)re2 * CAP + hist[64 + re2] + s2;
            LT[p1] = 2 * (tok0 + t); LG[p1] = g1; LR[p1] = rstd;
            LT[p2] = 2 * (tok0 + t) + 1; LG[p2] = g2; LR[p2] = rstd;
        }
    }
}
DI void build_tile_table(Frame& F) {
    LAS int* tbl = (LAS int*)(F.lds + TBL_OFF);
    unsigned* cnt = (unsigned*)(F.ws + WS_CTL) + CW_CNT;
    __syncthreads();
    if (F.tid < 64) tbl[F.tid] = (F.tid < 32) ? (int)__hip_atomic_load(cnt + 64 * F.tid, RLX_AGENT) : 0;
    __syncthreads();
    if (F.tid == 0) { int a = 0; for (int j = 0; j < 64; ++j) { tbl[64 + j] = a; a += (tbl[j] + 255) >> 8; } tbl[128] = a; }
    __syncthreads();
}

DI void final_phase(Frame& F) {
    const bf16_t* C0 = (const bf16_t*)(F.ws + WS_RB); const bf16_t* C1 = (const bf16_t*)(F.ws + WS_RA); const bf16_t* X2 = (const bf16_t*)(F.ws + WS_RC);
    const size_t n8 = (size_t)T * D / 8;
    for (size_t i = (size_t)F.bid * NTHR + F.tid; i < n8; i += (size_t)F.G * NTHR) {
        const u32x4 a = __builtin_nontemporal_load((const GAS u32x4*)(C0 + i * 8)), b = __builtin_nontemporal_load((const GAS u32x4*)(C1 + i * 8)), x = __builtin_nontemporal_load((const GAS u32x4*)(X2 + i * 8));
        GAS f32x4* o = (GAS f32x4*)(F.out + i * 8);
        f32x4 o0, o1;
        o0[0] = bflo(x.x) + (bflo(a.x) + bflo(b.x)); o0[1] = bfhi(x.x) + (bfhi(a.x) + bfhi(b.x)); o0[2] = bflo(x.y) + (bflo(a.y) + bflo(b.y)); o0[3] = bfhi(x.y) + (bfhi(a.y) + bfhi(b.y));
        o1[0] = bflo(x.z) + (bflo(a.z) + bflo(b.z)); o1[1] = bfhi(x.z) + (bfhi(a.z) + bfhi(b.z)); o1[2] = bflo(x.w) + (bflo(a.w) + bflo(b.w)); o1[3] = bfhi(x.w) + (bfhi(a.w) + bfhi(b.w));
        __builtin_nontemporal_store(o0, o); __builtin_nontemporal_store(o1, o + 1);
    }
}

__global__ void __launch_bounds__(NTHR, 2) fwd_kernel(Args args) {
    extern __shared__ __attribute__((aligned(16))) unsigned char lds_raw[];
    Frame F;
    F.lds = (LAS unsigned char*)lds_raw;
    F.ws = args.ws; F.out = args.out; F.in = args.in;
    F.tid = threadIdx.x; F.lane = F.tid & 63; F.wave = __builtin_amdgcn_readfirstlane(F.tid >> 6);
    F.G = gridDim.x; F.bid = blockIdx.x;
    for (int u = F.tid; u < (LDS_BYTES - LDSCTL_OFF) / 4; u += NTHR) ((LAS unsigned*)(F.lds + LDSCTL_OFF))[u] = 0u;
    __syncthreads();
    unsigned* ctl = (unsigned*)(args.ws + WS_CTL);
    const int lo = args.ph_lo, hi = args.ph_hi;
    XcdBarrier bar; bar.bar = ctl + CW_BAR; bar.x = 0; bar.st = nullptr;
    if (hi - lo > 1) bar = xcd_barrier_post(ctl + CW_BAR, (volatile LAS unsigned*)(F.lds + MISC_OFF) + 8);
    Sched S; S.G = F.G; S.c = F.bid; S.ws = F.ws; S.tbl = (const LAS int*)(F.lds + TBL_OFF); S.round = 0;
    EpiCtx E; E.ws = F.ws; E.out = F.out; E.in = F.in;
#define IN(k) (lo <= (k) && (k) < hi)
#define SEAM(k) do { if (IN(k) && IN((k) + 1)) xcd_barrier(bar); } while (0)
#ifndef DUP_PHASE
#define DUP_PHASE -1
#endif
#ifndef TS_UNIT
#define TS_UNIT 100
#endif
#if TS_PHASE >= 0
    volatile LAS unsigned long long* tsw = (volatile LAS unsigned long long*)(F.lds + MISC_OFF + 64);
#define STAMP(k) do { if (F.tid == 0) tsw[k] = __builtin_amdgcn_s_memrealtime(); } while (0)
#else
#define STAMP(k) do { } while (0)
#endif
    STAMP(0);
#define RUNPH(k, body) do { if (IN(k)) { const int nrep_ = (DUP_PHASE == (k)) ? 2 + (lo >> 20) : 1; for (int rep_ = 0; rep_ < nrep_; ++rep_) { if (rep_) xcd_barrier(bar); body; } } SEAM(k); STAMP((k) + 1); } while (0)
    RUNPH(PH_P0, p0_prologue(F));
#if DUP_PHASE == 100
    for (int i = 0; i < 4; ++i) xcd_barrier(bar);
#endif
    RUNPH(PH_PROJ, { const bool conv_first = (F.bid & 7) < 4; if (conv_first) p0b_expert_weights(F); gemm_phase<PH_PROJ>(F.lds, S, E); gemm_phase<PH_MEMK>(F.lds, S, E); gemm_phase<PH_MEMV>(F.lds, S, E); if (!conv_first) p0b_expert_weights(F); });
    RUNPH(PH_MIX, mix_phase(F));
    RUNPH(PH_WOUT, gemm_phase<PH_WOUT>(F.lds, S, E));
    RUNPH(PH_WCQ, { gemm_phase<PH_WCQ>(F.lds, S, E); xattn_phase(F); });
    STAMP(PH_SC + 1); STAMP(PH_PV + 1);
    RUNPH(PH_WCO, gemm_phase<PH_WCO>(F.lds, S, E));
    RUNPH(PH_ROUTE, route_phase(F, rep_ + 1 < nrep_));
    RUNPH(PH_UP, { build_tile_table(F); gemm_phase<PH_UP>(F.lds, S, E); (gemm_phase<PH_UP, 1>)(F.lds, S, E); (gemm_phase<PH_UP, 2>)(F.lds, S, E); });
    RUNPH(PH_DOWN0, { build_tile_table(F); gemm_phase<PH_DOWN0>(F.lds, S, E); (gemm_phase<PH_DOWN0, 1>)(F.lds, S, E); (gemm_phase<PH_DOWN0, 2>)(F.lds, S, E); });
    RUNPH(PH_DOWN1, final_phase(F));
#if TS_PHASE >= 0
    xcd_barrier(bar);
    if (F.bid == 0 && F.tid == 0) { const unsigned long long dt = (TS_PHASE == 30 ? (tsw[PH_N] - tsw[0]) : (tsw[TS_PHASE + 1] - tsw[TS_PHASE])) / TS_UNIT; F.out[0] += (float)(dt > 250ull ? 250ull : dt); }
#endif
#undef RUNPH
#undef IN
#undef SEAM
}

#ifndef N_LAUNCH_MODE
#define N_LAUNCH_MODE 1
#endif
extern "C" void kernel_launch(void* const* d_in, const int* in_sizes, int n_in, void* d_out, int out_size, void* d_ws, size_t ws_size, hipStream_t stream) {
    static int grid = 0;
    if (grid == 0) {
        if (n_in != 27 || out_size != T * D || ws_size < WS_END) { fprintf(stderr, "kernel_launch: unexpected shapes (n_in %d out %d ws %zu)\n", n_in, out_size, ws_size); grid = -1; return; }
        int dev = 0, cus = 0, per_cu = 0;
        if (hipGetDevice(&dev) != hipSuccess || hipDeviceGetAttribute(&cus, hipDeviceAttributeMultiprocessorCount, dev) != hipSuccess) { grid = -1; return; }
        if (hipFuncSetAttribute((const void*)fwd_kernel, hipFuncAttributeMaxDynamicSharedMemorySize, LDS_BYTES) != hipSuccess) { fprintf(stderr, "kernel_launch: hipFuncSetAttribute failed\n"); grid = -1; return; }
        if (hipOccupancyMaxActiveBlocksPerMultiprocessor(&per_cu, (const void*)fwd_kernel, NTHR, LDS_BYTES) != hipSuccess || per_cu < 1) { fprintf(stderr, "kernel_launch: occupancy query says %d\n", per_cu); }
        (void)hipGetLastError();
        grid = cus;
    }
    if (grid < 0) return;
    (void)hipMemsetAsync((char*)d_ws + WS_CTL, 0, CTL_ZERO_BYTES, stream);
    Args a{};
    for (int i = 0; i < 27; ++i) a.in[i] = (const float*)d_in[i];
    a.out = (float*)d_out; a.ws = (unsigned char*)d_ws;
    if (N_LAUNCH_MODE == 1) { a.ph_lo = 0; a.ph_hi = PH_N; hipLaunchKernelGGL(fwd_kernel, dim3(grid), dim3(NTHR), LDS_BYTES, stream, a); }
    else for (int p = 0; p < PH_N; ++p) { a.ph_lo = p; a.ph_hi = p + 1; hipLaunchKernelGGL(fwd_kernel, dim3(grid), dim3(NTHR), LDS_BYTES, stream, a); }
}
```

```cpp
#include <hip/hip_runtime.h>
#include <hip/hip_bf16.h>
#include <cstdio>
#include <cstdint>

#define GAS __attribute__((address_space(1)))
#define LAS __attribute__((address_space(3)))
typedef unsigned short bf16_t;
typedef short bf16x8 __attribute__((ext_vector_type(8)));
typedef short s16x4 __attribute__((ext_vector_type(4)));
typedef float f32x4 __attribute__((ext_vector_type(4)));
typedef float f32x2 __attribute__((ext_vector_type(2)));
typedef float f32x16 __attribute__((ext_vector_type(16)));
typedef unsigned u32x4 __attribute__((ext_vector_type(4)));
typedef unsigned u32x2 __attribute__((ext_vector_type(2)));
typedef __bf16 bf16x2_t __attribute__((ext_vector_type(2)));
#define DI __device__ __forceinline__

#ifndef TS_PHASE
#define TS_PHASE -1
#endif
constexpr int T = 32768, D = 1024, BATCH = 8, SEQ = 4096, MEML = 256, NMEM = BATCH * MEML;
constexpr int INW = 1792;
constexpr int PJW = 768;
constexpr float EPS = 1e-6f;
constexpr int NWAVES = 8, NTHR = 512;
constexpr int CAP = 32768;
constexpr int MAXRT = 320;

constexpr size_t MiB = 1u << 20;
constexpr size_t WS_CTL = 0, CTL_ZERO_BYTES = 64 * 1024;
constexpr size_t WS_WRT = 1 * MiB;
constexpr size_t WS_SSQ1P = 2 * MiB;
constexpr size_t WS_SSQQ = 4 * MiB;
constexpr size_t WS_LSUM = 6 * MiB;
constexpr size_t WS_SSQK = 8 * MiB;
constexpr size_t WS_RSTDK = 8 * MiB + 512 * 1024;
constexpr size_t WS_RSTD0 = 9 * MiB;
constexpr size_t WS_LTOK = 10 * MiB, WS_LGATE = 18 * MiB, WS_LRSTD = 26 * MiB;
constexpr size_t WS_WIN = 34 * MiB, WS_WOUT = 38 * MiB, WS_WCQ = 40 * MiB, WS_WCK = 42 * MiB, WS_WCV = 44 * MiB, WS_WCO = 46 * MiB;
constexpr size_t WS_W13 = 48 * MiB, WS_W2 = 112 * MiB;
constexpr size_t WS_MEMB = 144 * MiB, WS_KMEM = 148 * MiB, WS_VMT = 152 * MiB;
constexpr size_t WS_RA = 156 * MiB;
constexpr size_t WS_RB = 220 * MiB;
constexpr size_t WS_RC = 332 * MiB;
constexpr size_t WS_RD = 396 * MiB;
constexpr size_t WS_END = 476 * MiB;
constexpr int CW_BAR = 4096, CW_CNT = 8192;

constexpr int RING_BYTES = 131072;
constexpr int LDS_BYTES = 147456;
constexpr int LDSCTL_OFF = RING_BYTES, MISC_OFF = LDS_BYTES - 256;
constexpr int TBL_OFF = RING_BYTES + 512;
constexpr int XCH_OFF = RING_BYTES + 2048;
constexpr int SGP_OFF = RING_BYTES + 4096;
constexpr int SGR_OFF = RING_BYTES + 8192;
constexpr int RT_XT_BYTES = 16 * 260 * 4;
constexpr int RT_HIST_OFF = 8 * RT_XT_BYTES;

#define RLX_AGENT __ATOMIC_RELAXED, __HIP_MEMORY_SCOPE_AGENT
#define LDS_WAIT() asm volatile("s_waitcnt lgkmcnt(0)" ::: "memory")
#define VM_WAIT() asm volatile("s_waitcnt vmcnt(0)" ::: "memory")
DI unsigned f2bf(float f) { unsigned u = __builtin_bit_cast(unsigned, f); return (u + 0x7fffu + ((u >> 16) & 1u)) >> 16; }
DI unsigned pk2(float lo, float hi) { f32x2 v = {lo, hi}; bf16x2_t b = __builtin_convertvector(v, bf16x2_t); return __builtin_bit_cast(unsigned, b); }
DI float bf2f(unsigned short h) { return __builtin_bit_cast(float, (unsigned)h << 16); }
DI float bflo(unsigned w) { return __builtin_bit_cast(float, w << 16); }
DI float bfhi(unsigned w) { return __builtin_bit_cast(float, w & 0xffff0000u); }
DI float wave_sum(float v) {
#pragma unroll
    for (int o = 1; o < 64; o <<= 1) v += __shfl_xor(v, o);
    return v;
}
DI float fast_exp(float x) { return __builtin_amdgcn_exp2f(x * 1.4426950408889634f); }
DI float gelu_tanh(float x) {
    const float z2 = 1.5957691216057308f * (x + 0.044715f * x * x * x);
    return x * __builtin_amdgcn_rcpf(1.0f + fast_exp(-z2));
}
DI float silu(float x) { return x * __builtin_amdgcn_rcpf(1.0f + fast_exp(-x)); }

#define XB_TMO      128
#define XB_XCNT(j)  (256  + 64 * (j))
#define XB_XSUB(j)  (1280 + 64 * (j))
#define XB_XGEN(j)  (2304 + 64 * (j))
#define XB_TOP      3328
#define XB_TOPGEN   3392
#define XCD_BAR_WORDS 3456
#define XB_SPIN_CAP (1u << 18)
DI unsigned xb_ld(unsigned* p)              { return __hip_atomic_load(p, __ATOMIC_RELAXED, __HIP_MEMORY_SCOPE_AGENT); }
DI unsigned xb_add(unsigned* p, unsigned v) { return __hip_atomic_fetch_add(p, v, __ATOMIC_RELAXED, __HIP_MEMORY_SCOPE_AGENT); }
DI unsigned xb_xcc_id() { return (unsigned)__builtin_amdgcn_s_getreg((3 << 11) | 20) & 0xFu; }
#define XB_SPIN(cond, bar) do { unsigned _sp = 0; while (cond) { __builtin_amdgcn_s_sleep(1); \
    if ((++_sp & 255u) == 0u) { if (xb_ld(&(bar)[XB_TMO])) break; if (_sp > XB_SPIN_CAP) { atomicAdd(&(bar)[XB_TMO], 1u); break; } } } } while (0)
struct XcdBarrier { unsigned* bar; unsigned x; volatile LAS unsigned* st; };
DI XcdBarrier xcd_barrier_post(unsigned* bar, volatile LAS unsigned* st) {
    XcdBarrier b; b.bar = bar; b.x = xb_xcc_id(); b.st = st;
    if (threadIdx.x == 0) (void)xb_add(&bar[XB_XCNT(b.x)], 1u);
    return b;
}
DI void xcd_barrier_complete(unsigned* bar, unsigned x, unsigned& nloc, unsigned& nx) {
    const unsigned G = gridDim.x * gridDim.y * gridDim.z;
    unsigned sum, cnt, mine, sp = 0u;
    for (;;) {
        sum = 0u; cnt = 0u; mine = 0u;
#pragma unroll
        for (unsigned j = 0; j < 16; ++j) { const unsigned c = xb_ld(&bar[XB_XCNT(j)]); sum += c; cnt += (c > 0u) ? 1u : 0u; mine = (j == x) ? c : mine; }
        if (sum == G) break;
        __builtin_amdgcn_s_sleep(1);
        if ((++sp & 255u) == 0u) { if (xb_ld(&bar[XB_TMO])) break; if (sp > XB_SPIN_CAP) { atomicAdd(&bar[XB_TMO], 1u); break; } }
    }
    nloc = mine > 0u ? mine : 1u; nx = cnt > 0u ? cnt : 1u;
}
DI void xcd_barrier(const XcdBarrier& b) {
    asm volatile("s_waitcnt vmcnt(0)" ::: "memory");
    __syncthreads();
    if (threadIdx.x == 0) {
        unsigned* bar = b.bar;
        __builtin_amdgcn_s_waitcnt(0);
        unsigned nloc = b.st[0], nx = b.st[1];
        if (nloc == 0u) { xcd_barrier_complete(bar, b.x, nloc, nx); b.st[0] = nloc; b.st[1] = nx; }
        const unsigned old = xb_add(&bar[XB_XSUB(b.x)], 1u);
        const unsigned gen = old / nloc;
        if (old + 1u == (gen + 1u) * nloc) {
            __builtin_amdgcn_fence(__ATOMIC_RELEASE, "agent");
            asm volatile("s_waitcnt vmcnt(0)" ::: "memory");
            const unsigned og = xb_add(&bar[XB_TOP], 1u);
            const unsigned tg = og / nx;
            if (og + 1u == (tg + 1u) * nx) xb_add(&bar[XB_TOPGEN], 1u);
            else XB_SPIN(xb_ld(&bar[XB_TOPGEN]) == tg, bar);
            __builtin_amdgcn_fence(__ATOMIC_ACQUIRE, "agent");
            xb_add(&bar[XB_XGEN(b.x)], 1u);
            asm volatile("s_waitcnt vmcnt(0)" ::: "memory");
        } else {
            XB_SPIN(xb_ld(&bar[XB_XGEN(b.x)]) == gen, bar);
            __builtin_amdgcn_fence(__ATOMIC_ACQUIRE, "agent");
            asm volatile("s_waitcnt vmcnt(0)" ::: "memory");
        }
    }
    __syncthreads();
}

struct Args {
    const float* in[27];
    float* out; unsigned char* ws;
    int ph_lo, ph_hi;
};
struct Frame {
    LAS unsigned char* lds;
    unsigned char* ws; float* out;
    int tid, lane, wave, G, bid;
    const float* const* in;
};
enum { I_X = 0, I_MEM, I_NORM_MIX, I_W_IN, I_Q_NORM, I_K_NORM, I_SINKS, I_SGU_NORM, I_SGU_W, I_SGU_B, I_ON_ATTN, I_ON_SGU, I_W_OUT,
       I_NORM_CROSS, I_NORM_MEM, I_W_CQ, I_W_CK, I_W_CV, I_CQ_NORM, I_CK_NORM, I_W_CO, I_NORM_FFN, I_WRG, I_WRE, I_W1, I_W3, I_W2 };

DI void p0_transpose_item(const float* W, int N, bf16_t* WT, int ldt, int row_off, const float* gain, LAS unsigned* scr, int kb, int nb, int lane) {
    const int k0 = 64 * kb, n0 = 64 * nb, c = lane & 15, kp = lane >> 4;
    f32x4 va[8], vb[8];
#pragma unroll
    for (int i = 0; i < 8; ++i) { const int kk = 2 * (kp + 4 * i);
        va[i] = __builtin_nontemporal_load((const GAS f32x4*)(W + (size_t)(k0 + kk) * N + n0 + 4 * c)); vb[i] = __builtin_nontemporal_load((const GAS f32x4*)(W + (size_t)(k0 + kk + 1) * N + n0 + 4 * c)); }
#pragma unroll
    for (int i = 0; i < 8; ++i) { const int kk = 2 * (kp + 4 * i);
        float ga = 1.f, gb = 1.f; if (gain) { ga = gain[k0 + kk]; gb = gain[k0 + kk + 1]; }
#pragma unroll
        for (int e = 0; e < 4; ++e) scr[(4 * c + e) * 33 + (kp + 4 * i)] = pk2(va[i][e] * ga, vb[i][e] * gb); }
    LDS_WAIT(); asm volatile("" ::: "memory");
    const int ch = lane & 7;
#pragma unroll
    for (int j = 0; j < 8; ++j) { const int n = (lane >> 3) + 8 * j; const LAS unsigned* sp = scr + n * 33 + 4 * ch;
        u32x4 o; o.x = sp[0]; o.y = sp[1]; o.z = sp[2]; o.w = sp[3];
        *(GAS u32x4*)(WT + (size_t)(row_off + n0 + n) * ldt + k0 + 8 * ch) = o; }
    LDS_WAIT(); asm volatile("" ::: "memory");
}
DI void rms_row_to_bf16(const float* xrow, bf16_t* orow, int lane, float* rstd_out) {
    const GAS f32x4* xr = (const GAS f32x4*)xrow + lane;
    f32x4 v[4]; float s = 0.f;
#pragma unroll
    for (int j = 0; j < 4; ++j) { v[j] = __builtin_nontemporal_load(xr + 64 * j); s += (v[j].x * v[j].x + v[j].y * v[j].y) + (v[j].z * v[j].z + v[j].w * v[j].w); }
    float rstd = 1.0f / sqrtf(wave_sum(s) * (1.f / D) + EPS);
    if (rstd_out) { if (lane == 0) *rstd_out = rstd; rstd = 1.0f; }
    GAS u32x2* o8 = (GAS u32x2*)orow + lane;
#pragma unroll
    for (int j = 0; j < 4; ++j) { u32x2 w; w.x = pk2(v[j].x * rstd, v[j].y * rstd); w.y = pk2(v[j].z * rstd, v[j].w * rstd); o8[64 * j] = w; }
}
DI void p0_prologue(Frame& F) {
    LAS unsigned* scr = (LAS unsigned*)(F.lds + F.wave * 16384);
    const int gw = F.bid * NWAVES + F.wave, NGW = F.G * NWAVES, lane = F.lane;
    unsigned char* ws = F.ws;
    constexpr int I_IN = 16 * 28, I_SQ = 16 * 16, I_E1 = 32 * 16 * 8, I_E2 = 32 * 8 * 16;
    constexpr int NITEMS = I_IN + 2 * I_SQ;
    for (int it = gw; it < NITEMS; it += NGW) {
        int r = it;
        if (r < I_IN) { p0_transpose_item(F.in[I_W_IN], INW, (bf16_t*)(ws + WS_WIN), D, 0, F.in[I_NORM_MIX], scr, r / 28, r % 28, lane); continue; } r -= I_IN;
        if (r < I_SQ) { p0_transpose_item(F.in[I_W_CK], D, (bf16_t*)(ws + WS_WCK), D, 0, F.in[I_NORM_MEM], scr, r / 16, r % 16, lane); continue; } r -= I_SQ;
        if (r < I_SQ) { p0_transpose_item(F.in[I_W_CV], D, (bf16_t*)(ws + WS_WCV), D, 0, F.in[I_NORM_MEM], scr, r / 16, r % 16, lane); continue; } r -= I_SQ;
    }
    (void)I_E1; (void)I_E2;
#if 0
        if (r < I_E1) { const int e = r / 128, q = r % 128;
                        p0_transpose_item(F.in[I_W1] + (size_t)e * D * 512, 512, (bf16_t*)(ws + WS_W13) + (size_t)e * 1024 * 1024, D, 0, F.in[I_NORM_FFN], scr, q / 8, q % 8, lane); continue; } r -= I_E1;
        if (r < I_E1) { const int e = r / 128, q = r % 128;
                        p0_transpose_item(F.in[I_W3] + (size_t)e * D * 512, 512, (bf16_t*)(ws + WS_W13) + (size_t)e * 1024 * 1024, D, 512, F.in[I_NORM_FFN], scr, q / 8, q % 8, lane); continue; } r -= I_E1;
        { const int e = r / 128, q = r % 128;
          p0_transpose_item(F.in[I_W2] + (size_t)e * 512 * D, D, (bf16_t*)(ws + WS_W2) + (size_t)e * 1024 * 512, 512, 0, nullptr, scr, q / 16, q % 16, lane); }
    }
#endif
    for (int m = gw; m < T + NMEM; m += NGW) {
        if (m < T) rms_row_to_bf16(F.in[I_X] + (size_t)m * D, (bf16_t*)(ws + WS_RA) + (size_t)m * D, lane, (float*)(ws + WS_RSTD0) + m);
        else rms_row_to_bf16(F.in[I_MEM] + (size_t)(m - T) * D, (bf16_t*)(ws + WS_MEMB) + (size_t)(m - T) * D, lane, nullptr);
    }
    {
        bf16_t* swb = (bf16_t*)(ws + WS_WRT + 512 * 1024);
        for (int i = F.bid * NTHR + F.tid; i < 8 * 128 * 128 / 8; i += F.G * NTHR) {
            const int j8 = (i & 15) * 8, ii = (i >> 4) & 127;
            const f32x4 a = *(const f32x4*)(F.in[I_SGU_W] + (size_t)i * 8), c = *(const f32x4*)(F.in[I_SGU_W] + (size_t)i * 8 + 4);
            float v[8] = {a[0], a[1], a[2], a[3], c[0], c[1], c[2], c[3]};
#pragma unroll
            for (int e = 0; e < 8; ++e) v[e] = (j8 + e <= ii) ? v[e] : 0.f;
            u32x4 w; w.x = pk2(v[0], v[1]); w.y = pk2(v[2], v[3]); w.z = pk2(v[4], v[5]); w.w = pk2(v[6], v[7]);
            *(GAS u32x4*)(swb + (size_t)i * 8) = w;
        }
    }
    if (F.bid == 0 && F.wave == 0) {
        float a = 0.f, b = 0.f;
        for (int i = lane; i < 256; i += 64) { a = fmaxf(a, fabsf(F.in[I_CQ_NORM][i])); b = fmaxf(b, fabsf(F.in[I_CK_NORM][i])); }
#pragma unroll
        for (int o = 1; o < 64; o <<= 1) { a = fmaxf(a, __shfl_xor(a, o)); b = fmaxf(b, __shfl_xor(b, o)); }
        if (lane == 0) *(float*)(ws + WS_WRT + 256 * 1024) = 16.0f * a * b * 1.4426950408889634f;
    }
    {
        bf16_t* wrp = (bf16_t*)(ws + WS_WRT);
        for (int i = F.bid * NTHR + F.tid; i < 32 * 3 * 64 * 8; i += F.G * NTHR) {
            const int j = i & 7, ln = (i >> 3) & 63, nb = (i >> 9) % 3, sidx = i / 1536;
            const int k = 32 * sidx + 8 * (ln >> 4) + j, e = 16 * nb + (ln & 15);
            float w = 0.f;
            if (e < 4) w = F.in[I_WRG][k * 4 + e];
            else if (e < 36) { const int g = (e - 4) >> 3, ee = (e - 4) & 7; w = F.in[I_WRE][((size_t)g * D + k) * 8 + ee]; }
            w *= F.in[I_NORM_FFN][k];
            const unsigned h = f2bf(w); const unsigned l = f2bf(w - bf2f((unsigned short)h));
            wrp[((size_t)((sidx * 3 + nb) * 2 + 0) * 64 + ln) * 8 + j] = (bf16_t)h;
            wrp[((size_t)((sidx * 3 + nb) * 2 + 1) * 64 + ln) * 8 + j] = (bf16_t)l;
        }
    }
}

DI void p0b_expert_weights(Frame& F) {
    LAS unsigned* scr = (LAS unsigned*)(F.lds + F.wave * 16384);
    int lane = F.lane; asm volatile("" : "+v"(lane));
    unsigned char* ws = F.ws;
    constexpr int I_E1 = 32 * 16 * 8, I_E2 = 32 * 8 * 16, I_SQ = 16 * 16, NIT = 2 * I_E1 + I_E2 + 3 * I_SQ;
    const int c = F.bid, G = F.G;
    int i0, i1;
    if (G == 256) { const int w0 = c < 192 ? 2 * c : 384 + 4 * (c - 192), w1 = w0 + (c < 192 ? 2 : 4); i0 = (int)(((long)w0 * NIT) / 640); i1 = (int)(((long)w1 * NIT) / 640); }
    else { i0 = (int)(((long)c * NIT) / G); i1 = (int)(((long)(c + 1) * NIT) / G); }
#pragma unroll 1
    for (int it = i0 + F.wave; it < i1; it += NWAVES) {
        const float* W; int N, ldt, row_off, kb, nb; bf16_t* WT; const float* gain;
        if (it < 2 * I_E1) { const int which = it < I_E1 ? 0 : 1, r = it - which * I_E1, e = r >> 7, q = r & 127;
            W = F.in[which == 0 ? I_W1 : I_W3] + (size_t)e * D * 512; N = 512; WT = (bf16_t*)(ws + WS_W13) + (size_t)e * 1024 * 1024; ldt = D; row_off = which * 512; gain = F.in[I_NORM_FFN]; kb = q >> 3; nb = q & 7; }
        else if (it < 2 * I_E1 + I_E2) { const int r = it - 2 * I_E1, e = r >> 7, q = r & 127;
            W = F.in[I_W2] + (size_t)e * 512 * D; N = D; WT = (bf16_t*)(ws + WS_W2) + (size_t)e * 1024 * 512; ldt = 512; row_off = 0; gain = nullptr; kb = q >> 4; nb = q & 15; }
        else { const int r = it - 2 * I_E1 - I_E2, m = r >> 8, q = r & 255; kb = q >> 4; nb = q & 15; N = D; ldt = D; row_off = 0;
            if (m == 0) { W = F.in[I_W_OUT]; WT = (bf16_t*)(ws + WS_WOUT); gain = (kb < 8) ? F.in[I_ON_ATTN] : (F.in[I_ON_SGU] - 512); }
            else if (m == 1) { W = F.in[I_W_CQ]; WT = (bf16_t*)(ws + WS_WCQ); gain = F.in[I_NORM_CROSS]; }
            else { W = F.in[I_W_CO]; WT = (bf16_t*)(ws + WS_WCO); gain = nullptr; } }
        p0_transpose_item(W, N, WT, ldt, row_off, gain, scr, kb, nb, lane);
    }
    asm volatile("s_waitcnt vmcnt(0) lgkmcnt(0)" ::: "memory"); __syncthreads();
}

constexpr int BM = 256, BK = 64, HALF = 128, HTB = HALF * BK * 2;
DI int lds_byte(int r, int c) { const int st = (r >> 4) * 2 + (c >> 5), rr = r & 15, cc = c & 31, ob = rr * 64 + cc * 2; return st * 1024 + (ob ^ (((ob >> 9) & 1) << 5)); }
DI void stage_rc(int b, int& R, int& C) { const int st = b / 1024, sb = b % 1024, swz = sb ^ (((sb >> 9) & 1) << 5); R = (st >> 1) * 16 + swz / 64; C = (st & 1) * 32 + (swz % 64) / 2; }
DI int perm32(int rho) { const int n = rho >> 4, i = rho & 15; return 8 * (i >> 2) + 4 * n + (i & 3); }

enum { K_PROJ = 0, K_MEMK, K_MEMVT, K_WOUT, K_WCQ, K_SC, K_PV, K_WCO, K_UP, K_DOWN };
enum { PH_MEMK = 100, PH_MEMV = 101 };
enum { PH_P0 = 0, PH_PROJ, PH_MIX, PH_WOUT, PH_WCQ, PH_SC, PH_PV, PH_WCO, PH_ROUTE, PH_UP, PH_DOWN0, PH_DOWN1, PH_N };

struct GUnit {
    int half;
    const char* A; const char* B;
    int kind, pm, pn;
    const int* gl; int gcnt;
    int aux;
};

DI int xcd_remap(int wgid, int nwg) { const int q = nwg / 8, r = nwg % 8, xcd = wgid % 8, off = wgid / 8; return (xcd < r ? xcd * (q + 1) : r * (q + 1) + (xcd - r) * q) + off; }
DI void grouped_tile(int wgid, int nM, int nN, int& pm, int& pn) {
    const int nig = 8 * nN, gid = wgid / nig, fm = gid * 8, gsz = (nM - fm) < 8 ? (nM - fm) : 8;
    pm = fm + ((wgid % nig) % gsz); pn = (wgid % nig) / gsz;
}

struct Sched { int G, c; unsigned char* ws; const LAS int* tbl; int round; };
template <int PH> struct PCfg { static constexpr int K = 1024; static constexpr unsigned lda2 = 2048, ldb2 = 2048, hstepB = 32 * 2048; static constexpr int RS = 64; };
template <> struct PCfg<PH_UP> { static constexpr int K = 1024; static constexpr unsigned lda2 = 2048, ldb2 = 2048, hstepB = 512 * 2048; static constexpr int RS = 32; };
template <> struct PCfg<PH_DOWN0> { static constexpr int K = 512; static constexpr unsigned lda2 = 1024, ldb2 = 1024, hstepB = 32 * 1024; static constexpr int RS = 64; };

template <int PH, int HV = 0> DI bool sched_next(const Sched& S, int i, GUnit& u) {
    const int L = i * S.G + S.c; unsigned char* ws = S.ws;
    u.gl = nullptr; u.gcnt = 256; u.aux = 0; u.half = 0;
    if constexpr (PH == PH_PROJ) {
        constexpr int NP = 128 * 7;
        if (L >= NP) return false;
        const int w = xcd_remap(L, NP); grouped_tile(w, 128, 7, u.pm, u.pn); u.kind = K_PROJ;
        u.A = (const char*)(ws + WS_RA) + (size_t)u.pm * 256 * 2048; u.B = (const char*)(ws + WS_WIN) + (size_t)u.pn * 256 * 2048;
        return true;
    } else if constexpr (PH == PH_MEMK) {
        const int j = S.c - 128; if (i != 0 || j < 0 || j >= 32) return false;
        u.pm = j >> 2; u.pn = j & 3; u.kind = K_MEMK;
        u.A = (const char*)(ws + WS_MEMB) + (size_t)u.pm * 256 * 2048; u.B = (const char*)(ws + WS_WCK) + (size_t)u.pn * 256 * 2048;
        return true;
    } else if constexpr (PH == PH_MEMV) {
        const int j = S.c - 160; if (i != 0 || j < 0 || j >= 32) return false;
        u.pm = j >> 2; u.pn = j & 3; u.kind = K_MEMVT;
        u.A = (const char*)(ws + WS_MEMB) + (size_t)u.pm * 256 * 2048; u.B = (const char*)(ws + WS_WCV) + (size_t)u.pn * 256 * 2048;
        return true;
    } else if constexpr (PH == PH_WOUT || PH == PH_WCQ || PH == PH_WCO) {
        if (L >= 512) return false;
        const int w = xcd_remap(L, 512); grouped_tile(w, 128, 4, u.pm, u.pn);
        constexpr size_t wa = PH == PH_WOUT ? WS_RC : (PH == PH_WCQ ? WS_RA : WS_RD), wb = PH == PH_WOUT ? WS_WOUT : (PH == PH_WCQ ? WS_WCQ : WS_WCO);
        u.kind = PH == PH_WOUT ? K_WOUT : (PH == PH_WCQ ? K_WCQ : K_WCO);
        u.A = (const char*)(ws + wa) + (size_t)u.pm * 256 * 2048; u.B = (const char*)(ws + wb) + (size_t)u.pn * 256 * 2048;
        return true;
    } else {
        const LAS int* tbl = S.tbl;
        const int r0 = 0, r1 = 64;
        const int t0 = __builtin_amdgcn_readfirstlane(tbl[64 + r0]), t1 = __builtin_amdgcn_readfirstlane(tbl[64 + r1]), nu = (t1 - t0) * 4;
        const int nfull = nu / S.G, rem = nu - nfull * S.G;
        int Lu = L;
        if constexpr (HV) {
            if (i != 0 || 2 * rem > S.G || S.c >= 2 * rem || (S.c & 1) != HV - 1) return false;
            Lu = nfull * S.G + (S.c >> 1); u.half = HV;
        } else {
            if (i >= nfull) { if (i > nfull || 2 * rem <= S.G || S.c >= rem) return false; }
        }
        const int w = xcd_remap(Lu, nu); const int rt = t0 + (w >> 2), pn = w & 3;
        const int jl = r0 + 1 + (int)(threadIdx.x & 63);
        const bool hit = (jl < r1) && (tbl[64 + (jl < 64 ? jl : 64)] <= rt);
        const int re = r0 + (int)__popcll(__ballot(hit));
        const int jt = rt - __builtin_amdgcn_readfirstlane(tbl[64 + re]), cnt = __builtin_amdgcn_readfirstlane(tbl[re]), e = re & 31;
        u.pm = rt; u.pn = pn; u.gcnt = (cnt - jt * 256) < 256 ? (cnt - jt * 256) : 256; u.aux = re * CAP + jt * 256;
        if constexpr (PH == PH_UP) { u.kind = K_UP; u.gl = (const int*)(ws + WS_LTOK) + u.aux;
            u.A = (const char*)(ws + WS_RC); u.B = (const char*)(ws + WS_W13) + ((size_t)e * 1024 + pn * 128) * 2048; }
        else { u.kind = K_DOWN;
            u.A = (const char*)(ws + WS_RD) + (size_t)rt * 256 * 1024; u.B = (const char*)(ws + WS_W2) + ((size_t)e * 1024 + pn * 256) * 1024; }
        return true;
    }
}

struct EpiCtx {
    unsigned char* ws; float* out; const float* const* in;
};

DI void store_bf16x8(bf16_t* p, const f32x4& a, const f32x4& b) { u32x4 w; w.x = pk2(a[0], a[1]); w.y = pk2(a[2], a[3]); w.z = pk2(b[0], b[1]); w.w = pk2(b[2], b[3]); *(GAS u32x4*)p = w; }
DI float sumsq16(const f32x4& a, const f32x4& b, const f32x4& c, const f32x4& d) {
    return ((a[0] * a[0] + a[1] * a[1]) + (a[2] * a[2] + a[3] * a[3])) + ((b[0] * b[0] + b[1] * b[1]) + (b[2] * b[2] + b[3] * b[3])) +
           ((c[0] * c[0] + c[1] * c[1]) + (c[2] * c[2] + c[3] * c[3])) + ((d[0] * d[0] + d[1] * d[1]) + (d[2] * d[2] + d[3] * d[3]));
}
#define RSLOT(p) (((p) == 0 ? 4 : (p) == 1 ? 5 : (p) == 2 ? 0 : (p) == 3 ? 1 : (p) == 4 ? 6 : (p) == 5 ? 7 : 2) * 16384)
#define PIN_ROW(ai, m) asm volatile("" : "+v"(acc[ai][0][m][0]), "+v"(acc[ai][0][m][1]), "+v"(acc[ai][1][m][0]), "+v"(acc[ai][1][m][1]))
DI float quad_sum(float s) { s += __shfl_xor(s, 16); s += __shfl_xor(s, 32); return s; }

template <int PH, int HV = 0> DI void epilogue(const EpiCtx& E, const GUnit& u, f32x4 (&acc)[2][2][4][2], int wr, int wc, int fr_, int fq_, const float (&epre)[8], LAS unsigned char* lds, bool resl) {
    int fr = fr_, fq = fq_; asm volatile("" : "+v"(fr), "+v"(fq));
    unsigned char* ws = E.ws;
    const int rbase = wr * 64 + fr;
    const int cb = 64 * wc + 8 * fq;
    const int kind = (PH == PH_PROJ) ? K_PROJ : (PH == PH_MEMK) ? K_MEMK : (PH == PH_MEMV) ? K_MEMVT : (PH == PH_WOUT ? K_WOUT : PH == PH_WCQ ? K_WCQ : PH == PH_WCO ? K_WCO : PH == PH_UP ? K_UP : K_DOWN);
    switch (kind) {
    case K_PROJ: {
        const int hd = 4 * u.pn + wc;
        bf16_t* PJ = (bf16_t*)(ws + WS_RB) + ((size_t)u.pm * 256 + rbase) * PJW + 64 * (hd < 12 ? hd - 8 : hd - 16) + 8 * fq;
        const int cmh = (hd < 8) ? hd : hd - 4;
        unsigned char* QU = ws + WS_RD + ((size_t)(u.pm * 8 + (rbase >> 5)) * 128 + 8 * cmh + fq) * 512 + (rbase & 31) * 16;
        const float* R0 = (const float*)(ws + WS_RSTD0) + (size_t)u.pm * 256 + rbase;
        float r0v[2][4];
#pragma unroll
        for (int ai = 0; ai < 2; ++ai)
#pragma unroll
            for (int m = 0; m < 4; ++m) r0v[ai][m] = R0[ai * 128 + m * 16];
        if (hd < 10) {
            const float* gp = (hd < 8) ? E.in[I_Q_NORM] : E.in[I_K_NORM]; const float sc = (hd < 8) ? 0.125f * 1.4426950408889634f : 1.0f;
#pragma unroll
            for (int ai = 0; ai < 2; ++ai)
#pragma unroll
                for (int m = 0; m < 4; ++m) {
                    const float r0 = r0v[ai][m];
                    const float ss = quad_sum(sumsq16(acc[ai][0][m][0], acc[ai][0][m][1], acc[ai][1][m][0], acc[ai][1][m][1])) * (r0 * r0);
                    const float rstd = sc * r0 / sqrtf(ss * (1.0f / 64.0f) + EPS);
#pragma unroll
                    for (int bj = 0; bj < 2; ++bj) {
                        const f32x4 g0 = *(const f32x4*)(gp + 32 * bj + 8 * fq), g1 = *(const f32x4*)(gp + 32 * bj + 8 * fq + 4);
                        if (hd < 8) store_bf16x8((bf16_t*)(QU + (size_t)((ai * 4 + (m >> 1)) * 128 + 4 * bj) * 512 + (m & 1) * 256), acc[ai][bj][m][0] * rstd * g0, acc[ai][bj][m][1] * rstd * g1);
                        else store_bf16x8(PJ + (size_t)(ai * 128 + m * 16) * PJW + 32 * bj, acc[ai][bj][m][0] * rstd * g0, acc[ai][bj][m][1] * rstd * g1);
                    }
                    asm volatile("" ::: "memory");
                }
        } else if (hd < 12) {
#pragma unroll
            for (int ai = 0; ai < 2; ++ai)
#pragma unroll
                for (int m = 0; m < 4; ++m) {
                    const float r0 = r0v[ai][m];
#pragma unroll
                    for (int bj = 0; bj < 2; ++bj) store_bf16x8(PJ + (size_t)(ai * 128 + m * 16) * PJW + 32 * bj, acc[ai][bj][m][0] * r0, acc[ai][bj][m][1] * r0);
                }
        } else {
#pragma unroll
            for (int ai = 0; ai < 2; ++ai)
#pragma unroll
                for (int m = 0; m < 4; ++m) {
                    const float r0 = r0v[ai][m];
#pragma unroll
                    for (int bj = 0; bj < 2; ++bj) {
                        f32x4 v0 = acc[ai][bj][m][0] * r0, v1 = acc[ai][bj][m][1] * r0;
#pragma unroll
                        for (int e = 0; e < 4; ++e) { v0[e] = gelu_tanh(v0[e]); v1[e] = gelu_tanh(v1[e]); }
                        if (hd < 20) store_bf16x8((bf16_t*)(QU + (size_t)((ai * 4 + (m >> 1)) * 128 + 4 * bj) * 512 + (m & 1) * 256), v0, v1);
                        else store_bf16x8(PJ + (size_t)(ai * 128 + m * 16) * PJW + 32 * bj, v0, v1);
                    }
                    asm volatile("" ::: "memory");
                }
        }
        break; }
    case K_MEMK: {
        bf16_t* KM = (bf16_t*)(ws + WS_KMEM); float* SK = (float*)(ws + WS_SSQK);
        f32x4 g[2][2];
#pragma unroll
        for (int bj = 0; bj < 2; ++bj)
#pragma unroll
            for (int n = 0; n < 2; ++n) g[bj][n] = *(const f32x4*)(E.in[I_CK_NORM] + cb + 32 * bj + 4 * n);
#pragma unroll
        for (int ai = 0; ai < 2; ++ai)
#pragma unroll
            for (int m = 0; m < 4; ++m) {
                const size_t grow = (size_t)u.pm * 256 + ai * 128 + m * 16 + rbase;
                const float ss = quad_sum(sumsq16(acc[ai][0][m][0], acc[ai][0][m][1], acc[ai][1][m][0], acc[ai][1][m][1]));
                if (fq == 0) SK[(grow * 4 + u.pn) * 4 + wc] = ss;
#pragma unroll
                for (int bj = 0; bj < 2; ++bj) store_bf16x8(KM + grow * D + u.pn * 256 + cb + 32 * bj, acc[ai][bj][m][0] * g[bj][0], acc[ai][bj][m][1] * g[bj][1]);
            }
        break; }
    case K_MEMVT: {
        bf16_t* VT = (bf16_t*)(ws + WS_VMT);
#pragma unroll
        for (int ai = 0; ai < 2; ++ai)
#pragma unroll
            for (int m = 0; m < 4; ++m) {
                const size_t grow = (size_t)u.pm * 256 + ai * 128 + m * 16 + rbase;
#pragma unroll
                for (int bj = 0; bj < 2; ++bj) store_bf16x8(VT + grow * D + u.pn * 256 + cb + 32 * bj, acc[ai][bj][m][0], acc[ai][bj][m][1]);
            }
        break; }
    case K_WOUT: {
        const size_t off0 = ((size_t)u.pm * 256 + rbase) * D + u.pn * 256 + cb;
        bf16_t* XB = (bf16_t*)(ws + WS_RA) + off0; float* SP = (float*)(ws + WS_SSQ1P) + ((size_t)u.pm * 256 + rbase) * 16 + u.pn * 4 + wc;
#pragma unroll
        for (int ai = 0; ai < 2; ++ai) {
            u32x4 rv[4][2];
#pragma unroll
            for (int m = 0; m < 4; ++m)
#pragma unroll
                for (int bj = 0; bj < 2; ++bj) rv[m][bj] = (resl && !(ai == 1 && wc == 3)) ? *(const LAS u32x4*)(lds + RSLOT(ai * 4 + wc) + lds_byte(wr * 64 + m * 16 + fr, 32 * bj + 8 * fq)) : __builtin_nontemporal_load((const GAS u32x4*)(XB + (size_t)(ai * 128 + m * 16) * D + 32 * bj));
            asm volatile("" ::: "memory");
#pragma unroll
            for (int m = 0; m < 4; ++m) {
                const size_t ro = (size_t)(ai * 128 + m * 16) * D;
                f32x4 v[2][2];
#pragma unroll
                for (int bj = 0; bj < 2; ++bj) {
                    const u32x4 r = rv[m][bj];
                    f32x4 v0 = acc[ai][bj][m][0], v1 = acc[ai][bj][m][1];
                    v0[0] += bflo(r.x); v0[1] += bfhi(r.x); v0[2] += bflo(r.y); v0[3] += bfhi(r.y);
                    v1[0] += bflo(r.z); v1[1] += bfhi(r.z); v1[2] += bflo(r.w); v1[3] += bfhi(r.w);
                    v[bj][0] = v0; v[bj][1] = v1;
                    store_bf16x8(XB + ro + 32 * bj, v0, v1);
                }
                const float ss = quad_sum(sumsq16(v[0][0], v[0][1], v[1][0], v[1][1])); if (fq == 0) SP[(size_t)(ai * 128 + m * 16) * 16] = ss;
            }
            asm volatile("" ::: "memory");
        }
        break; }
    case K_WCO: {
        const size_t off0 = ((size_t)u.pm * 256 + rbase) * D + u.pn * 256 + cb;
        const bf16_t* X1 = (const bf16_t*)(ws + WS_RA) + off0;
        bf16_t* XB = (bf16_t*)(ws + WS_RC) + off0;
#pragma unroll
        for (int ai = 0; ai < 2; ++ai) {
            u32x4 rv[4][2];
#pragma unroll
            for (int m = 0; m < 4; ++m)
#pragma unroll
                for (int bj = 0; bj < 2; ++bj) rv[m][bj] = (resl && !(ai == 1 && wc == 3)) ? *(const LAS u32x4*)(lds + RSLOT(ai * 4 + wc) + lds_byte(wr * 64 + m * 16 + fr, 32 * bj + 8 * fq)) : __builtin_nontemporal_load((const GAS u32x4*)(X1 + (size_t)(ai * 128 + m * 16) * D + 32 * bj));
            asm volatile("" ::: "memory");
#pragma unroll
            for (int m = 0; m < 4; ++m) {
                const size_t ro = (size_t)(ai * 128 + m * 16) * D;
#pragma unroll
                for (int bj = 0; bj < 2; ++bj) {
                    const u32x4 r = rv[m][bj];
                    f32x4 v0 = acc[ai][bj][m][0], v1 = acc[ai][bj][m][1];
                    v0[0] += bflo(r.x); v0[1] += bfhi(r.x); v0[2] += bflo(r.y); v0[3] += bfhi(r.y);
                    v1[0] += bflo(r.z); v1[1] += bfhi(r.z); v1[2] += bflo(r.w); v1[3] += bfhi(r.w);
                    store_bf16x8(XB + ro + 32 * bj, v0, v1);
                }
            }
            asm volatile("" ::: "memory");
        }
        break; }
    case K_WCQ: {
        bf16_t* QC = (bf16_t*)(ws + WS_RB); const float* SP = (const float*)(ws + WS_SSQ1P); float* SQ = (float*)(ws + WS_SSQQ);
        f32x4 g[2][2];
#pragma unroll
        for (int bj = 0; bj < 2; ++bj)
#pragma unroll
            for (int n = 0; n < 2; ++n) g[bj][n] = *(const f32x4*)(E.in[I_CQ_NORM] + cb + 32 * bj + 4 * n);
#pragma unroll
        for (int ai = 0; ai < 2; ++ai)
#pragma unroll
            for (int m = 0; m < 4; ++m) {
                const size_t grow = (size_t)u.pm * 256 + ai * 128 + m * 16 + rbase;
                const f32x4 p = *(const f32x4*)(SP + grow * 16 + 4 * fq);
                const float tot = quad_sum((p[0] + p[1]) + (p[2] + p[3]));
                const float rstd1 = 1.0f / sqrtf(tot * (1.0f / D) + EPS);
                f32x4 v[2][2];
#pragma unroll
                for (int bj = 0; bj < 2; ++bj)
#pragma unroll
                    for (int n = 0; n < 2; ++n) v[bj][n] = acc[ai][bj][m][n] * rstd1;
                const float ss = quad_sum(sumsq16(v[0][0], v[0][1], v[1][0], v[1][1]));
                if (fq == 0) SQ[(grow * 4 + u.pn) * 4 + wc] = ss;
#pragma unroll
                for (int bj = 0; bj < 2; ++bj) store_bf16x8(QC + grow * D + u.pn * 256 + cb + 32 * bj, v[bj][0] * g[bj][0], v[bj][1] * g[bj][1]);
            }
        break; }
    case K_UP: {
        bf16_t* HID = (bf16_t*)(ws + WS_RD); const float* LR = (const float*)(ws + WS_LRSTD) + u.aux;
#pragma unroll
        for (int ai = (HV ? HV - 1 : 0); ai < (HV ? HV : 2); ++ai)
#pragma unroll
            for (int m = 0; m < 4; ++m) {
                PIN_ROW(ai, m);
                const int lrow = ai * 128 + m * 16 + rbase;
                const float rs = epre[ai * 4 + m];
                f32x4 hv[2];
#pragma unroll
                for (int n = 0; n < 2; ++n)
#pragma unroll
                    for (int e = 0; e < 4; ++e) hv[n][e] = silu(acc[ai][0][m][n][e] * rs) * (acc[ai][1][m][n][e] * rs);
                store_bf16x8(HID + ((size_t)u.pm * 256 + lrow) * 512 + u.pn * 128 + 32 * wc + 8 * fq, hv[0], hv[1]);
                asm volatile("" ::: "memory");
            }
        break; }
    case K_DOWN: {
        const int* LT = (const int*)(ws + WS_LTOK) + u.aux; const float* LG = (const float*)(ws + WS_LGATE) + u.aux;
        bf16_t* CB0 = (bf16_t*)(ws + WS_RB) + u.pn * 256 + cb; bf16_t* CB1 = (bf16_t*)(ws + WS_RA) + u.pn * 256 + cb;
        int tk[2][4]; float gt[2][4];
#pragma unroll
        for (int ai = (HV ? HV - 1 : 0); ai < (HV ? HV : 2); ++ai)
#pragma unroll
            for (int m = 0; m < 4; ++m) { const int lrow = ai * 128 + m * 16 + rbase; const bool ok = (lrow < u.gcnt); tk[ai][m] = ok ? LT[lrow] : -1; gt[ai][m] = ok ? LG[lrow] : 0.f; }
#pragma unroll
        for (int ai = (HV ? HV - 1 : 0); ai < (HV ? HV : 2); ++ai)
#pragma unroll
            for (int m = 0; m < 4; ++m) {
                if (tk[ai][m] >= 0) {
                    bf16_t* o = ((tk[ai][m] & 1) ? CB1 : CB0) + (size_t)(tk[ai][m] >> 1) * D; const float g = gt[ai][m];
#pragma unroll
                    for (int bj = 0; bj < 2; ++bj) store_bf16x8(o + 32 * bj, acc[ai][bj][m][0] * g, acc[ai][bj][m][1] * g);
                }
            }
        break; }
    }
}

template <int PH> struct Stagger { static constexpr int ways = 1; static constexpr unsigned ticks = 0; };
#ifndef STG_WOUT
#define STG_WOUT 0
#endif
#ifndef STG_WCO
#define STG_WCO 0
#endif
#ifndef STG_DOWN
#define STG_DOWN 0
#endif
template <> struct Stagger<PH_WOUT> { static constexpr int ways = 2; static constexpr unsigned ticks = STG_WOUT; };
template <> struct Stagger<PH_WCO> { static constexpr int ways = 2; static constexpr unsigned ticks = STG_WCO; };
template <> struct Stagger<PH_DOWN0> { static constexpr int ways = 4; static constexpr unsigned ticks = STG_DOWN; };
template <int PH, int HV = 0> DI void gemm_phase(LAS unsigned char* lds, const Sched& S, const EpiCtx& E) {
    if constexpr (Stagger<PH>::ways > 1 && Stagger<PH>::ticks > 0) {
        const unsigned way = ((unsigned)S.c >> 3) % Stagger<PH>::ways;
        if (way) { const unsigned long long t0 = __builtin_amdgcn_s_memrealtime(), dl = (unsigned long long)way * Stagger<PH>::ticks;
            while (__builtin_amdgcn_s_memrealtime() - t0 < dl) __builtin_amdgcn_s_sleep(8); }
    }
    typedef PCfg<(PH == PH_DOWN1 ? PH_DOWN0 : PH)> g;
    constexpr bool GATHER = (PH == PH_UP);
    constexpr bool CMA = (PH == PH_WOUT || PH == PH_WCO);
    constexpr bool RESL = (PH == PH_WOUT || PH == PH_WCO);
    constexpr bool HALVES = (PH == PH_UP || PH == PH_DOWN0);
    const int tid = threadIdx.x, wid = __builtin_amdgcn_readfirstlane(tid >> 6), lane = tid & 63, wr = wid >> 2, wc = wid & 3, fr = lane & 15, fq = lane >> 4;
    constexpr int nt = g::K / BK;
    int R0, C0; stage_rc(tid * 16, R0, C0);
    unsigned vB[2], vA0[2], vR[2];
#pragma unroll
    for (int i = 0; i < 2; ++i) { const int R = R0 + 64 * i; vB[i] = (unsigned)(g::RS * (R >> 5) + perm32(R & 31)) * g::ldb2 + (unsigned)C0 * 2u; vR[i] = (unsigned)R * 2048u + (unsigned)C0 * 2u; vA0[i] = CMA ? (unsigned)(((R >> 5) * 128 + (C0 >> 3)) * 512 + (R & 31) * 16) : (unsigned)R * g::lda2 + (unsigned)C0 * 2u; }
    const unsigned ldsw = (unsigned)wid * 1024u;
    const int aoff = lds_byte(wr * 64 + fr, fq * 8), boff = lds_byte(wc * 32 + fr, fq * 8);
    constexpr size_t hA = (size_t)HALF * g::lda2;
#define SA(b, h) (((b) * 2 + (h)) * HTB)
#define SB(b, h) ((4 + (b) * 2 + (h)) * HTB)
#define GLDS(gp, loff) __builtin_amdgcn_global_load_lds((const unsigned*)(gp), (LAS unsigned*)(lds + (loff)), 16, 0, 0)
#define STG_A(bufoff, base, h, useN) do { if constexpr (GATHER) { \
        GLDS((base) + vAc[h][0], (bufoff) + ldsw); GLDS((base) + vAc[h][1], (bufoff) + ldsw + 8192); } else { \
        GLDS((base) + (h) * hA + vA0[0], (bufoff) + ldsw); GLDS((base) + (h) * hA + vA0[1], (bufoff) + ldsw + 8192); } } while (0)
#define STG_B(bufoff, base) do { GLDS((base) + vB[0], (bufoff) + ldsw); GLDS((base) + vB[1], (bufoff) + ldsw + 8192); } while (0)
#define STG_BR(bufoff, base, piece) do { if constexpr (RESL) { const char* bb_ = resm ? resb + ((piece) >> 2) * (128 * 2048) + ((piece) & 3) * 128 : (const char*)(base); \
        GLDS(bb_ + (resm ? vR[0] : vB[0]), (bufoff) + ldsw); GLDS(bb_ + (resm ? vR[1] : vB[1]), (bufoff) + ldsw + 8192); } else { STG_B(bufoff, base); } } while (0)
#define STG_AR(bufoff, base, h, useN, piece) do { if constexpr (RESL) { const char* bb_ = resm ? resb + ((piece) >> 2) * (128 * 2048) + ((piece) & 3) * 128 : (const char*)(base) + (h) * hA; \
        GLDS(bb_ + (resm ? vR[0] : vA0[0]), (bufoff) + ldsw); GLDS(bb_ + (resm ? vR[1] : vA0[1]), (bufoff) + ldsw + 8192); } else { STG_A(bufoff, base, h, useN); } } while (0)
#define LDA(dst, b, h) do { _Pragma("unroll") for (int m = 0; m < 4; ++m) _Pragma("unroll") for (int k = 0; k < 2; ++k) dst[m][k] = *(const LAS bf16x8*)(lds + SA(b, h) + aoff + m * 2048 + k * 1024); } while (0)
#define LDB(dst, b, h) do { _Pragma("unroll") for (int n = 0; n < 2; ++n) _Pragma("unroll") for (int k = 0; k < 2; ++k) dst[n][k] = *(const LAS bf16x8*)(lds + SB(b, h) + boff + n * 2048 + k * 1024); } while (0)
#define MMA(ai, bj, At, Bt) do { __builtin_amdgcn_s_setprio(1); _Pragma("unroll") for (int m = 0; m < 4; ++m) _Pragma("unroll") for (int n = 0; n < 2; ++n) _Pragma("unroll") for (int k = 0; k < 2; ++k) \
        acc[ai][bj][m][n] = __builtin_amdgcn_mfma_f32_16x16x32_bf16(Bt[n][k], At[m][k], acc[ai][bj][m][n], 0, 0, 0); __builtin_amdgcn_s_setprio(0); } while (0)
#define WAIT_V(n) asm volatile("s_waitcnt vmcnt(" #n ")" ::: "memory")
#define WAIT_L(n) asm volatile("s_waitcnt lgkmcnt(" #n ")" ::: "memory")
#define BAR __builtin_amdgcn_s_barrier()
#define SCHED __builtin_amdgcn_sched_barrier(0)
#define LOAD_IDX(ii, U) do { _Pragma("unroll") for (int h = 0; h < 2; ++h) _Pragma("unroll") for (int i = 0; i < 2; ++i) { const int r_ = 128 * h + R0 + 64 * i; \
        (ii)[h][i] = (r_ < (U).gcnt) ? ((U).gl[r_] >> 1) : 0; } } while (0)
#define IDX_TO_VA(vv, ii) do { _Pragma("unroll") for (int h = 0; h < 2; ++h) _Pragma("unroll") for (int i = 0; i < 2; ++i) (vv)[h][i] = (unsigned)(ii)[h][i] * g::lda2 + (unsigned)C0 * 2u; } while (0)
    GUnit cur, nxt; int ui = 0;
    if (!sched_next<PH, HV>(S, 0, cur)) return;
    f32x4 acc[2][2][4][2];
#pragma unroll
    for (int a = 0; a < 2; ++a)
#pragma unroll
        for (int b = 0; b < 2; ++b)
#pragma unroll
            for (int m = 0; m < 4; ++m)
#pragma unroll
                for (int n = 0; n < 2; ++n) acc[a][b][m][n] = (f32x4){0.f, 0.f, 0.f, 0.f};
    bf16x8 At[4][2], B0[2][2], B1[2][2];
    unsigned vAc[2][2]; int idxn[2][2]; float epre[8];
    if constexpr (GATHER) { LOAD_IDX(idxn, cur); IDX_TO_VA(vAc, idxn); }
    const char* cA = cur.A; const char* cB = cur.B;
    constexpr size_t kstep = BK * 2; constexpr size_t hB = g::hstepB;
    constexpr size_t kstepA = CMA ? 8 * 512 : BK * 2;
    STG_B(SB(0, 0), cB); STG_B(SB(0, 1), cB + hB); STG_A(SA(0, 0), cA, 0, false); STG_A(SA(0, 1), cA, 1, false);
    if (wr == 1) BAR;
    WAIT_V(2); BAR;
    STG_B(SB(1, 0), cB + kstep); STG_A(SA(1, 0), cA + kstepA, 0, false); STG_B(SB(1, 1), cB + hB + kstep);
    WAIT_V(6); BAR;
    for (;;) {
        const bool has_next = sched_next<PH, HV>(S, ui + 1, nxt);
        const char* nA = has_next ? nxt.A : cA; const char* nB = has_next ? nxt.B : cB;
#pragma unroll 1
        for (int t = 0; t < nt; t += 2) {
            const bool last = (t == nt - 2);
            if constexpr (GATHER) { if (last) { if (has_next) { LOAD_IDX(idxn, nxt); }
                const float* LR_ = (const float*)(E.ws + WS_LRSTD) + cur.aux;
#pragma unroll
                for (int ai = 0; ai < 2; ++ai)
#pragma unroll
                    for (int m = 0; m < 4; ++m) { const int lr_ = ai * 128 + m * 16 + wr * 64 + fr; epre[ai * 4 + m] = (lr_ < cur.gcnt) ? LR_[lr_] : 0.f; } } }
            const bool resm = RESL && last && !has_next;
            const char* resb = (const char*)(E.ws + WS_RA) + ((size_t)cur.pm * 256 * D + cur.pn * 256) * 2;
            const char* a1 = cA + (size_t)(t + 1) * kstepA;
            const char* a2 = last ? nA : cA + (size_t)(t + 2) * kstepA; const char* b2 = last ? nB : cB + (size_t)(t + 2) * kstep;
            const char* a3 = a2 + kstepA; const char* b3 = b2 + kstep;
            LDB(B0, 0, 0); LDB(B1, 0, 1); SCHED; if constexpr (HV != 2) LDA(At, 0, 0); STG_A(SA(1, 1), a1, 1, false);
            WAIT_V(8); WAIT_L(0); BAR; if constexpr (HV != 2) { MMA(0, 0, At, B0); MMA(0, 1, At, B1); } BAR; SCHED;
            if constexpr (GATHER) { if (last) { asm volatile("" : "+v"(epre[0]), "+v"(epre[1]), "+v"(epre[2]), "+v"(epre[3]), "+v"(epre[4]), "+v"(epre[5]), "+v"(epre[6]), "+v"(epre[7])); if (has_next) { IDX_TO_VA(vAc, idxn); } } }
            if constexpr (HV != 1) LDA(At, 0, 1); STG_BR(SB(0, 0), b2, 0); STG_BR(SB(0, 1), b2 + hB, 1); STG_AR(SA(0, 0), a2, 0, last, 2);
            WAIT_V(8); WAIT_L(0); BAR; if constexpr (HV != 1) { MMA(1, 0, At, B0); MMA(1, 1, At, B1); } BAR; SCHED;
            LDB(B0, 1, 0); LDB(B1, 1, 1); SCHED; if constexpr (HV != 2) LDA(At, 1, 0); STG_AR(SA(0, 1), a2, 1, last, 3);
            WAIT_V(8); WAIT_L(0); BAR; if constexpr (HV != 2) { MMA(0, 0, At, B0); MMA(0, 1, At, B1); } BAR; SCHED;
            if constexpr (HV != 1) LDA(At, 1, 1); STG_BR(SB(1, 0), b3, 4); STG_BR(SB(1, 1), b3 + hB, 5); STG_AR(SA(1, 0), a3, 0, last, 6);
            WAIT_V(8); WAIT_L(0); BAR; if constexpr (HV != 1) { MMA(1, 0, At, B0); MMA(1, 1, At, B1); } BAR; SCHED;
        }
        if (wr == 0) BAR;
        if constexpr (RESL) { if (!has_next) { WAIT_V(0); BAR; } }
        epilogue<PH, HV>(E, cur, acc, wr, wc, fr, fq, epre, lds, RESL && !has_next);
        if (!has_next) break;
#pragma unroll
        for (int a = 0; a < 2; ++a)
#pragma unroll
            for (int b = 0; b < 2; ++b)
#pragma unroll
                for (int m = 0; m < 4; ++m)
#pragma unroll
                    for (int n = 0; n < 2; ++n) acc[a][b][m][n] = (f32x4){0.f, 0.f, 0.f, 0.f};
        cur = nxt; cA = nA; cB = nB; ++ui;
        if (wr == 1) BAR;
    }
    WAIT_V(0);
    BAR;
#undef SA
#undef SB
#undef GLDS
#undef STG_A
#undef STG_B
#undef STG_BR
#undef STG_AR
#undef LDA
#undef LDB
#undef MMA
#undef WAIT_V
#undef WAIT_L
#undef BAR
#undef SCHED
#undef LOAD_IDX
#undef IDX_TO_VA
}

DI int crow(int r, int hi) { return (r & 3) + 8 * (r >> 2) + 4 * hi; }
typedef short v4i16_t __attribute__((ext_vector_type(4)));
DI s16x4 vtr(const LAS unsigned char* p) { return __builtin_bit_cast(s16x4, __builtin_amdgcn_ds_read_tr16_b64_v4i16((LAS v4i16_t*)p)); }
#define MFMA32(a, b, c) __builtin_amdgcn_mfma_f32_32x32x16_bf16((a), (b), (c), 0, 0, 0)
DI bf16x8 cat8(s16x4 lo, s16x4 hi) { return __builtin_shufflevector(lo, hi, 0, 1, 2, 3, 4, 5, 6, 7); }
DI bf16x8 pack8(float a0, float a1, float a2, float a3, float a4, float a5, float a6, float a7) {
    u32x4 w; w.x = pk2(a0, a1); w.y = pk2(a2, a3); w.z = pk2(a4, a5); w.w = pk2(a6, a7); return __builtin_bit_cast(bf16x8, w);
}
DI void norm_store_unit(Frame& F, f32x16 (&ov)[4][2], int ql, int hh, unsigned char* dst0  ) {
    LAS float* xch = (LAS float*)(F.lds + SGP_OFF);
    __syncthreads();
#pragma unroll
    for (int blk = 0; blk < 4; ++blk) {
        float ss = 0.f;
#pragma unroll
        for (int d = 0; d < 2; ++d)
#pragma unroll
            for (int r = 0; r < 16; ++r) ss += ov[blk][d][r] * ov[blk][d][r];
        ss += __shfl_xor(ss, 32);
        if (hh == 0) xch[F.wave * 128 + 32 * blk + ql] = ss;
    }
    __syncthreads();
#pragma unroll
    for (int blk = 0; blk < 4; ++blk) {
        float tot = 0.f;
#pragma unroll
        for (int w = 0; w < 8; ++w) tot += xch[w * 128 + 32 * blk + ql];
        const float rstd = 1.0f / sqrtf(tot * (1.0f / 512.0f) + EPS);
#pragma unroll
        for (int d = 0; d < 2; ++d)
#pragma unroll
            for (int g = 0; g < 4; ++g) {
                u32x2 w; w.x = pk2(ov[blk][d][4 * g] * rstd, ov[blk][d][4 * g + 1] * rstd); w.y = pk2(ov[blk][d][4 * g + 2] * rstd, ov[blk][d][4 * g + 3] * rstd);
                *(GAS u32x2*)(dst0 + (size_t)blk * 128 * 512 + (size_t)(4 * d + g) * 512) = w;
            }
    }
}
DI void norm_store_512(Frame& F, f32x16 (&o)[2], int par, int ql, int hh, unsigned char* dst  ) {
    LAS float* xch = (LAS float*)(F.lds + XCH_OFF) + par * 256;
    float ss = 0.f;
#pragma unroll
    for (int d = 0; d < 2; ++d)
#pragma unroll
        for (int r = 0; r < 16; ++r) ss += o[d][r] * o[d][r];
    ss += __shfl_xor(ss, 32);
    if (hh == 0) xch[F.wave * 32 + ql] = ss;
    __syncthreads();
    float tot = 0.f;
#pragma unroll
    for (int w = 0; w < 8; ++w) tot += xch[w * 32 + ql];
    const float rstd = 1.0f / sqrtf(tot * (1.0f / 512.0f) + EPS);
#pragma unroll
    for (int d = 0; d < 2; ++d)
#pragma unroll
        for (int g = 0; g < 4; ++g) {
            u32x2 w; w.x = pk2(o[d][4 * g] * rstd, o[d][4 * g + 1] * rstd); w.y = pk2(o[d][4 * g + 2] * rstd, o[d][4 * g + 3] * rstd);
            *(GAS u32x2*)(dst + (size_t)(4 * d + g) * 512) = w;
        }
}

#if defined(TS_PHASE) && TS_PHASE >= 20
#define MSTAMP(k) do { __syncthreads(); if (F.tid == 0) ((volatile LAS unsigned long long*)(F.lds + MISC_OFF + 64))[k] = __builtin_amdgcn_s_memrealtime(); } while (0)
#else
#define MSTAMP(k) do { } while (0)
#endif
DI void attn_unit(Frame& F, int b, int n) {
    if (F.wave >= 4) __builtin_amdgcn_s_setprio(1);
    int tid = F.tid; asm volatile("" : "+v"(tid));
    const int lane = tid & 63, ql = lane & 31, hh = lane >> 5;
    const int t0 = b * SEQ + n * 128;
    const bf16_t* PJ = (const bf16_t*)(F.ws + WS_RB);
    bf16_t* MX = (bf16_t*)(F.ws + WS_RC);
    LAS unsigned char* lds = F.lds;
    const int h = F.wave, kvh = h >> 2;
    bf16x8 qfa[4][4];
#pragma unroll
    for (int i = 0; i < 4; ++i) { const unsigned char* qp = F.ws + WS_RD + ((size_t)((t0 >> 5) + i) * 128 + 8 * h + hh) * 512 + ql * 16;
#pragma unroll
        for (int ks = 0; ks < 4; ++ks) qfa[i][ks] = __builtin_nontemporal_load((const GAS bf16x8*)(qp + (size_t)(2 * ks) * 512)); }
    __syncthreads();
#pragma unroll 8
    for (int j = 0; j < 16; ++j) {
        const int p = tid + NTHR * j, row = p >> 5, c = p & 31;
        int tok = t0 - 128 + row; if (n == 0 && row < 128) tok = t0;
        const u32x4 v = *(const GAS u32x4*)(PJ + (size_t)tok * PJW + 8 * c);
        int addr;
        if (c < 16) { const int kvh = c >> 3, ch = c & 7; addr = kvh * 32768 + row * 128 + ((ch ^ ((row >> 1) & 7)) << 4); }
        else { const int cc = c - 16, kvh = cc >> 3, ch = cc & 7; addr = 65536 + kvh * 32768 + (ch >> 2) * 16384 + row * 64 + (ch & 3) * 16; }
        *(LAS u32x4*)(lds + addr) = v;
    }
    __syncthreads();
    const float sinkv = F.in[I_SINKS][h] * 1.4426950408889634f;
    const LAS unsigned char* Kb = lds + kvh * 32768;
    const LAS unsigned char* Vb = lds + 65536 + kvh * 32768;
    const int vtr_off = ((lane & 15) >> 2) * 64 + (16 * ((lane >> 4) & 1) + 4 * (lane & 3)) * 2;
#pragma unroll
    for (int i = 0; i < 4; ++i) {
        const bf16x8* qf = qfa[i];
        f32x16 s[5];
#pragma unroll
        for (int jt = 0; jt < 5; ++jt) {
            const int key = 32 * (i + jt) + ql;
            f32x16 a = {};
#pragma unroll
            for (int ks = 0; ks < 4; ++ks) {
                const bf16x8 kf = *(const LAS bf16x8*)(Kb + key * 128 + (((2 * ks + hh) ^ ((key >> 1) & 7)) << 4));
                a = MFMA32(kf, qf[ks], a);
            }
            s[jt] = a;
        }
        float m = sinkv;
#pragma unroll
        for (int jt = 0; jt < 5; ++jt) {
            const bool tile_ok = (n != 0) || (i + jt >= 4);
#pragma unroll
            for (int r = 0; r < 16; ++r) {
                const int c = crow(r, hh);
                bool ok = tile_ok;
                if (jt == 0) ok = ok && (c > ql);
                if (jt == 4) ok = ok && (c <= ql);
                const float v = ok ? s[jt][r] : -INFINITY;
                s[jt][r] = v; m = fmaxf(m, v);
            }
        }
        m = fmaxf(m, __shfl_xor(m, 32));
        float l = 0.f;
#pragma unroll
        for (int jt = 0; jt < 5; ++jt)
#pragma unroll
            for (int r = 0; r < 16; ++r) { const float p = __builtin_amdgcn_exp2f(s[jt][r] - m); s[jt][r] = p; l += p; }
        l += __shfl_xor(l, 32);
        l += __builtin_amdgcn_exp2f(sinkv - m);
        f32x16 o[2]; o[0] = f32x16{}; o[1] = f32x16{};
#pragma unroll
        for (int jt = 0; jt < 5; ++jt)
#pragma unroll
            for (int s2 = 0; s2 < 2; ++s2) {
                const bf16x8 pf = pack8(s[jt][8 * s2], s[jt][8 * s2 + 1], s[jt][8 * s2 + 2], s[jt][8 * s2 + 3], s[jt][8 * s2 + 4], s[jt][8 * s2 + 5], s[jt][8 * s2 + 6], s[jt][8 * s2 + 7]);
                const int k0 = 32 * (i + jt) + 16 * s2 + 4 * hh;
#pragma unroll
                for (int d = 0; d < 2; ++d) {
                    const LAS unsigned char* vp = Vb + d * 16384 + k0 * 64 + vtr_off;
                    const s16x4 lo = vtr(vp), hi = vtr(vp + 8 * 64);
                    o[d] = MFMA32(cat8(lo, hi), pf, o[d]);
                }
            }
        const float inv = 1.0f / l;
#pragma unroll
        for (int d = 0; d < 2; ++d)
#pragma unroll
            for (int r = 0; r < 16; ++r) o[d][r] *= inv;
        norm_store_512(F, o, i & 1, ql, hh, (unsigned char*)MX + ((size_t)((t0 >> 5) + i) * 128 + 8 * h) * 512 + ql * 16 + 8 * hh);
    }
    __builtin_amdgcn_s_setprio(0);
}

DI void sgu_unit(Frame& F, int b, int n) {
    int tid = F.tid; asm volatile("" : "+v"(tid));
    const int lane = tid & 63, ql = lane & 31, hh = lane >> 5, gi = F.wave;
    const int t0 = b * SEQ + n * 128;
    const bf16_t* PJ = (const bf16_t*)(F.ws + WS_RB);
    bf16_t* MX = (bf16_t*)(F.ws + WS_RC);
    LAS unsigned char* lds = F.lds;
    LAS float* sgp = (LAS float*)(lds + SGP_OFF);
    LAS float* sgr = (LAS float*)(lds + SGR_OFF);
    __syncthreads();
    MSTAMP(22);
    u32x4 gv[16];
    const int ch = lane & 7;
#pragma unroll
    for (int L = 0; L < 16; ++L) {
        const int tok = 8 * L + (lane >> 3);
        gv[L] = __builtin_nontemporal_load((const GAS u32x4*)(PJ + (size_t)(t0 + tok) * PJW + 256 + 64 * gi + 8 * ch));
    }
#pragma unroll
    for (int L = 0; L < 16; ++L) {
        const int tok = 8 * L + (lane >> 3);
        float ss = 0.f;
#pragma unroll
        for (int e = 0; e < 4; ++e) { const float a = bflo(gv[L][e]), c = bfhi(gv[L][e]); ss += a * a + c * c; }
        ss += __shfl_xor(ss, 1); ss += __shfl_xor(ss, 2); ss += __shfl_xor(ss, 4);
        if (ch == 0) sgp[gi * 128 + tok] = ss;
    }
    __syncthreads();
    if (tid < 128) { float tot = 0.f;
#pragma unroll
        for (int g = 0; g < 8; ++g) tot += sgp[g * 128 + tid];
        sgr[tid] = 1.0f / sqrtf(tot * (1.0f / 512.0f) + EPS); }
    __syncthreads();
    MSTAMP(23);
    float gn[8];
    { const f32x4 a = *(const f32x4*)(F.in[I_SGU_NORM] + 64 * gi + 8 * ch), c = *(const f32x4*)(F.in[I_SGU_NORM] + 64 * gi + 8 * ch + 4);
      gn[0] = a[0]; gn[1] = a[1]; gn[2] = a[2]; gn[3] = a[3]; gn[4] = c[0]; gn[5] = c[1]; gn[6] = c[2]; gn[7] = c[3]; }
    LAS unsigned char* vcb = lds + gi * 16384;
#pragma unroll
    for (int L = 0; L < 16; ++L) {
        const int tok = 8 * L + (lane >> 3);
        const float r = sgr[tok];
        u32x4 w;
#pragma unroll
        for (int e = 0; e < 4; ++e) w[e] = pk2(bflo(gv[L][e]) * r * gn[2 * e], bfhi(gv[L][e]) * r * gn[2 * e + 1]);
        *(LAS u32x4*)(vcb + (ch >> 2) * 8192 + tok * 64 + (ch & 3) * 16) = w;
    }
    LDS_WAIT();
    __syncthreads();
    MSTAMP(24);
    const bf16_t* Wg = (const bf16_t*)(F.ws + WS_WRT + 512 * 1024) + (size_t)gi * 128 * 128;
    const float* bias = F.in[I_SGU_B] + gi * 128;
    const int vtr_off = ((lane & 15) >> 2) * 64 + (16 * ((lane >> 4) & 1) + 4 * (lane & 3)) * 2;
    f32x16 ov[4][2];
#pragma unroll
    for (int ib = 0; ib < 4; ++ib) {
        const int it = 32 * ib + ql;
        f32x16 a[2]; a[0] = f32x16{}; a[1] = f32x16{};
        const float bi = bias[it];
        const unsigned char* up = F.ws + WS_RD + ((size_t)((t0 >> 5) + ib) * 128 + 64 + 8 * gi) * 512 + ql * 16 + 8 * hh;
        u32x2 uw[2][4];
#pragma unroll
        for (int d = 0; d < 2; ++d)
#pragma unroll
            for (int g = 0; g < 4; ++g) uw[d][g] = __builtin_nontemporal_load((const GAS u32x2*)(up + (size_t)(4 * d + g) * 512));
        bf16x8 wfr[8];
#pragma unroll
        for (int js = 0; js < 2 * (ib + 1); ++js) wfr[js] = *(const GAS bf16x8*)(Wg + (size_t)it * 128 + 16 * js + 8 * hh);
        s16x4 vlo[8][2], vhi[8][2];
#pragma unroll
        for (int js = 0; js < 2 * (ib + 1); ++js)
#pragma unroll
            for (int d = 0; d < 2; ++d) { const LAS unsigned char* vp = vcb + d * 8192 + (16 * js + 8 * hh) * 64 + vtr_off; vlo[js][d] = vtr(vp); vhi[js][d] = vtr(vp + 4 * 64); }
#pragma unroll
        for (int js = 0; js < 2 * (ib + 1); ++js)
#pragma unroll
            for (int d = 0; d < 2; ++d) a[d] = MFMA32(cat8(vlo[js][d], vhi[js][d]), wfr[js], a[d]);
#pragma unroll
        for (int d = 0; d < 2; ++d)
#pragma unroll
            for (int g = 0; g < 4; ++g) {
                const u32x2 uu = uw[d][g];
                a[d][4 * g] = bflo(uu.x) * (a[d][4 * g] + bi); a[d][4 * g + 1] = bfhi(uu.x) * (a[d][4 * g + 1] + bi);
                a[d][4 * g + 2] = bflo(uu.y) * (a[d][4 * g + 2] + bi); a[d][4 * g + 3] = bfhi(uu.y) * (a[d][4 * g + 3] + bi);
            }
        ov[ib][0] = a[0]; ov[ib][1] = a[1];
        asm volatile("" ::: "memory");
    }
    MSTAMP(25);
    norm_store_unit(F, ov, ql, hh, (unsigned char*)MX + ((size_t)(t0 >> 5) * 128 + 64 + 8 * gi) * 512 + ql * 16 + 8 * hh);
    MSTAMP(26);
}

DI void mix_phase(Frame& F) {
    { const int i = F.bid * NTHR + F.tid;
      if (i < NMEM * 4 * 8) { const int piece = i & 7, kh = i >> 3, key = kh >> 2, h = kh & 3;
          const f32x4 p = *(const f32x4*)((const float*)(F.ws + WS_SSQK) + (size_t)kh * 4);
          const float r = 1.0f / sqrtf(((p[0] + p[1]) + (p[2] + p[3])) * (1.0f / 256.0f) + EPS);
          GAS u32x4* kp = (GAS u32x4*)((bf16_t*)(F.ws + WS_KMEM) + (size_t)key * D + h * 256 + piece * 32);
#pragma unroll
          for (int q = 0; q < 4; ++q) { u32x4 v = kp[q];
#pragma unroll
              for (int e = 0; e < 4; ++e) v[e] = pk2(bflo(v[e]) * r, bfhi(v[e]) * r);
              kp[q] = v; } } }
    MSTAMP(20);
    for (int uidx = F.bid; uidx < 256; uidx += F.G) attn_unit(F, uidx >> 5, uidx & 31);
    MSTAMP(21);
    for (int uidx = F.bid; uidx < 256; uidx += F.G) sgu_unit(F, uidx >> 5, uidx & 31);
    MSTAMP(27);
}

DI void xattn_unit(Frame& F, int pm, int pn) {
    if (F.wave >= 4) __builtin_amdgcn_s_setprio(1);
    int tid = F.tid; asm volatile("" : "+v"(tid));
    const int lane = tid & 63, ql = lane & 31, hh = lane >> 5, w = F.wave;
    const int b = pm >> 4, h = pn;
    const size_t row = (size_t)pm * 256 + 32 * w + ql;
    LAS unsigned char* lds = F.lds;
    const bf16_t* QC = (const bf16_t*)(F.ws + WS_RB);
    bf16x8 qf[16];
#pragma unroll
    for (int ks = 0; ks < 16; ++ks) qf[ks] = __builtin_nontemporal_load((const GAS bf16x8*)(QC + row * D + h * 256 + 16 * ks + 8 * hh));
    const f32x4 pq = *(const f32x4*)((const float*)(F.ws + WS_SSQQ) + (row * 4 + h) * 4);
    const float rq = (0.0625f * 1.4426950408889634f) / sqrtf(((pq[0] + pq[1]) + (pq[2] + pq[3])) * (1.0f / 256.0f) + EPS);
    __syncthreads();
    { const bf16_t* KM = (const bf16_t*)(F.ws + WS_KMEM) + (size_t)(b * MEML) * D + h * 256;
#pragma unroll 8
      for (int j = 0; j < 16; ++j) { const int p = tid + NTHR * j, key = p >> 5, c = p & 31;
          const u32x4 v = *(const GAS u32x4*)(KM + (size_t)key * D + 8 * c);
          *(LAS u32x4*)(lds + key * 512 + ((c ^ (key & 15)) << 4)) = v; } }
    __syncthreads();
    const float shift2 = *(const float*)(F.ws + WS_WRT + 256 * 1024);
    bf16x8 pf[8][2];
    float l = 0.f;
#pragma unroll
    for (int kt = 0; kt < 8; ++kt) {
        const int key = 32 * kt + ql;
        f32x16 a = {};
#pragma unroll
        for (int ks = 0; ks < 16; ++ks) {
            const bf16x8 kf = *(const LAS bf16x8*)(lds + key * 512 + (((2 * ks + hh) ^ (key & 15)) << 4));
            a = MFMA32(kf, qf[ks], a);
        }
#pragma unroll
        for (int r = 0; r < 16; ++r) { a[r] = __builtin_amdgcn_exp2f(a[r] * rq - shift2); l += a[r]; }
        pf[kt][0] = pack8(a[0], a[1], a[2], a[3], a[4], a[5], a[6], a[7]);
        pf[kt][1] = pack8(a[8], a[9], a[10], a[11], a[12], a[13], a[14], a[15]);
    }
    l += __shfl_xor(l, 32);
    __syncthreads();
    { const bf16_t* VM = (const bf16_t*)(F.ws + WS_VMT) + (size_t)(b * MEML) * D + h * 256;
#pragma unroll 8
      for (int j = 0; j < 16; ++j) { const int p = tid + NTHR * j, key = p >> 5, c = p & 31;
          const u32x4 v = *(const GAS u32x4*)(VM + (size_t)key * D + 8 * c);
          *(LAS u32x4*)(lds + (c >> 2) * 16384 + key * 64 + (c & 3) * 16) = v; } }
    __syncthreads();
    const int vtr_off = ((lane & 15) >> 2) * 64 + (16 * ((lane >> 4) & 1) + 4 * (lane & 3)) * 2;
    const float inv = 1.0f / l;
    unsigned char* OC = F.ws + WS_RD + ((size_t)(pm * 8 + w) * 128 + h * 32) * 512 + ql * 16 + 8 * hh;
#pragma unroll
    for (int d = 0; d < 8; ++d) {
        f32x16 o = {};
#pragma unroll
        for (int kt = 0; kt < 8; ++kt)
#pragma unroll
            for (int s2 = 0; s2 < 2; ++s2) {
                const LAS unsigned char* vp = lds + d * 16384 + (32 * kt + 16 * s2 + 4 * hh) * 64 + vtr_off;
                const s16x4 lo = vtr(vp), hi = vtr(vp + 8 * 64);
                o = MFMA32(cat8(lo, hi), pf[kt][s2], o);
            }
#pragma unroll
        for (int g = 0; g < 4; ++g) {
            u32x2 wv; wv.x = pk2(o[4 * g] * inv, o[4 * g + 1] * inv); wv.y = pk2(o[4 * g + 2] * inv, o[4 * g + 3] * inv);
            *(GAS u32x2*)(OC + (size_t)(4 * d + g) * 512) = wv;
        }
    }
    __builtin_amdgcn_s_setprio(0);
}
DI void xattn_phase(Frame& F) {
    for (int i = 0; i < 2; ++i) {
        const int L = i * F.G + F.bid; if (L >= 512) break;
        const int wg = xcd_remap(L, 512); int pm, pn; grouped_tile(wg, 128, 4, pm, pn);
        xattn_unit(F, pm, pn);
    }
    asm volatile("s_waitcnt vmcnt(0)" ::: "memory"); __syncthreads();
}

DI void route_phase(Frame& F, bool dummy) {
    const int lane = F.lane, tr = lane & 15, kq = lane >> 4, w = F.wave;
    const bf16_t* WRP = (const bf16_t*)(F.ws + WS_WRT);
    unsigned* cnt = (unsigned*)(F.ws + WS_CTL) + CW_CNT + (dummy ? 4096 : 0);
    int* LT = (int*)(F.ws + (dummy ? WS_RD : WS_LTOK)); float* LG = (float*)(F.ws + (dummy ? WS_RD + 8 * MiB : WS_LGATE)); float* LR = (float*)(F.ws + (dummy ? WS_RD + 16 * MiB : WS_LRSTD));
    LAS float* red = (LAS float*)(F.lds);
    LAS float* lgs = (LAS float*)(F.lds + 98304);
    LAS float* ssp = (LAS float*)(F.lds + 98304 + 25600);
    LAS unsigned* hist = (LAS unsigned*)(F.lds + 98304 + 25600 + 4096);
    bf16x8 bfr[4][3][2];
#pragma unroll
    for (int sp = 0; sp < 4; ++sp)
#pragma unroll
        for (int nb = 0; nb < 3; ++nb)
#pragma unroll
            for (int hl = 0; hl < 2; ++hl) bfr[sp][nb][hl] = *(const GAS bf16x8*)(WRP + ((size_t)(((4 * w + sp) * 3 + nb) * 2 + hl) * 64 + lane) * 8);
    for (int chunk = F.bid; chunk < T / 128; chunk += F.G) {
        __syncthreads();
        if (F.tid < 128) hist[F.tid] = 0u;
        const int tok0 = chunk * 128;
        const bf16_t* xbase = (const bf16_t*)(F.ws + WS_RC) + (size_t)(tok0 + tr) * D + 128 * w + 8 * kq;
        u32x4 xc[2][4], xn[2][4];
#pragma unroll
        for (int tq = 0; tq < 2; ++tq)
#pragma unroll
            for (int sp = 0; sp < 4; ++sp) xc[tq][sp] = *(const GAS u32x4*)(xbase + (size_t)(16 * tq) * D + 32 * sp);
#pragma unroll 1
        for (int half = 0; half < 4; ++half) {
            f32x4 acc[2][3];
            { const int hn = (half < 3) ? half + 1 : half;
#pragma unroll
              for (int tq = 0; tq < 2; ++tq)
#pragma unroll
                for (int sp = 0; sp < 4; ++sp) xn[tq][sp] = *(const GAS u32x4*)(xbase + (size_t)(16 * (2 * hn + tq)) * D + 32 * sp); }
#pragma unroll
            for (int tq = 0; tq < 2; ++tq) {
                const int tb = 2 * half + tq;
                float ss = 0.f;
                acc[tq][0] = (f32x4){0.f, 0.f, 0.f, 0.f}; acc[tq][1] = acc[tq][0]; acc[tq][2] = acc[tq][0];
#pragma unroll
                for (int sp = 0; sp < 4; ++sp) {
                    const u32x4 xw = xc[tq][sp];
#pragma unroll
                    for (int e = 0; e < 4; ++e) { const float a0 = bflo(xw[e]), a1 = bfhi(xw[e]); ss += a0 * a0 + a1 * a1; }
                    const bf16x8 ah = __builtin_bit_cast(bf16x8, xw);
#pragma unroll
                    for (int nb = 0; nb < 3; ++nb) {
                        acc[tq][nb] = __builtin_amdgcn_mfma_f32_16x16x32_bf16(ah, bfr[sp][nb][0], acc[tq][nb], 0, 0, 0);
                        acc[tq][nb] = __builtin_amdgcn_mfma_f32_16x16x32_bf16(ah, bfr[sp][nb][1], acc[tq][nb], 0, 0, 0);
                    }
                }
                ss += __shfl_xor(ss, 16); ss += __shfl_xor(ss, 32);
                if (kq == 0) ssp[w * 128 + 16 * tb + tr] = ss;
            }
#pragma unroll
            for (int tq = 0; tq < 2; ++tq)
#pragma unroll
                for (int sp = 0; sp < 4; ++sp) xc[tq][sp] = xn[tq][sp];
#pragma unroll
            for (int tq = 0; tq < 2; ++tq)
#pragma unroll
                for (int nb = 0; nb < 3; ++nb)
#pragma unroll
                    for (int r = 0; r < 4; ++r) red[w * 1536 + ((tq * 3 + nb) * 4 + r) * 64 + lane] = acc[tq][nb][r];
            __syncthreads();
#pragma unroll
            for (int q = 0; q < 3; ++q) {
                const int e = F.tid + 512 * q, idx = e >> 6, ln = e & 63;
                float sum = 0.f;
#pragma unroll
                for (int ww = 0; ww < 8; ++ww) sum += red[ww * 1536 + e];
                const int r = idx & 3, nb = (idx >> 2) % 3, tq = idx / 12;
                lgs[(16 * (2 * half + tq) + 4 * (ln >> 4) + r) * 49 + 16 * nb + (ln & 15)] = sum;
            }
            __syncthreads();
        }
        __syncthreads();
        int re1 = 0, re2 = 0; float g1 = 0.f, g2 = 0.f, rstd = 0.f; unsigned s1 = 0, s2 = 0;
        const int t = F.tid;
        if (t < 128) {
            float ss = 0.f;
#pragma unroll
            for (int q = 0; q < 8; ++q) ss += ssp[q * 128 + t];
            rstd = 1.0f / sqrtf(ss * (1.0f / D) + EPS);
            float lg[36];
#pragma unroll
            for (int e = 0; e < 36; ++e) lg[e] = lgs[t * 49 + e] * rstd;
            float gmax = lg[0]; int gi = 0;
#pragma unroll
            for (int j = 1; j < 4; ++j) if (lg[j] > gmax) { gmax = lg[j]; gi = j; }
            float den = 0.f;
#pragma unroll
            for (int j = 0; j < 4; ++j) den += __expf(lg[j] - gmax);
            const float gwt = 1.0f / den;
            float le[8];
#pragma unroll
            for (int e = 0; e < 8; ++e) le[e] = gi == 0 ? lg[4 + e] : (gi == 1 ? lg[12 + e] : (gi == 2 ? lg[20 + e] : lg[28 + e]));
            float t1 = le[0]; int i1 = 0;
#pragma unroll
            for (int e = 1; e < 8; ++e) if (le[e] > t1) { t1 = le[e]; i1 = e; }
            float t2 = -INFINITY; int i2 = 0;
#pragma unroll
            for (int e = 0; e < 8; ++e) if (e != i1 && le[e] > t2) { t2 = le[e]; i2 = e; }
            const float ex = __expf(t2 - t1), p1 = 1.0f / (1.0f + ex), p2 = ex * p1;
            re1 = gi * 8 + i1; re2 = gi * 8 + i2; g1 = p1 * gwt; g2 = p2 * gwt;
            s1 = __hip_atomic_fetch_add(hist + re1, 1u, __ATOMIC_RELAXED, __HIP_MEMORY_SCOPE_WORKGROUP); s2 = __hip_atomic_fetch_add(hist + re2, 1u, __ATOMIC_RELAXED, __HIP_MEMORY_SCOPE_WORKGROUP);
        }
        __syncthreads();
        if (t < 64) { const unsigned c = hist[t]; hist[64 + t] = c ? __hip_atomic_fetch_add(cnt + 64 * t, c, RLX_AGENT) : 0u; }
        __syncthreads();
        if (t < 128) {
            const size_t p1 = (size_t)re1 * CAP + hist[64 + re1] + s1, p2 = (size_t)re2 * CAP + hist[64 + re2] + s2;
            LT[p1] = 2 * (tok0 + t); LG[p1] = g1; LR[p1] = rstd;
            LT[p2] = 2 * (tok0 + t) + 1; LG[p2] = g2; LR[p2] = rstd;
        }
    }
}
DI void build_tile_table(Frame& F) {
    LAS int* tbl = (LAS int*)(F.lds + TBL_OFF);
    unsigned* cnt = (unsigned*)(F.ws + WS_CTL) + CW_CNT;
    __syncthreads();
    if (F.tid < 64) tbl[F.tid] = (F.tid < 32) ? (int)__hip_atomic_load(cnt + 64 * F.tid, RLX_AGENT) : 0;
    __syncthreads();
    if (F.tid == 0) { int a = 0; for (int j = 0; j < 64; ++j) { tbl[64 + j] = a; a += (tbl[j] + 255) >> 8; } tbl[128] = a; }
    __syncthreads();
}

DI void final_phase(Frame& F) {
    const bf16_t* C0 = (const bf16_t*)(F.ws + WS_RB); const bf16_t* C1 = (const bf16_t*)(F.ws + WS_RA); const bf16_t* X2 = (const bf16_t*)(F.ws + WS_RC);
    const size_t n8 = (size_t)T * D / 8;
    for (size_t i = (size_t)F.bid * NTHR + F.tid; i < n8; i += (size_t)F.G * NTHR) {
        const u32x4 a = __builtin_nontemporal_load((const GAS u32x4*)(C0 + i * 8)), b = __builtin_nontemporal_load((const GAS u32x4*)(C1 + i * 8)), x = __builtin_nontemporal_load((const GAS u32x4*)(X2 + i * 8));
        GAS f32x4* o = (GAS f32x4*)(F.out + i * 8);
        f32x4 o0, o1;
        o0[0] = bflo(x.x) + (bflo(a.x) + bflo(b.x)); o0[1] = bfhi(x.x) + (bfhi(a.x) + bfhi(b.x)); o0[2] = bflo(x.y) + (bflo(a.y) + bflo(b.y)); o0[3] = bfhi(x.y) + (bfhi(a.y) + bfhi(b.y));
        o1[0] = bflo(x.z) + (bflo(a.z) + bflo(b.z)); o1[1] = bfhi(x.z) + (bfhi(a.z) + bfhi(b.z)); o1[2] = bflo(x.w) + (bflo(a.w) + bflo(b.w)); o1[3] = bfhi(x.w) + (bfhi(a.w) + bfhi(b.w));
        __builtin_nontemporal_store(o0, o); __builtin_nontemporal_store(o1, o + 1);
    }
}

__global__ void __launch_bounds__(NTHR, 2) fwd_kernel(Args args) {
    extern __shared__ __attribute__((aligned(16))) unsigned char lds_raw[];
    Frame F;
    F.lds = (LAS unsigned char*)lds_raw;
    F.ws = args.ws; F.out = args.out; F.in = args.in;
    F.tid = threadIdx.x; F.lane = F.tid & 63; F.wave = __builtin_amdgcn_readfirstlane(F.tid >> 6);
    F.G = gridDim.x; F.bid = blockIdx.x;
    for (int u = F.tid; u < (LDS_BYTES - LDSCTL_OFF) / 4; u += NTHR) ((LAS unsigned*)(F.lds + LDSCTL_OFF))[u] = 0u;
    __syncthreads();
    unsigned* ctl = (unsigned*)(args.ws + WS_CTL);
    const int lo = args.ph_lo, hi = args.ph_hi;
    XcdBarrier bar; bar.bar = ctl + CW_BAR; bar.x = 0; bar.st = nullptr;
    if (hi - lo > 1) bar = xcd_barrier_post(ctl + CW_BAR, (volatile LAS unsigned*)(F.lds + MISC_OFF) + 8);
    Sched S; S.G = F.G; S.c = F.bid; S.ws = F.ws; S.tbl = (const LAS int*)(F.lds + TBL_OFF); S.round = 0;
    EpiCtx E; E.ws = F.ws; E.out = F.out; E.in = F.in;
#define IN(k) (lo <= (k) && (k) < hi)
#define SEAM(k) do { if (IN(k) && IN((k) + 1)) xcd_barrier(bar); } while (0)
#ifndef DUP_PHASE
#define DUP_PHASE -1
#endif
#ifndef TS_UNIT
#define TS_UNIT 100
#endif
#if TS_PHASE >= 0
    volatile LAS unsigned long long* tsw = (volatile LAS unsigned long long*)(F.lds + MISC_OFF + 64);
#define STAMP(k) do { if (F.tid == 0) tsw[k] = __builtin_amdgcn_s_memrealtime(); } while (0)
#else
#define STAMP(k) do { } while (0)
#endif
    STAMP(0);
#define RUNPH(k, body) do { if (IN(k)) { const int nrep_ = (DUP_PHASE == (k)) ? 2 + (lo >> 20) : 1; for (int rep_ = 0; rep_ < nrep_; ++rep_) { if (rep_) xcd_barrier(bar); body; } } SEAM(k); STAMP((k) + 1); } while (0)
    RUNPH(PH_P0, p0_prologue(F));
#if DUP_PHASE == 100
    for (int i = 0; i < 4; ++i) xcd_barrier(bar);
#endif
    RUNPH(PH_PROJ, { const bool conv_first = (F.bid & 7) < 4; if (conv_first) p0b_expert_weights(F); gemm_phase<PH_PROJ>(F.lds, S, E); gemm_phase<PH_MEMK>(F.lds, S, E); gemm_phase<PH_MEMV>(F.lds, S, E); if (!conv_first) p0b_expert_weights(F); });
    RUNPH(PH_MIX, mix_phase(F));
    RUNPH(PH_WOUT, gemm_phase<PH_WOUT>(F.lds, S, E));
    RUNPH(PH_WCQ, { gemm_phase<PH_WCQ>(F.lds, S, E); xattn_phase(F); });
    STAMP(PH_SC + 1); STAMP(PH_PV + 1);
    RUNPH(PH_WCO, gemm_phase<PH_WCO>(F.lds, S, E));
    RUNPH(PH_ROUTE, route_phase(F, rep_ + 1 < nrep_));
    RUNPH(PH_UP, { build_tile_table(F); gemm_phase<PH_UP>(F.lds, S, E); (gemm_phase<PH_UP, 1>)(F.lds, S, E); (gemm_phase<PH_UP, 2>)(F.lds, S, E); });
    RUNPH(PH_DOWN0, { build_tile_table(F); gemm_phase<PH_DOWN0>(F.lds, S, E); (gemm_phase<PH_DOWN0, 1>)(F.lds, S, E); (gemm_phase<PH_DOWN0, 2>)(F.lds, S, E); });
    RUNPH(PH_DOWN1, final_phase(F));
#if TS_PHASE >= 0
    xcd_barrier(bar);
    if (F.bid == 0 && F.tid == 0) { const unsigned long long dt = (TS_PHASE == 30 ? (tsw[PH_N] - tsw[0]) : (tsw[TS_PHASE + 1] - tsw[TS_PHASE])) / TS_UNIT; F.out[0] += (float)(dt > 250ull ? 250ull : dt); }
#endif
#undef RUNPH
#undef IN
#undef SEAM
}

#ifndef N_LAUNCH_MODE
#define N_LAUNCH_MODE 1
#endif
extern "C" void kernel_launch(void* const* d_in, const int* in_sizes, int n_in, void* d_out, int out_size, void* d_ws, size_t ws_size, hipStream_t stream) {
    static int grid = 0;
    if (grid == 0) {
        if (n_in != 27 || out_size != T * D || ws_size < WS_END) { fprintf(stderr, "kernel_launch: unexpected shapes (n_in %d out %d ws %zu)\n", n_in, out_size, ws_size); grid = -1; return; }
        int dev = 0, cus = 0, per_cu = 0;
        if (hipGetDevice(&dev) != hipSuccess || hipDeviceGetAttribute(&cus, hipDeviceAttributeMultiprocessorCount, dev) != hipSuccess) { grid = -1; return; }
        if (hipFuncSetAttribute((const void*)fwd_kernel, hipFuncAttributeMaxDynamicSharedMemorySize, LDS_BYTES) != hipSuccess) { fprintf(stderr, "kernel_launch: hipFuncSetAttribute failed\n"); grid = -1; return; }
        if (hipOccupancyMaxActiveBlocksPerMultiprocessor(&per_cu, (const void*)fwd_kernel, NTHR, LDS_BYTES) != hipSuccess || per_cu < 1) { fprintf(stderr, "kernel_launch: occupancy query says %d\n", per_cu); }
        (void)hipGetLastError();
        grid = cus;
    }
    if (grid < 0) return;
    (void)hipMemsetAsync((char*)d_ws + WS_CTL, 0, CTL_ZERO_BYTES, stream);
    Args a{};
    for (int i = 0; i < 27; ++i) a.in[i] = (const float*)d_in[i];
    a.out = (float*)d_out; a.ws = (unsigned char*)d_ws;
    if (N_LAUNCH_MODE == 1) { a.ph_lo = 0; a.ph_hi = PH_N; hipLaunchKernelGGL(fwd_kernel, dim3(grid), dim3(NTHR), LDS_BYTES, stream, a); }
    else for (int p = 0; p < PH_N; ++p) { a.ph_lo = p; a.ph_hi = p + 1; hipLaunchKernelGGL(fwd_kernel, dim3(grid), dim3(NTHR), LDS_BYTES, stream, a); }
}
```

```cpp
#include <hip/hip_runtime.h>
#include <hip/hip_bf16.h>
#include <cstdio>
#include <cstdint>

#define GAS __attribute__((address_space(1)))
#define LAS __attribute__((address_space(3)))
typedef unsigned short bf16_t;
typedef short bf16x8 __attribute__((ext_vector_type(8)));
typedef short s16x4 __attribute__((ext_vector_type(4)));
typedef float f32x4 __attribute__((ext_vector_type(4)));
typedef float f32x2 __attribute__((ext_vector_type(2)));
typedef float f32x16 __attribute__((ext_vector_type(16)));
typedef unsigned u32x4 __attribute__((ext_vector_type(4)));
typedef unsigned u32x2 __attribute__((ext_vector_type(2)));
typedef __bf16 bf16x2_t __attribute__((ext_vector_type(2)));
typedef int v8i_t __attribute__((ext_vector_type(8)));
typedef int v4i_t __attribute__((ext_vector_type(4)));
#define DI __device__ __forceinline__

#ifndef TS_PHASE
#define TS_PHASE -1
#endif
constexpr int T = 32768, D = 1024, BATCH = 8, SEQ = 4096, MEML = 256, NMEM = BATCH * MEML;
constexpr int INW = 1792;
constexpr int PJW = 768;
constexpr float EPS = 1e-6f;
constexpr int NWAVES = 8, NTHR = 512;
constexpr int CAP = 32768;
constexpr int MAXRT = 320;

constexpr size_t MiB = 1u << 20;
constexpr size_t WS_CTL = 0, CTL_ZERO_BYTES = 64 * 1024;
constexpr size_t WS_WRT = 1 * MiB;
constexpr size_t WS_SSQ1P = 2 * MiB;
constexpr size_t WS_SSQQ = 4 * MiB;
constexpr size_t WS_LSUM = 6 * MiB;
constexpr size_t WS_SSQK = 8 * MiB;
constexpr size_t WS_RSTDK = 8 * MiB + 512 * 1024;
constexpr size_t WS_RSTD0 = 9 * MiB;
constexpr size_t WS_LTOK = 10 * MiB, WS_LGATE = 18 * MiB, WS_LRSTD = 26 * MiB;
constexpr size_t WS_WIN = 34 * MiB, WS_WOUT = 38 * MiB, WS_WCQ = 40 * MiB, WS_WCK = 42 * MiB, WS_WCV = 44 * MiB, WS_WCO = 46 * MiB;
constexpr size_t WS_W13 = 48 * MiB, WS_W2 = 112 * MiB;
constexpr size_t WS_X2F8 = 80 * MiB;
constexpr size_t WS_MEMB = 144 * MiB, WS_KMEM = 148 * MiB, WS_VMT = 152 * MiB;
constexpr size_t WS_RA = 156 * MiB;
constexpr size_t WS_RB = 220 * MiB;
constexpr size_t WS_RC = 332 * MiB;
constexpr size_t WS_RD = 396 * MiB;
constexpr size_t WS_END = 476 * MiB;
constexpr int CW_BAR = 4096, CW_CNT = 8192;

constexpr int RING_BYTES = 131072;
constexpr int LDS_BYTES = 147456;
constexpr int LDSCTL_OFF = RING_BYTES, MISC_OFF = LDS_BYTES - 256;
constexpr int TBL_OFF = RING_BYTES + 512;
constexpr int XCH_OFF = RING_BYTES + 2048;
constexpr int SGP_OFF = RING_BYTES + 4096;
constexpr int SGR_OFF = RING_BYTES + 8192;
constexpr int RT_XT_BYTES = 16 * 260 * 4;
constexpr int RT_HIST_OFF = 8 * RT_XT_BYTES;

#define RLX_AGENT __ATOMIC_RELAXED, __HIP_MEMORY_SCOPE_AGENT
#define LDS_WAIT() asm volatile("s_waitcnt lgkmcnt(0)" ::: "memory")
#define VM_WAIT() asm volatile("s_waitcnt vmcnt(0)" ::: "memory")
DI unsigned f2bf(float f) { unsigned u = __builtin_bit_cast(unsigned, f); return (u + 0x7fffu + ((u >> 16) & 1u)) >> 16; }
DI unsigned pk2(float lo, float hi) { f32x2 v = {lo, hi}; bf16x2_t b = __builtin_convertvector(v, bf16x2_t); return __builtin_bit_cast(unsigned, b); }
DI unsigned pk4_fp8(float a, float b, float c, float d) { int w = 0; w = __builtin_amdgcn_cvt_pk_fp8_f32(a, b, w, false); w = __builtin_amdgcn_cvt_pk_fp8_f32(c, d, w, true); return (unsigned)w; }
DI float bf2f(unsigned short h) { return __builtin_bit_cast(float, (unsigned)h << 16); }
DI float bflo(unsigned w) { return __builtin_bit_cast(float, w << 16); }
DI float bfhi(unsigned w) { return __builtin_bit_cast(float, w & 0xffff0000u); }
DI float wave_sum(float v) {
#pragma unroll
    for (int o = 1; o < 64; o <<= 1) v += __shfl_xor(v, o);
    return v;
}
DI float fast_exp(float x) { return __builtin_amdgcn_exp2f(x * 1.4426950408889634f); }
DI float gelu_tanh(float x) {
    const float z2 = 1.5957691216057308f * (x + 0.044715f * x * x * x);
    return x * __builtin_amdgcn_rcpf(1.0f + fast_exp(-z2));
}
DI float silu(float x) { return x * __builtin_amdgcn_rcpf(1.0f + fast_exp(-x)); }

#define XB_TMO      128
#define XB_XCNT(j)  (256  + 64 * (j))
#define XB_XSUB(j)  (1280 + 64 * (j))
#define XB_XGEN(j)  (2304 + 64 * (j))
#define XB_TOP      3328
#define XB_TOPGEN   3392
#define XCD_BAR_WORDS 3456
#define XB_SPIN_CAP (1u << 18)
DI unsigned xb_ld(unsigned* p)              { return __hip_atomic_load(p, __ATOMIC_RELAXED, __HIP_MEMORY_SCOPE_AGENT); }
DI unsigned xb_add(unsigned* p, unsigned v) { return __hip_atomic_fetch_add(p, v, __ATOMIC_RELAXED, __HIP_MEMORY_SCOPE_AGENT); }
DI unsigned xb_xcc_id() { return (unsigned)__builtin_amdgcn_s_getreg((3 << 11) | 20) & 0xFu; }
#define XB_SPIN(cond, bar) do { unsigned _sp = 0; while (cond) { __builtin_amdgcn_s_sleep(1); \
    if ((++_sp & 255u) == 0u) { if (xb_ld(&(bar)[XB_TMO])) break; if (_sp > XB_SPIN_CAP) { atomicAdd(&(bar)[XB_TMO], 1u); break; } } } } while (0)
struct XcdBarrier { unsigned* bar; unsigned x; volatile LAS unsigned* st; };
DI XcdBarrier xcd_barrier_post(unsigned* bar, volatile LAS unsigned* st) {
    XcdBarrier b; b.bar = bar; b.x = xb_xcc_id(); b.st = st;
    if (threadIdx.x == 0) (void)xb_add(&bar[XB_XCNT(b.x)], 1u);
    return b;
}
DI void xcd_barrier_complete(unsigned* bar, unsigned x, unsigned& nloc, unsigned& nx) {
    const unsigned G = gridDim.x * gridDim.y * gridDim.z;
    unsigned sum, cnt, mine, sp = 0u;
    for (;;) {
        sum = 0u; cnt = 0u; mine = 0u;
#pragma unroll
        for (unsigned j = 0; j < 16; ++j) { const unsigned c = xb_ld(&bar[XB_XCNT(j)]); sum += c; cnt += (c > 0u) ? 1u : 0u; mine = (j == x) ? c : mine; }
        if (sum == G) break;
        __builtin_amdgcn_s_sleep(1);
        if ((++sp & 255u) == 0u) { if (xb_ld(&bar[XB_TMO])) break; if (sp > XB_SPIN_CAP) { atomicAdd(&bar[XB_TMO], 1u); break; } }
    }
    nloc = mine > 0u ? mine : 1u; nx = cnt > 0u ? cnt : 1u;
}
DI void xcd_barrier(const XcdBarrier& b) {
    asm volatile("s_waitcnt vmcnt(0)" ::: "memory");
    __syncthreads();
    if (threadIdx.x == 0) {
        unsigned* bar = b.bar;
        __builtin_amdgcn_s_waitcnt(0);
        unsigned nloc = b.st[0], nx = b.st[1];
        if (nloc == 0u) { xcd_barrier_complete(bar, b.x, nloc, nx); b.st[0] = nloc; b.st[1] = nx; }
        const unsigned old = xb_add(&bar[XB_XSUB(b.x)], 1u);
        const unsigned gen = old / nloc;
        if (old + 1u == (gen + 1u) * nloc) {
            __builtin_amdgcn_fence(__ATOMIC_RELEASE, "agent");
            asm volatile("s_waitcnt vmcnt(0)" ::: "memory");
            const unsigned og = xb_add(&bar[XB_TOP], 1u);
            const unsigned tg = og / nx;
            if (og + 1u == (tg + 1u) * nx) xb_add(&bar[XB_TOPGEN], 1u);
            else XB_SPIN(xb_ld(&bar[XB_TOPGEN]) == tg, bar);
            __builtin_amdgcn_fence(__ATOMIC_ACQUIRE, "agent");
            xb_add(&bar[XB_XGEN(b.x)], 1u);
            asm volatile("s_waitcnt vmcnt(0)" ::: "memory");
        } else {
            XB_SPIN(xb_ld(&bar[XB_XGEN(b.x)]) == gen, bar);
            __builtin_amdgcn_fence(__ATOMIC_ACQUIRE, "agent");
            asm volatile("s_waitcnt vmcnt(0)" ::: "memory");
        }
    }
    __syncthreads();
}

struct Args {
    const float* in[27];
    float* out; unsigned char* ws;
    int ph_lo, ph_hi;
};
struct Frame {
    LAS unsigned char* lds;
    unsigned char* ws; float* out;
    int tid, lane, wave, G, bid;
    const float* const* in;
};
enum { I_X = 0, I_MEM, I_NORM_MIX, I_W_IN, I_Q_NORM, I_K_NORM, I_SINKS, I_SGU_NORM, I_SGU_W, I_SGU_B, I_ON_ATTN, I_ON_SGU, I_W_OUT,
       I_NORM_CROSS, I_NORM_MEM, I_W_CQ, I_W_CK, I_W_CV, I_CQ_NORM, I_CK_NORM, I_W_CO, I_NORM_FFN, I_WRG, I_WRE, I_W1, I_W3, I_W2 };

DI void p0_transpose_item(const float* W, int N, bf16_t* WT, int ldt, int row_off, const float* gain, LAS unsigned* scr, int kb, int nb, int lane) {
    const int k0 = 64 * kb, n0 = 64 * nb, c = lane & 15, kp = lane >> 4;
    f32x4 va[8], vb[8];
#pragma unroll
    for (int i = 0; i < 8; ++i) { const int kk = 2 * (kp + 4 * i);
        va[i] = __builtin_nontemporal_load((const GAS f32x4*)(W + (size_t)(k0 + kk) * N + n0 + 4 * c)); vb[i] = __builtin_nontemporal_load((const GAS f32x4*)(W + (size_t)(k0 + kk + 1) * N + n0 + 4 * c)); }
#pragma unroll
    for (int i = 0; i < 8; ++i) { const int kk = 2 * (kp + 4 * i);
        float ga = 1.f, gb = 1.f; if (gain) { ga = gain[k0 + kk]; gb = gain[k0 + kk + 1]; }
#pragma unroll
        for (int e = 0; e < 4; ++e) scr[(4 * c + e) * 33 + (kp + 4 * i)] = pk2(va[i][e] * ga, vb[i][e] * gb); }
    LDS_WAIT(); asm volatile("" ::: "memory");
    const int ch = lane & 7;
#pragma unroll
    for (int j = 0; j < 8; ++j) { const int n = (lane >> 3) + 8 * j; const LAS unsigned* sp = scr + n * 33 + 4 * ch;
        u32x4 o; o.x = sp[0]; o.y = sp[1]; o.z = sp[2]; o.w = sp[3];
        *(GAS u32x4*)(WT + (size_t)(row_off + n0 + n) * ldt + k0 + 8 * ch) = o; }
    LDS_WAIT(); asm volatile("" ::: "memory");
}
DI void p0_transpose_item_f8(const float* W, int N, unsigned char* WT, int ldt, int row_off, const float* gain, LAS unsigned* scr, int kb, int nb, int lane) {
    const int k0 = 128 * kb, n0 = 32 * nb, c = lane & 7, kq = lane >> 3;
    f32x4 v[4][4];
#pragma unroll
    for (int i = 0; i < 4; ++i)
#pragma unroll
        for (int r = 0; r < 4; ++r) v[i][r] = __builtin_nontemporal_load((const GAS f32x4*)(W + (size_t)(k0 + 4 * (kq + 8 * i) + r) * N + n0 + 4 * c));
#pragma unroll
    for (int i = 0; i < 4; ++i) {
        f32x4 g = {32.f, 32.f, 32.f, 32.f}; if (gain) g = *(const f32x4*)(gain + k0 + 4 * (kq + 8 * i)) * 32.f;
#pragma unroll
        for (int e = 0; e < 4; ++e) scr[(4 * c + e) * 33 + (kq + 8 * i)] = pk4_fp8(v[i][0][e] * g[0], v[i][1][e] * g[1], v[i][2][e] * g[2], v[i][3][e] * g[3]); }
    LDS_WAIT(); asm volatile("" ::: "memory");
    const int ch = lane & 7;
#pragma unroll
    for (int j = 0; j < 4; ++j) { const int n = (lane >> 3) + 8 * j; const LAS unsigned* sp = scr + n * 33 + 4 * ch;
        u32x4 o; o.x = sp[0]; o.y = sp[1]; o.z = sp[2]; o.w = sp[3];
        *(GAS u32x4*)(WT + (size_t)(row_off + n0 + n) * ldt + k0 + 16 * ch) = o; }
    LDS_WAIT(); asm volatile("" ::: "memory");
}
DI void rms_row_to_bf16(const float* xrow, bf16_t* orow, int lane, float* rstd_out) {
    const GAS f32x4* xr = (const GAS f32x4*)xrow + lane;
    f32x4 v[4]; float s = 0.f;
#pragma unroll
    for (int j = 0; j < 4; ++j) { v[j] = __builtin_nontemporal_load(xr + 64 * j); s += (v[j].x * v[j].x + v[j].y * v[j].y) + (v[j].z * v[j].z + v[j].w * v[j].w); }
    float rstd = 1.0f / sqrtf(wave_sum(s) * (1.f / D) + EPS);
    if (rstd_out) { if (lane == 0) *rstd_out = rstd; rstd = 1.0f; }
    GAS u32x2* o8 = (GAS u32x2*)orow + lane;
#pragma unroll
    for (int j = 0; j < 4; ++j) { u32x2 w; w.x = pk2(v[j].x * rstd, v[j].y * rstd); w.y = pk2(v[j].z * rstd, v[j].w * rstd); o8[64 * j] = w; }
}
DI void p0_prologue(Frame& F) {
    LAS unsigned* scr = (LAS unsigned*)(F.lds + F.wave * 16384);
    const int gw = F.bid * NWAVES + F.wave, NGW = F.G * NWAVES, lane = F.lane;
    unsigned char* ws = F.ws;
    constexpr int I_IN = 16 * 28, I_SQ = 16 * 16, I_E1 = 32 * 16 * 8, I_E2 = 32 * 8 * 16;
    constexpr int NITEMS = I_IN + 2 * I_SQ;
    for (int it = gw; it < NITEMS; it += NGW) {
        int r = it;
        if (r < I_IN) { p0_transpose_item(F.in[I_W_IN], INW, (bf16_t*)(ws + WS_WIN), D, 0, F.in[I_NORM_MIX], scr, r / 28, r % 28, lane); continue; } r -= I_IN;
        if (r < I_SQ) { p0_transpose_item(F.in[I_W_CK], D, (bf16_t*)(ws + WS_WCK), D, 0, F.in[I_NORM_MEM], scr, r / 16, r % 16, lane); continue; } r -= I_SQ;
        if (r < I_SQ) { p0_transpose_item(F.in[I_W_CV], D, (bf16_t*)(ws + WS_WCV), D, 0, F.in[I_NORM_MEM], scr, r / 16, r % 16, lane); continue; } r -= I_SQ;
    }
    (void)I_E1; (void)I_E2;
#if 0
        if (r < I_E1) { const int e = r / 128, q = r % 128;
                        p0_transpose_item(F.in[I_W1] + (size_t)e * D * 512, 512, (bf16_t*)(ws + WS_W13) + (size_t)e * 1024 * 1024, D, 0, F.in[I_NORM_FFN], scr, q / 8, q % 8, lane); continue; } r -= I_E1;
        if (r < I_E1) { const int e = r / 128, q = r % 128;
                        p0_transpose_item(F.in[I_W3] + (size_t)e * D * 512, 512, (bf16_t*)(ws + WS_W13) + (size_t)e * 1024 * 1024, D, 512, F.in[I_NORM_FFN], scr, q / 8, q % 8, lane); continue; } r -= I_E1;
        { const int e = r / 128, q = r % 128;
          p0_transpose_item(F.in[I_W2] + (size_t)e * 512 * D, D, (bf16_t*)(ws + WS_W2) + (size_t)e * 1024 * 512, 512, 0, nullptr, scr, q / 16, q % 16, lane); }
    }
#endif
    for (int m = gw; m < T + NMEM; m += NGW) {
        if (m < T) rms_row_to_bf16(F.in[I_X] + (size_t)m * D, (bf16_t*)(ws + WS_RA) + (size_t)m * D, lane, (float*)(ws + WS_RSTD0) + m);
        else rms_row_to_bf16(F.in[I_MEM] + (size_t)(m - T) * D, (bf16_t*)(ws + WS_MEMB) + (size_t)(m - T) * D, lane, nullptr);
    }
    {
        bf16_t* swb = (bf16_t*)(ws + WS_WRT + 512 * 1024);
        for (int i = F.bid * NTHR + F.tid; i < 8 * 128 * 128 / 8; i += F.G * NTHR) {
            const int j8 = (i & 15) * 8, ii = (i >> 4) & 127;
            const f32x4 a = *(const f32x4*)(F.in[I_SGU_W] + (size_t)i * 8), c = *(const f32x4*)(F.in[I_SGU_W] + (size_t)i * 8 + 4);
            float v[8] = {a[0], a[1], a[2], a[3], c[0], c[1], c[2], c[3]};
#pragma unroll
            for (int e = 0; e < 8; ++e) v[e] = (j8 + e <= ii) ? v[e] : 0.f;
            u32x4 w; w.x = pk2(v[0], v[1]); w.y = pk2(v[2], v[3]); w.z = pk2(v[4], v[5]); w.w = pk2(v[6], v[7]);
            *(GAS u32x4*)(swb + (size_t)i * 8) = w;
        }
    }
    if (F.bid == 0 && F.wave == 0) {
        float a = 0.f, b = 0.f;
        for (int i = lane; i < 256; i += 64) { a = fmaxf(a, fabsf(F.in[I_CQ_NORM][i])); b = fmaxf(b, fabsf(F.in[I_CK_NORM][i])); }
#pragma unroll
        for (int o = 1; o < 64; o <<= 1) { a = fmaxf(a, __shfl_xor(a, o)); b = fmaxf(b, __shfl_xor(b, o)); }
        if (lane == 0) *(float*)(ws + WS_WRT + 256 * 1024) = 16.0f * a * b * 1.4426950408889634f;
    }
    {
        bf16_t* wrp = (bf16_t*)(ws + WS_WRT);
        for (int i = F.bid * NTHR + F.tid; i < 32 * 3 * 64 * 8; i += F.G * NTHR) {
            const int j = i & 7, ln = (i >> 3) & 63, nb = (i >> 9) % 3, sidx = i / 1536;
            const int k = 32 * sidx + 8 * (ln >> 4) + j, e = 16 * nb + (ln & 15);
            float w = 0.f;
            if (e < 4) w = F.in[I_WRG][k * 4 + e];
            else if (e < 36) { const int g = (e - 4) >> 3, ee = (e - 4) & 7; w = F.in[I_WRE][((size_t)g * D + k) * 8 + ee]; }
            w *= F.in[I_NORM_FFN][k];
            const unsigned h = f2bf(w); const unsigned l = f2bf(w - bf2f((unsigned short)h));
            wrp[((size_t)((sidx * 3 + nb) * 2 + 0) * 64 + ln) * 8 + j] = (bf16_t)h;
            wrp[((size_t)((sidx * 3 + nb) * 2 + 1) * 64 + ln) * 8 + j] = (bf16_t)l;
        }
    }
}

DI void p0b_expert_weights(Frame& F) {
    LAS unsigned* scr = (LAS unsigned*)(F.lds + F.wave * 16384);
    int lane = F.lane; asm volatile("" : "+v"(lane));
    unsigned char* ws = F.ws;
    constexpr int I_E1 = 32 * 16 * 8, I_E2 = 32 * 8 * 16, I_SQ = 16 * 16, NEXP = 2 * I_E1 + I_E2;
    const int c = F.bid, G = F.G;
    int i0, i1;
    if (G == 256) { const int w0 = c < 192 ? 2 * c : 384 + 4 * (c - 192), w1 = w0 + (c < 192 ? 2 : 4); i0 = (int)(((long)w0 * NEXP) / 640); i1 = (int)(((long)w1 * NEXP) / 640); }
    else { i0 = (int)(((long)c * NEXP) / G); i1 = (int)(((long)(c + 1) * NEXP) / G); }
#pragma unroll 1
    for (int r = c * NWAVES + F.wave; r < 3 * I_SQ; r += G * NWAVES) {
        const int m = r >> 8, q = r & 255, kb = q >> 4, nb = q & 15;
        const float* W; bf16_t* WT; const float* gain;
        if (m == 0) { W = F.in[I_W_OUT]; WT = (bf16_t*)(ws + WS_WOUT); gain = (kb < 8) ? F.in[I_ON_ATTN] : (F.in[I_ON_SGU] - 512); }
        else if (m == 1) { W = F.in[I_W_CQ]; WT = (bf16_t*)(ws + WS_WCQ); gain = F.in[I_NORM_CROSS]; }
        else { W = F.in[I_W_CO]; WT = (bf16_t*)(ws + WS_WCO); gain = nullptr; }
        p0_transpose_item(W, D, WT, D, 0, gain, scr, kb, nb, lane);
    }
#pragma unroll 1
    for (int it = i0 + F.wave; it < i1; it += NWAVES) {
        const float* W; int N, ldt, row_off, kb, nb; unsigned char* WT; const float* gain;
        if (it < 2 * I_E1) { const int which = it < I_E1 ? 0 : 1, r = it - which * I_E1, e = r >> 7, q = r & 127;
            W = F.in[which == 0 ? I_W1 : I_W3] + (size_t)e * D * 512; N = 512; WT = ws + WS_W13 + (size_t)e * 1024 * 1024; ldt = D; row_off = which * 512; gain = F.in[I_NORM_FFN]; kb = q >> 4; nb = q & 15; }
        else { const int r = it - 2 * I_E1, e = r >> 7, q = r & 127;
            W = F.in[I_W2] + (size_t)e * 512 * D; N = D; WT = ws + WS_W2 + (size_t)e * 1024 * 512; ldt = 512; row_off = 0; gain = nullptr; kb = q >> 5; nb = q & 31; }
        p0_transpose_item_f8(W, N, WT, ldt, row_off, gain, scr, kb, nb, lane);
    }
    asm volatile("s_waitcnt vmcnt(0) lgkmcnt(0)" ::: "memory"); __syncthreads();
}

constexpr int BM = 256, BK = 64, HALF = 128, HTB = HALF * BK * 2;
DI int lds_byte(int r, int c) { const int st = (r >> 4) * 2 + (c >> 5), rr = r & 15, cc = c & 31, ob = rr * 64 + cc * 2; return st * 1024 + (ob ^ (((ob >> 9) & 1) << 5)); }
DI void stage_rc(int b, int& R, int& C) { const int st = b / 1024, sb = b % 1024, swz = sb ^ (((sb >> 9) & 1) << 5); R = (st >> 1) * 16 + swz / 64; C = (st & 1) * 32 + (swz % 64) / 2; }
DI v8i_t cat32(bf16x8 lo, bf16x8 hi) { return __builtin_shufflevector(__builtin_bit_cast(v4i_t, lo), __builtin_bit_cast(v4i_t, hi), 0, 1, 2, 3, 4, 5, 6, 7); }
DI int perm32(int rho) { const int n = rho >> 4, i = rho & 15; return 8 * (i >> 2) + 4 * n + (i & 3); }

enum { K_PROJ = 0, K_MEMK, K_MEMVT, K_WOUT, K_WCQ, K_SC, K_PV, K_WCO, K_UP, K_DOWN };
enum { PH_MEMK = 100, PH_MEMV = 101 };
enum { PH_P0 = 0, PH_PROJ, PH_MIX, PH_WOUT, PH_WCQ, PH_SC, PH_PV, PH_WCO, PH_ROUTE, PH_UP, PH_DOWN0, PH_DOWN1, PH_N };

struct GUnit {
    int half;
    const char* A; const char* B;
    int kind, pm, pn;
    const int* gl; int gcnt;
    int aux;
};

DI int xcd_remap(int wgid, int nwg) { const int q = nwg / 8, r = nwg % 8, xcd = wgid % 8, off = wgid / 8; return (xcd < r ? xcd * (q + 1) : r * (q + 1) + (xcd - r) * q) + off; }
DI void grouped_tile(int wgid, int nM, int nN, int& pm, int& pn) {
    const int nig = 8 * nN, gid = wgid / nig, fm = gid * 8, gsz = (nM - fm) < 8 ? (nM - fm) : 8;
    pm = fm + ((wgid % nig) % gsz); pn = (wgid % nig) / gsz;
}

struct Sched { int G, c; unsigned char* ws; const LAS int* tbl; int round; };
template <int PH> struct PCfg { static constexpr int K = 1024; static constexpr unsigned lda2 = 2048, ldb2 = 2048, hstepB = 32 * 2048; static constexpr int RS = 64; };
template <> struct PCfg<PH_UP> { static constexpr int K = 512; static constexpr unsigned lda2 = 1024, ldb2 = 1024, hstepB = 512 * 1024; static constexpr int RS = 32; };
template <> struct PCfg<PH_DOWN0> { static constexpr int K = 256; static constexpr unsigned lda2 = 512, ldb2 = 512, hstepB = 32 * 512; static constexpr int RS = 64; };

template <int PH, int HV = 0> DI bool sched_next(const Sched& S, int i, GUnit& u) {
    const int L = i * S.G + S.c; unsigned char* ws = S.ws;
    u.gl = nullptr; u.gcnt = 256; u.aux = 0; u.half = 0;
    if constexpr (PH == PH_PROJ) {
        constexpr int NP = 128 * 7;
        if (L >= NP) return false;
        const int w = xcd_remap(L, NP); grouped_tile(w, 128, 7, u.pm, u.pn); u.kind = K_PROJ;
        u.A = (const char*)(ws + WS_RA) + (size_t)u.pm * 256 * 2048; u.B = (const char*)(ws + WS_WIN) + (size_t)u.pn * 256 * 2048;
        return true;
    } else if constexpr (PH == PH_MEMK) {
        const int j = S.c - 128; if (i != 0 || j < 0 || j >= 32) return false;
        u.pm = j >> 2; u.pn = j & 3; u.kind = K_MEMK;
        u.A = (const char*)(ws + WS_MEMB) + (size_t)u.pm * 256 * 2048; u.B = (const char*)(ws + WS_WCK) + (size_t)u.pn * 256 * 2048;
        return true;
    } else if constexpr (PH == PH_MEMV) {
        const int j = S.c - 160; if (i != 0 || j < 0 || j >= 32) return false;
        u.pm = j >> 2; u.pn = j & 3; u.kind = K_MEMVT;
        u.A = (const char*)(ws + WS_MEMB) + (size_t)u.pm * 256 * 2048; u.B = (const char*)(ws + WS_WCV) + (size_t)u.pn * 256 * 2048;
        return true;
    } else if constexpr (PH == PH_WOUT || PH == PH_WCQ || PH == PH_WCO) {
        if (L >= 512) return false;
        const int w = xcd_remap(L, 512); grouped_tile(w, 128, 4, u.pm, u.pn);
        constexpr size_t wa = PH == PH_WOUT ? WS_RC : (PH == PH_WCQ ? WS_RA : WS_RD), wb = PH == PH_WOUT ? WS_WOUT : (PH == PH_WCQ ? WS_WCQ : WS_WCO);
        u.kind = PH == PH_WOUT ? K_WOUT : (PH == PH_WCQ ? K_WCQ : K_WCO);
        u.A = (const char*)(ws + wa) + (size_t)u.pm * 256 * 2048; u.B = (const char*)(ws + wb) + (size_t)u.pn * 256 * 2048;
        return true;
    } else {
        const LAS int* tbl = S.tbl;
        const int r0 = 0, r1 = 64;
        const int t0 = __builtin_amdgcn_readfirstlane(tbl[64 + r0]), t1 = __builtin_amdgcn_readfirstlane(tbl[64 + r1]), nu = (t1 - t0) * 4;
        const int nfull = nu / S.G, rem = nu - nfull * S.G;
        int Lu = L;
        if constexpr (HV) {
            if (i != 0 || 2 * rem > S.G || S.c >= 2 * rem || (S.c & 1) != HV - 1) return false;
            Lu = nfull * S.G + (S.c >> 1); u.half = HV;
        } else {
            if (i >= nfull) { if (i > nfull || 2 * rem <= S.G || S.c >= rem) return false; }
        }
        const int w = xcd_remap(Lu, nu); const int rt = t0 + (w >> 2), pn = w & 3;
        int ln_ = (int)(threadIdx.x & 63); asm volatile("" : "+v"(ln_));
        const int jl = r0 + 1 + ln_;
        const bool hit = (jl < r1) && (tbl[64 + (jl < 64 ? jl : 64)] <= rt);
        const int re = r0 + (int)__popcll(__ballot(hit));
        const int jt = rt - __builtin_amdgcn_readfirstlane(tbl[64 + re]), cnt = __builtin_amdgcn_readfirstlane(tbl[re]), e = re & 31;
        u.pm = rt; u.pn = pn; u.gcnt = (cnt - jt * 256) < 256 ? (cnt - jt * 256) : 256; u.aux = re * CAP + jt * 256;
        if constexpr (PH == PH_UP) { u.kind = K_UP; u.gl = (const int*)(ws + WS_LTOK) + u.aux;
            u.A = (const char*)(ws + WS_X2F8); u.B = (const char*)(ws + WS_W13) + ((size_t)e * 1024 + pn * 128) * 1024; }
        else { u.kind = K_DOWN;
            u.A = (const char*)(ws + WS_RD) + (size_t)rt * 256 * 512; u.B = (const char*)(ws + WS_W2) + ((size_t)e * 1024 + pn * 256) * 512; }
        return true;
    }
}

struct EpiCtx {
    unsigned char* ws; float* out; const float* const* in;
};

DI void store_bf16x8(bf16_t* p, const f32x4& a, const f32x4& b) { u32x4 w; w.x = pk2(a[0], a[1]); w.y = pk2(a[2], a[3]); w.z = pk2(b[0], b[1]); w.w = pk2(b[2], b[3]); *(GAS u32x4*)p = w; }
DI float sumsq16(const f32x4& a, const f32x4& b, const f32x4& c, const f32x4& d) {
    return ((a[0] * a[0] + a[1] * a[1]) + (a[2] * a[2] + a[3] * a[3])) + ((b[0] * b[0] + b[1] * b[1]) + (b[2] * b[2] + b[3] * b[3])) +
           ((c[0] * c[0] + c[1] * c[1]) + (c[2] * c[2] + c[3] * c[3])) + ((d[0] * d[0] + d[1] * d[1]) + (d[2] * d[2] + d[3] * d[3]));
}
#define RSLOT(p) (((p) == 0 ? 4 : (p) == 1 ? 5 : (p) == 2 ? 0 : (p) == 3 ? 1 : (p) == 4 ? 6 : (p) == 5 ? 7 : 2) * 16384)
#define PIN_ROW(ai, m) asm volatile("" : "+v"(acc[ai][0][m][0]), "+v"(acc[ai][0][m][1]), "+v"(acc[ai][1][m][0]), "+v"(acc[ai][1][m][1]))
DI float quad_sum(float s) { s += __shfl_xor(s, 16); s += __shfl_xor(s, 32); return s; }

template <int PH, int HV = 0> DI void epilogue(const EpiCtx& E, const GUnit& u, f32x4 (&acc)[2][2][4][2], int wr, int wc, int fr_, int fq_, const float (&epre)[8], LAS unsigned char* lds, bool resl) {
    int fr = (int)(threadIdx.x & 15), fq = (int)((threadIdx.x >> 4) & 3); asm volatile("" : "+v"(fr), "+v"(fq));
    (void)fr_; (void)fq_;
    unsigned char* ws = E.ws;
    const int rbase = wr * 64 + fr;
    const int cb = 64 * wc + 8 * fq;
    const int kind = (PH == PH_PROJ) ? K_PROJ : (PH == PH_MEMK) ? K_MEMK : (PH == PH_MEMV) ? K_MEMVT : (PH == PH_WOUT ? K_WOUT : PH == PH_WCQ ? K_WCQ : PH == PH_WCO ? K_WCO : PH == PH_UP ? K_UP : K_DOWN);
    switch (kind) {
    case K_PROJ: {
        const int hd = 4 * u.pn + wc;
        bf16_t* PJ = (bf16_t*)(ws + WS_RB) + ((size_t)u.pm * 256 + rbase) * PJW + 64 * (hd < 12 ? hd - 8 : hd - 16) + 8 * fq;
        const int cmh = (hd < 8) ? hd : hd - 4;
        unsigned char* QU = ws + WS_RD + ((size_t)(u.pm * 8 + (rbase >> 5)) * 128 + 8 * cmh + fq) * 512 + (rbase & 31) * 16;
        const float* R0 = (const float*)(ws + WS_RSTD0) + (size_t)u.pm * 256 + rbase;
        float r0v[2][4];
#pragma unroll
        for (int ai = 0; ai < 2; ++ai)
#pragma unroll
            for (int m = 0; m < 4; ++m) r0v[ai][m] = R0[ai * 128 + m * 16];
        if (hd < 10) {
            const float* gp = (hd < 8) ? E.in[I_Q_NORM] : E.in[I_K_NORM]; const float sc = (hd < 8) ? 0.125f * 1.4426950408889634f : 1.0f;
#pragma unroll
            for (int ai = 0; ai < 2; ++ai)
#pragma unroll
                for (int m = 0; m < 4; ++m) {
                    const float r0 = r0v[ai][m];
                    const float ss = quad_sum(sumsq16(acc[ai][0][m][0], acc[ai][0][m][1], acc[ai][1][m][0], acc[ai][1][m][1])) * (r0 * r0);
                    const float rstd = sc * r0 / sqrtf(ss * (1.0f / 64.0f) + EPS);
#pragma unroll
                    for (int bj = 0; bj < 2; ++bj) {
                        const f32x4 g0 = *(const f32x4*)(gp + 32 * bj + 8 * fq), g1 = *(const f32x4*)(gp + 32 * bj + 8 * fq + 4);
                        if (hd < 8) store_bf16x8((bf16_t*)(QU + (size_t)((ai * 4 + (m >> 1)) * 128 + 4 * bj) * 512 + (m & 1) * 256), acc[ai][bj][m][0] * rstd * g0, acc[ai][bj][m][1] * rstd * g1);
                        else store_bf16x8(PJ + (size_t)(ai * 128 + m * 16) * PJW + 32 * bj, acc[ai][bj][m][0] * rstd * g0, acc[ai][bj][m][1] * rstd * g1);
                    }
                    asm volatile("" ::: "memory");
                }
        } else if (hd < 12) {
#pragma unroll
            for (int ai = 0; ai < 2; ++ai)
#pragma unroll
                for (int m = 0; m < 4; ++m) {
                    const float r0 = r0v[ai][m];
#pragma unroll
                    for (int bj = 0; bj < 2; ++bj) store_bf16x8(PJ + (size_t)(ai * 128 + m * 16) * PJW + 32 * bj, acc[ai][bj][m][0] * r0, acc[ai][bj][m][1] * r0);
                }
        } else {
#pragma unroll
            for (int ai = 0; ai < 2; ++ai)
#pragma unroll
                for (int m = 0; m < 4; ++m) {
                    const float r0 = r0v[ai][m];
#pragma unroll
                    for (int bj = 0; bj < 2; ++bj) {
                        f32x4 v0 = acc[ai][bj][m][0] * r0, v1 = acc[ai][bj][m][1] * r0;
#pragma unroll
                        for (int e = 0; e < 4; ++e) { v0[e] = gelu_tanh(v0[e]); v1[e] = gelu_tanh(v1[e]); }
                        if (hd < 20) store_bf16x8((bf16_t*)(QU + (size_t)((ai * 4 + (m >> 1)) * 128 + 4 * bj) * 512 + (m & 1) * 256), v0, v1);
                        else store_bf16x8(PJ + (size_t)(ai * 128 + m * 16) * PJW + 32 * bj, v0, v1);
                    }
                    asm volatile("" ::: "memory");
                }
        }
        break; }
    case K_MEMK: {
        bf16_t* KM = (bf16_t*)(ws + WS_KMEM); float* SK = (float*)(ws + WS_SSQK);
        f32x4 g[2][2];
#pragma unroll
        for (int bj = 0; bj < 2; ++bj)
#pragma unroll
            for (int n = 0; n < 2; ++n) g[bj][n] = *(const f32x4*)(E.in[I_CK_NORM] + cb + 32 * bj + 4 * n);
#pragma unroll
        for (int ai = 0; ai < 2; ++ai)
#pragma unroll
            for (int m = 0; m < 4; ++m) {
                const size_t grow = (size_t)u.pm * 256 + ai * 128 + m * 16 + rbase;
                const float ss = quad_sum(sumsq16(acc[ai][0][m][0], acc[ai][0][m][1], acc[ai][1][m][0], acc[ai][1][m][1]));
                if (fq == 0) SK[(grow * 4 + u.pn) * 4 + wc] = ss;
#pragma unroll
                for (int bj = 0; bj < 2; ++bj) store_bf16x8(KM + grow * D + u.pn * 256 + cb + 32 * bj, acc[ai][bj][m][0] * g[bj][0], acc[ai][bj][m][1] * g[bj][1]);
            }
        break; }
    case K_MEMVT: {
        bf16_t* VT = (bf16_t*)(ws + WS_VMT);
#pragma unroll
        for (int ai = 0; ai < 2; ++ai)
#pragma unroll
            for (int m = 0; m < 4; ++m) {
                const size_t grow = (size_t)u.pm * 256 + ai * 128 + m * 16 + rbase;
#pragma unroll
                for (int bj = 0; bj < 2; ++bj) store_bf16x8(VT + grow * D + u.pn * 256 + cb + 32 * bj, acc[ai][bj][m][0], acc[ai][bj][m][1]);
            }
        break; }
    case K_WOUT: {
        const size_t off0 = ((size_t)u.pm * 256 + rbase) * D + u.pn * 256 + cb;
        bf16_t* XB = (bf16_t*)(ws + WS_RA) + off0; float* SP = (float*)(ws + WS_SSQ1P) + ((size_t)u.pm * 256 + rbase) * 16 + u.pn * 4 + wc;
#pragma unroll
        for (int ai = 0; ai < 2; ++ai) {
            u32x4 rv[4][2];
#pragma unroll
            for (int m = 0; m < 4; ++m)
#pragma unroll
                for (int bj = 0; bj < 2; ++bj) rv[m][bj] = (resl && !(ai == 1 && wc == 3)) ? *(const LAS u32x4*)(lds + RSLOT(ai * 4 + wc) + lds_byte(wr * 64 + m * 16 + fr, 32 * bj + 8 * fq)) : __builtin_nontemporal_load((const GAS u32x4*)(XB + (size_t)(ai * 128 + m * 16) * D + 32 * bj));
            asm volatile("" ::: "memory");
#pragma unroll
            for (int m = 0; m < 4; ++m) {
                const size_t ro = (size_t)(ai * 128 + m * 16) * D;
                f32x4 v[2][2];
#pragma unroll
                for (int bj = 0; bj < 2; ++bj) {
                    const u32x4 r = rv[m][bj];
                    f32x4 v0 = acc[ai][bj][m][0], v1 = acc[ai][bj][m][1];
                    v0[0] += bflo(r.x); v0[1] += bfhi(r.x); v0[2] += bflo(r.y); v0[3] += bfhi(r.y);
                    v1[0] += bflo(r.z); v1[1] += bfhi(r.z); v1[2] += bflo(r.w); v1[3] += bfhi(r.w);
                    v[bj][0] = v0; v[bj][1] = v1;
                    store_bf16x8(XB + ro + 32 * bj, v0, v1);
                }
                const float ss = quad_sum(sumsq16(v[0][0], v[0][1], v[1][0], v[1][1])); if (fq == 0) SP[(size_t)(ai * 128 + m * 16) * 16] = ss;
            }
            asm volatile("" ::: "memory");
        }
        break; }
    case K_WCO: {
        const size_t off0 = ((size_t)u.pm * 256 + rbase) * D + u.pn * 256 + cb;
        const bf16_t* X1 = (const bf16_t*)(ws + WS_RA) + off0;
        bf16_t* XB = (bf16_t*)(ws + WS_RC) + off0;
#pragma unroll
        for (int ai = 0; ai < 2; ++ai) {
            u32x4 rv[4][2];
#pragma unroll
            for (int m = 0; m < 4; ++m)
#pragma unroll
                for (int bj = 0; bj < 2; ++bj) rv[m][bj] = (resl && !(ai == 1 && wc == 3)) ? *(const LAS u32x4*)(lds + RSLOT(ai * 4 + wc) + lds_byte(wr * 64 + m * 16 + fr, 32 * bj + 8 * fq)) : __builtin_nontemporal_load((const GAS u32x4*)(X1 + (size_t)(ai * 128 + m * 16) * D + 32 * bj));
            asm volatile("" ::: "memory");
#pragma unroll
            for (int m = 0; m < 4; ++m) {
                const size_t ro = (size_t)(ai * 128 + m * 16) * D;
#pragma unroll
                for (int bj = 0; bj < 2; ++bj) {
                    const u32x4 r = rv[m][bj];
                    f32x4 v0 = acc[ai][bj][m][0], v1 = acc[ai][bj][m][1];
                    v0[0] += bflo(r.x); v0[1] += bfhi(r.x); v0[2] += bflo(r.y); v0[3] += bfhi(r.y);
                    v1[0] += bflo(r.z); v1[1] += bfhi(r.z); v1[2] += bflo(r.w); v1[3] += bfhi(r.w);
                    store_bf16x8(XB + ro + 32 * bj, v0, v1);
                }
            }
            asm volatile("" ::: "memory");
        }
        break; }
    case K_WCQ: {
        bf16_t* QC = (bf16_t*)(ws + WS_RB); const float* SP = (const float*)(ws + WS_SSQ1P); float* SQ = (float*)(ws + WS_SSQQ);
        f32x4 g[2][2];
#pragma unroll
        for (int bj = 0; bj < 2; ++bj)
#pragma unroll
            for (int n = 0; n < 2; ++n) g[bj][n] = *(const f32x4*)(E.in[I_CQ_NORM] + cb + 32 * bj + 4 * n);
#pragma unroll
        for (int ai = 0; ai < 2; ++ai)
#pragma unroll
            for (int m = 0; m < 4; ++m) {
                const size_t grow = (size_t)u.pm * 256 + ai * 128 + m * 16 + rbase;
                const f32x4 p = *(const f32x4*)(SP + grow * 16 + 4 * fq);
                const float tot = quad_sum((p[0] + p[1]) + (p[2] + p[3]));
                const float rstd1 = 1.0f / sqrtf(tot * (1.0f / D) + EPS);
                f32x4 v[2][2];
#pragma unroll
                for (int bj = 0; bj < 2; ++bj)
#pragma unroll
                    for (int n = 0; n < 2; ++n) v[bj][n] = acc[ai][bj][m][n] * rstd1;
                const float ss = quad_sum(sumsq16(v[0][0], v[0][1], v[1][0], v[1][1]));
                if (fq == 0) SQ[(grow * 4 + u.pn) * 4 + wc] = ss;
#pragma unroll
                for (int bj = 0; bj < 2; ++bj) store_bf16x8(QC + grow * D + u.pn * 256 + cb + 32 * bj, v[bj][0] * g[bj][0], v[bj][1] * g[bj][1]);
            }
        break; }
    case K_UP: {
        unsigned char* HID = ws + WS_RD;
#pragma unroll
        for (int ai = (HV ? HV - 1 : 0); ai < (HV ? HV : 2); ++ai)
#pragma unroll
            for (int m = 0; m < 4; ++m) {
                PIN_ROW(ai, m);
                const int lrow = ai * 128 + m * 16 + rbase;
                const float rs = epre[ai * 4 + m];
                f32x4 hv[2];
#pragma unroll
                for (int n = 0; n < 2; ++n)
#pragma unroll
                    for (int e = 0; e < 4; ++e) hv[n][e] = silu(acc[ai][0][m][n][e] * rs) * (acc[ai][1][m][n][e] * rs);
                { u32x2 w8; w8.x = pk4_fp8(hv[0][0], hv[0][1], hv[0][2], hv[0][3]); w8.y = pk4_fp8(hv[1][0], hv[1][1], hv[1][2], hv[1][3]);
                  *(GAS u32x2*)(HID + ((size_t)u.pm * 256 + lrow) * 512 + u.pn * 128 + 32 * wc + 8 * fq) = w8; }
                asm volatile("" ::: "memory");
            }
        break; }
    case K_DOWN: {
        const int* LT = (const int*)(ws + WS_LTOK) + u.aux; const float* LG = (const float*)(ws + WS_LGATE) + u.aux;
        bf16_t* CB0 = (bf16_t*)(ws + WS_RB) + u.pn * 256 + cb; bf16_t* CB1 = (bf16_t*)(ws + WS_RA) + u.pn * 256 + cb;
        int tk[2][4]; float gt[2][4];
#pragma unroll
        for (int ai = (HV ? HV - 1 : 0); ai < (HV ? HV : 2); ++ai)
#pragma unroll
            for (int m = 0; m < 4; ++m) { const int lrow = ai * 128 + m * 16 + rbase; const bool ok = (lrow < u.gcnt); tk[ai][m] = ok ? LT[lrow] : -1; gt[ai][m] = ok ? LG[lrow] * 0.03125f : 0.f; }
#pragma unroll
        for (int ai = (HV ? HV - 1 : 0); ai < (HV ? HV : 2); ++ai)
#pragma unroll
            for (int m = 0; m < 4; ++m) {
                if (tk[ai][m] >= 0) {
                    bf16_t* o = ((tk[ai][m] & 1) ? CB1 : CB0) + (size_t)(tk[ai][m] >> 1) * D; const float g = gt[ai][m];
#pragma unroll
                    for (int bj = 0; bj < 2; ++bj) store_bf16x8(o + 32 * bj, acc[ai][bj][m][0] * g, acc[ai][bj][m][1] * g);
                }
            }
        break; }
    }
}

template <int PH> struct Stagger { static constexpr int ways = 1; static constexpr unsigned ticks = 0; };
#ifndef STG_WOUT
#define STG_WOUT 0
#endif
#ifndef STG_WCO
#define STG_WCO 0
#endif
#ifndef STG_DOWN
#define STG_DOWN 0
#endif
template <> struct Stagger<PH_WOUT> { static constexpr int ways = 2; static constexpr unsigned ticks = STG_WOUT; };
template <> struct Stagger<PH_WCO> { static constexpr int ways = 2; static constexpr unsigned ticks = STG_WCO; };
template <> struct Stagger<PH_DOWN0> { static constexpr int ways = 4; static constexpr unsigned ticks = STG_DOWN; };
template <int PH, int HV = 0> DI void gemm_phase(LAS unsigned char* lds, const Sched& S, const EpiCtx& E) {
    if constexpr (Stagger<PH>::ways > 1 && Stagger<PH>::ticks > 0) {
        const unsigned way = ((unsigned)S.c >> 3) % Stagger<PH>::ways;
        if (way) { const unsigned long long t0 = __builtin_amdgcn_s_memrealtime(), dl = (unsigned long long)way * Stagger<PH>::ticks;
            while (__builtin_amdgcn_s_memrealtime() - t0 < dl) __builtin_amdgcn_s_sleep(8); }
    }
    typedef PCfg<(PH == PH_DOWN1 ? PH_DOWN0 : PH)> g;
    constexpr bool GATHER = (PH == PH_UP);
    constexpr bool F8 = (PH == PH_UP || PH == PH_DOWN0);
    constexpr bool CMA = (PH == PH_WOUT || PH == PH_WCO);
    constexpr bool RESL = (PH == PH_WOUT || PH == PH_WCO);
    constexpr bool HALVES = (PH == PH_UP || PH == PH_DOWN0);
    int tid = threadIdx.x; asm volatile("" : "+v"(tid));
    const int wid = __builtin_amdgcn_readfirstlane(tid >> 6), lane = tid & 63, wr = wid >> 2, wc = wid & 3, fr = lane & 15, fq = lane >> 4;
    constexpr int nt = g::K / BK;
    int R0, C0; stage_rc(tid * 16, R0, C0);
    unsigned vB[2], vA0[2], vR[2];
#pragma unroll
    for (int i = 0; i < 2; ++i) { const int R = R0 + 64 * i; vB[i] = (unsigned)(g::RS * (R >> 5) + perm32(R & 31)) * g::ldb2 + (unsigned)C0 * 2u; vR[i] = (unsigned)R * 2048u + (unsigned)C0 * 2u; vA0[i] = CMA ? (unsigned)(((R >> 5) * 128 + (C0 >> 3)) * 512 + (R & 31) * 16) : (unsigned)R * g::lda2 + (unsigned)C0 * 2u; }
    const unsigned ldsw = (unsigned)wid * 1024u;
    const int aoff = lds_byte(wr * 64 + fr, fq * 8), boff = lds_byte(wc * 32 + fr, fq * 8);
    constexpr size_t hA = (size_t)HALF * g::lda2;
#define SA(b, h) (((b) * 2 + (h)) * HTB)
#define SB(b, h) ((4 + (b) * 2 + (h)) * HTB)
#define GLDS(gp, loff) __builtin_amdgcn_global_load_lds((const unsigned*)(gp), (LAS unsigned*)(lds + (loff)), 16, 0, 0)
#define STG_A(bufoff, base, h, useN) do { if constexpr (GATHER) { \
        GLDS((base) + vAc[h][0], (bufoff) + ldsw); GLDS((base) + vAc[h][1], (bufoff) + ldsw + 8192); } else { \
        GLDS((base) + (h) * hA + vA0[0], (bufoff) + ldsw); GLDS((base) + (h) * hA + vA0[1], (bufoff) + ldsw + 8192); } } while (0)
#define STG_B(bufoff, base) do { GLDS((base) + vB[0], (bufoff) + ldsw); GLDS((base) + vB[1], (bufoff) + ldsw + 8192); } while (0)
#define STG_BR(bufoff, base, piece) do { if constexpr (RESL) { const char* bb_ = resm ? resb + ((piece) >> 2) * (128 * 2048) + ((piece) & 3) * 128 : (const char*)(base); \
        GLDS(bb_ + (resm ? vR[0] : vB[0]), (bufoff) + ldsw); GLDS(bb_ + (resm ? vR[1] : vB[1]), (bufoff) + ldsw + 8192); } else { STG_B(bufoff, base); } } while (0)
#define STG_AR(bufoff, base, h, useN, piece) do { if constexpr (RESL) { const char* bb_ = resm ? resb + ((piece) >> 2) * (128 * 2048) + ((piece) & 3) * 128 : (const char*)(base) + (h) * hA; \
        GLDS(bb_ + (resm ? vR[0] : vA0[0]), (bufoff) + ldsw); GLDS(bb_ + (resm ? vR[1] : vA0[1]), (bufoff) + ldsw + 8192); } else { STG_A(bufoff, base, h, useN); } } while (0)
#define LDA(dst, b, h) do { _Pragma("unroll") for (int m = 0; m < 4; ++m) _Pragma("unroll") for (int k = 0; k < 2; ++k) dst[m][k] = *(const LAS bf16x8*)(lds + SA(b, h) + aoff + m * 2048 + k * 1024); } while (0)
#define LDB(dst, b, h) do { _Pragma("unroll") for (int n = 0; n < 2; ++n) _Pragma("unroll") for (int k = 0; k < 2; ++k) dst[n][k] = *(const LAS bf16x8*)(lds + SB(b, h) + boff + n * 2048 + k * 1024); } while (0)
#define MMA(ai, bj, At, Bt) do { __builtin_amdgcn_s_setprio(1); _Pragma("unroll") for (int m = 0; m < 4; ++m) _Pragma("unroll") for (int n = 0; n < 2; ++n) { if constexpr (F8) { \
        asm volatile("v_mfma_f32_16x16x128_f8f6f4 %0, %1, %2, %0" : "+v"(acc[ai][bj][m][n]) : "v"(cat32(Bt[n][0], Bt[n][1])), "v"(cat32(At[m][0], At[m][1]))); } else { _Pragma("unroll") for (int k = 0; k < 2; ++k) \
        acc[ai][bj][m][n] = __builtin_amdgcn_mfma_f32_16x16x32_bf16(Bt[n][k], At[m][k], acc[ai][bj][m][n], 0, 0, 0); } } __builtin_amdgcn_s_setprio(0); } while (0)
#define WAIT_V(n) asm volatile("s_waitcnt vmcnt(" #n ")" ::: "memory")
#define WAIT_L(n) asm volatile("s_waitcnt lgkmcnt(" #n ")" ::: "memory")
#define BAR __builtin_amdgcn_s_barrier()
#define SCHED __builtin_amdgcn_sched_barrier(0)
#define LOAD_IDX(ii, U) do { _Pragma("unroll") for (int h = 0; h < 2; ++h) _Pragma("unroll") for (int i = 0; i < 2; ++i) { const int r_ = 128 * h + R0 + 64 * i; \
        (ii)[h][i] = (r_ < (U).gcnt) ? ((U).gl[r_] >> 1) : 0; } } while (0)
#define IDX_TO_VA(vv, ii) do { _Pragma("unroll") for (int h = 0; h < 2; ++h) _Pragma("unroll") for (int i = 0; i < 2; ++i) (vv)[h][i] = (unsigned)(ii)[h][i] * g::lda2 + (unsigned)C0 * 2u; } while (0)
    GUnit cur, nxt; int ui = 0;
    if (!sched_next<PH, HV>(S, 0, cur)) return;
    f32x4 acc[2][2][4][2];
#pragma unroll
    for (int a = 0; a < 2; ++a)
#pragma unroll
        for (int b = 0; b < 2; ++b)
#pragma unroll
            for (int m = 0; m < 4; ++m)
#pragma unroll
                for (int n = 0; n < 2; ++n) acc[a][b][m][n] = (f32x4){0.f, 0.f, 0.f, 0.f};
    bf16x8 At[4][2], B0[2][2], B1[2][2];
    unsigned vAc[2][2]; int idxn[2][2]; float epre[8];
    if constexpr (GATHER) { LOAD_IDX(idxn, cur); IDX_TO_VA(vAc, idxn); }
    const char* cA = cur.A; const char* cB = cur.B;
    constexpr size_t kstep = BK * 2; constexpr size_t hB = g::hstepB;
    constexpr size_t kstepA = CMA ? 8 * 512 : BK * 2;
    STG_B(SB(0, 0), cB); STG_B(SB(0, 1), cB + hB); STG_A(SA(0, 0), cA, 0, false); STG_A(SA(0, 1), cA, 1, false);
    if (wr == 1) BAR;
    WAIT_V(2); BAR;
    STG_B(SB(1, 0), cB + kstep); STG_A(SA(1, 0), cA + kstepA, 0, false); STG_B(SB(1, 1), cB + hB + kstep);
    WAIT_V(6); BAR;
    for (;;) {
        const bool has_next = sched_next<PH, HV>(S, ui + 1, nxt);
        const char* nA = has_next ? nxt.A : cA; const char* nB = has_next ? nxt.B : cB;
#pragma unroll 1
        for (int t = 0; t < nt; t += 2) {
            const bool last = (t == nt - 2);
            asm volatile("" : "+v"(vB[0]), "+v"(vB[1]), "+v"(vA0[0]), "+v"(vA0[1]));
            if constexpr (RESL) asm volatile("" : "+v"(vR[0]), "+v"(vR[1]));
            if constexpr (GATHER) asm volatile("" : "+v"(vAc[0][0]), "+v"(vAc[0][1]), "+v"(vAc[1][0]), "+v"(vAc[1][1]));
            if constexpr (GATHER) { if (last) { if (has_next) { LOAD_IDX(idxn, nxt); }
                const float* LR_ = (const float*)(E.ws + WS_LRSTD) + cur.aux;
#pragma unroll
                for (int ai = 0; ai < 2; ++ai)
#pragma unroll
                    for (int m = 0; m < 4; ++m) { const int lr_ = ai * 128 + m * 16 + wr * 64 + fr; epre[ai * 4 + m] = (lr_ < cur.gcnt) ? LR_[lr_] * 0.03125f : 0.f; } } }
            const bool resm = RESL && last && !has_next;
            const char* resb = (const char*)(E.ws + WS_RA) + ((size_t)cur.pm * 256 * D + cur.pn * 256) * 2;
            const char* a1 = cA + (size_t)(t + 1) * kstepA;
            const char* a2 = last ? nA : cA + (size_t)(t + 2) * kstepA; const char* b2 = last ? nB : cB + (size_t)(t + 2) * kstep;
            const char* a3 = a2 + kstepA; const char* b3 = b2 + kstep;
            LDB(B0, 0, 0); LDB(B1, 0, 1); SCHED; if constexpr (HV != 2) LDA(At, 0, 0); STG_A(SA(1, 1), a1, 1, false);
            WAIT_V(8); WAIT_L(0); BAR; if constexpr (HV != 2) { MMA(0, 0, At, B0); MMA(0, 1, At, B1); } BAR; SCHED;
            if constexpr (GATHER) { if (last) { asm volatile("" : "+v"(epre[0]), "+v"(epre[1]), "+v"(epre[2]), "+v"(epre[3]), "+v"(epre[4]), "+v"(epre[5]), "+v"(epre[6]), "+v"(epre[7])); if (has_next) { IDX_TO_VA(vAc, idxn); } } }
            if constexpr (HV != 1) LDA(At, 0, 1); STG_BR(SB(0, 0), b2, 0); STG_BR(SB(0, 1), b2 + hB, 1); STG_AR(SA(0, 0), a2, 0, last, 2);
            WAIT_V(8); WAIT_L(0); BAR; if constexpr (HV != 1) { MMA(1, 0, At, B0); MMA(1, 1, At, B1); } BAR; SCHED;
            LDB(B0, 1, 0); LDB(B1, 1, 1); SCHED; if constexpr (HV != 2) LDA(At, 1, 0); STG_AR(SA(0, 1), a2, 1, last, 3);
            WAIT_V(8); WAIT_L(0); BAR; if constexpr (HV != 2) { MMA(0, 0, At, B0); MMA(0, 1, At, B1); } BAR; SCHED;
            if constexpr (HV != 1) LDA(At, 1, 1); STG_BR(SB(1, 0), b3, 4); STG_BR(SB(1, 1), b3 + hB, 5); STG_AR(SA(1, 0), a3, 0, last, 6);
            WAIT_V(8); WAIT_L(0); BAR; if constexpr (HV != 1) { MMA(1, 0, At, B0); MMA(1, 1, At, B1); } BAR; SCHED;
        }
        if constexpr (F8) asm volatile("s_nop 15\n\ts_nop 15" ::: "memory");
        if (wr == 0) BAR;
        if constexpr (RESL) { if (!has_next) { WAIT_V(0); BAR; } }
        epilogue<PH, HV>(E, cur, acc, wr, wc, fr, fq, epre, lds, RESL && !has_next);
        if (!has_next) break;
#pragma unroll
        for (int a = 0; a < 2; ++a)
#pragma unroll
            for (int b = 0; b < 2; ++b)
#pragma unroll
                for (int m = 0; m < 4; ++m)
#pragma unroll
                    for (int n = 0; n < 2; ++n) acc[a][b][m][n] = (f32x4){0.f, 0.f, 0.f, 0.f};
        cur = nxt; cA = nA; cB = nB; ++ui;
        if (wr == 1) BAR;
    }
    WAIT_V(0);
    BAR;
#undef SA
#undef SB
#undef GLDS
#undef STG_A
#undef STG_B
#undef STG_BR
#undef STG_AR
#undef LDA
#undef LDB
#undef MMA
#undef WAIT_V
#undef WAIT_L
#undef BAR
#undef SCHED
#undef LOAD_IDX
#undef IDX_TO_VA
}

DI int crow(int r, int hi) { return (r & 3) + 8 * (r >> 2) + 4 * hi; }
typedef short v4i16_t __attribute__((ext_vector_type(4)));
DI s16x4 vtr(const LAS unsigned char* p) { return __builtin_bit_cast(s16x4, __builtin_amdgcn_ds_read_tr16_b64_v4i16((LAS v4i16_t*)p)); }
#define MFMA32(a, b, c) __builtin_amdgcn_mfma_f32_32x32x16_bf16((a), (b), (c), 0, 0, 0)
DI bf16x8 cat8(s16x4 lo, s16x4 hi) { return __builtin_shufflevector(lo, hi, 0, 1, 2, 3, 4, 5, 6, 7); }
DI bf16x8 pack8(float a0, float a1, float a2, float a3, float a4, float a5, float a6, float a7) {
    u32x4 w; w.x = pk2(a0, a1); w.y = pk2(a2, a3); w.z = pk2(a4, a5); w.w = pk2(a6, a7); return __builtin_bit_cast(bf16x8, w);
}
DI void norm_store_unit(Frame& F, f32x16 (&ov)[4][2], int ql, int hh, unsigned char* dst0  ) {
    LAS float* xch = (LAS float*)(F.lds + SGP_OFF);
    __syncthreads();
#pragma unroll
    for (int blk = 0; blk < 4; ++blk) {
        float ss = 0.f;
#pragma unroll
        for (int d = 0; d < 2; ++d)
#pragma unroll
            for (int r = 0; r < 16; ++r) ss += ov[blk][d][r] * ov[blk][d][r];
        ss += __shfl_xor(ss, 32);
        if (hh == 0) xch[F.wave * 128 + 32 * blk + ql] = ss;
    }
    __syncthreads();
#pragma unroll
    for (int blk = 0; blk < 4; ++blk) {
        float tot = 0.f;
#pragma unroll
        for (int w = 0; w < 8; ++w) tot += xch[w * 128 + 32 * blk + ql];
        const float rstd = 1.0f / sqrtf(tot * (1.0f / 512.0f) + EPS);
#pragma unroll
        for (int d = 0; d < 2; ++d)
#pragma unroll
            for (int g = 0; g < 4; ++g) {
                u32x2 w; w.x = pk2(ov[blk][d][4 * g] * rstd, ov[blk][d][4 * g + 1] * rstd); w.y = pk2(ov[blk][d][4 * g + 2] * rstd, ov[blk][d][4 * g + 3] * rstd);
                *(GAS u32x2*)(dst0 + (size_t)blk * 128 * 512 + (size_t)(4 * d + g) * 512) = w;
            }
    }
}
DI void norm_store_512(Frame& F, f32x16 (&o)[2], int par, int ql, int hh, unsigned char* dst  ) {
    LAS float* xch = (LAS float*)(F.lds + XCH_OFF) + par * 256;
    float ss = 0.f;
#pragma unroll
    for (int d = 0; d < 2; ++d)
#pragma unroll
        for (int r = 0; r < 16; ++r) ss += o[d][r] * o[d][r];
    ss += __shfl_xor(ss, 32);
    if (hh == 0) xch[F.wave * 32 + ql] = ss;
    __syncthreads();
    float tot = 0.f;
#pragma unroll
    for (int w = 0; w < 8; ++w) tot += xch[w * 32 + ql];
    const float rstd = 1.0f / sqrtf(tot * (1.0f / 512.0f) + EPS);
#pragma unroll
    for (int d = 0; d < 2; ++d)
#pragma unroll
        for (int g = 0; g < 4; ++g) {
            u32x2 w; w.x = pk2(o[d][4 * g] * rstd, o[d][4 * g + 1] * rstd); w.y = pk2(o[d][4 * g + 2] * rstd, o[d][4 * g + 3] * rstd);
            *(GAS u32x2*)(dst + (size_t)(4 * d + g) * 512) = w;
        }
}

#if defined(TS_PHASE) && TS_PHASE >= 20
#define MSTAMP(k) do { __syncthreads(); if (F.tid == 0) ((volatile LAS unsigned long long*)(F.lds + MISC_OFF + 64))[k] = __builtin_amdgcn_s_memrealtime(); } while (0)
#else
#define MSTAMP(k) do { } while (0)
#endif
DI void attn_unit(Frame& F, int b, int n) {
    if (F.wave >= 4) __builtin_amdgcn_s_setprio(1);
    int tid = F.tid; asm volatile("" : "+v"(tid));
    const int lane = tid & 63, ql = lane & 31, hh = lane >> 5;
    const int t0 = b * SEQ + n * 128;
    const bf16_t* PJ = (const bf16_t*)(F.ws + WS_RB);
    bf16_t* MX = (bf16_t*)(F.ws + WS_RC);
    LAS unsigned char* lds = F.lds;
    const int h = F.wave, kvh = h >> 2;
    bf16x8 qfa[4][4];
#pragma unroll
    for (int i = 0; i < 4; ++i) { const unsigned char* qp = F.ws + WS_RD + ((size_t)((t0 >> 5) + i) * 128 + 8 * h + hh) * 512 + ql * 16;
#pragma unroll
        for (int ks = 0; ks < 4; ++ks) qfa[i][ks] = __builtin_nontemporal_load((const GAS bf16x8*)(qp + (size_t)(2 * ks) * 512)); }
    __syncthreads();
#pragma unroll 8
    for (int j = 0; j < 16; ++j) {
        const int p = tid + NTHR * j, row = p >> 5, c = p & 31;
        int tok = t0 - 128 + row; if (n == 0 && row < 128) tok = t0;
        const u32x4 v = *(const GAS u32x4*)(PJ + (size_t)tok * PJW + 8 * c);
        int addr;
        if (c < 16) { const int kvh = c >> 3, ch = c & 7; addr = kvh * 32768 + row * 128 + ((ch ^ ((row >> 1) & 7)) << 4); }
        else { const int cc = c - 16, kvh = cc >> 3, ch = cc & 7; addr = 65536 + kvh * 32768 + (ch >> 2) * 16384 + row * 64 + (ch & 3) * 16; }
        *(LAS u32x4*)(lds + addr) = v;
    }
    __syncthreads();
    const float sinkv = F.in[I_SINKS][h] * 1.4426950408889634f;
    const LAS unsigned char* Kb = lds + kvh * 32768;
    const LAS unsigned char* Vb = lds + 65536 + kvh * 32768;
    const int vtr_off = ((lane & 15) >> 2) * 64 + (16 * ((lane >> 4) & 1) + 4 * (lane & 3)) * 2;
#pragma unroll
    for (int i = 0; i < 4; ++i) {
        const bf16x8* qf = qfa[i];
        f32x16 s[5];
#pragma unroll
        for (int jt = 0; jt < 5; ++jt) {
            const int key = 32 * (i + jt) + ql;
            f32x16 a = {};
#pragma unroll
            for (int ks = 0; ks < 4; ++ks) {
                const bf16x8 kf = *(const LAS bf16x8*)(Kb + key * 128 + (((2 * ks + hh) ^ ((key >> 1) & 7)) << 4));
                a = MFMA32(kf, qf[ks], a);
            }
            s[jt] = a;
        }
        float m = sinkv;
#pragma unroll
        for (int jt = 0; jt < 5; ++jt) {
            const bool tile_ok = (n != 0) || (i + jt >= 4);
#pragma unroll
            for (int r = 0; r < 16; ++r) {
                const int c = crow(r, hh);
                bool ok = tile_ok;
                if (jt == 0) ok = ok && (c > ql);
                if (jt == 4) ok = ok && (c <= ql);
                const float v = ok ? s[jt][r] : -INFINITY;
                s[jt][r] = v; m = fmaxf(m, v);
            }
        }
        m = fmaxf(m, __shfl_xor(m, 32));
        float l = 0.f;
#pragma unroll
        for (int jt = 0; jt < 5; ++jt)
#pragma unroll
            for (int r = 0; r < 16; ++r) { const float p = __builtin_amdgcn_exp2f(s[jt][r] - m); s[jt][r] = p; l += p; }
        l += __shfl_xor(l, 32);
        l += __builtin_amdgcn_exp2f(sinkv - m);
        f32x16 o[2]; o[0] = f32x16{}; o[1] = f32x16{};
#pragma unroll
        for (int jt = 0; jt < 5; ++jt)
#pragma unroll
            for (int s2 = 0; s2 < 2; ++s2) {
                const bf16x8 pf = pack8(s[jt][8 * s2], s[jt][8 * s2 + 1], s[jt][8 * s2 + 2], s[jt][8 * s2 + 3], s[jt][8 * s2 + 4], s[jt][8 * s2 + 5], s[jt][8 * s2 + 6], s[jt][8 * s2 + 7]);
                const int k0 = 32 * (i + jt) + 16 * s2 + 4 * hh;
#pragma unroll
                for (int d = 0; d < 2; ++d) {
                    const LAS unsigned char* vp = Vb + d * 16384 + k0 * 64 + vtr_off;
                    const s16x4 lo = vtr(vp), hi = vtr(vp + 8 * 64);
                    o[d] = MFMA32(cat8(lo, hi), pf, o[d]);
                }
            }
        const float inv = 1.0f / l;
#pragma unroll
        for (int d = 0; d < 2; ++d)
#pragma unroll
            for (int r = 0; r < 16; ++r) o[d][r] *= inv;
        norm_store_512(F, o, i & 1, ql, hh, (unsigned char*)MX + ((size_t)((t0 >> 5) + i) * 128 + 8 * h) * 512 + ql * 16 + 8 * hh);
    }
    __builtin_amdgcn_s_setprio(0);
}

DI void sgu_unit(Frame& F, int b, int n) {
    int tid = F.tid; asm volatile("" : "+v"(tid));
    const int lane = tid & 63, ql = lane & 31, hh = lane >> 5, gi = F.wave;
    const int t0 = b * SEQ + n * 128;
    const bf16_t* PJ = (const bf16_t*)(F.ws + WS_RB);
    bf16_t* MX = (bf16_t*)(F.ws + WS_RC);
    LAS unsigned char* lds = F.lds;
    LAS float* sgp = (LAS float*)(lds + SGP_OFF);
    LAS float* sgr = (LAS float*)(lds + SGR_OFF);
    __syncthreads();
    MSTAMP(22);
    u32x4 gv[16];
    const int ch = lane & 7;
#pragma unroll
    for (int L = 0; L < 16; ++L) {
        const int tok = 8 * L + (lane >> 3);
        gv[L] = __builtin_nontemporal_load((const GAS u32x4*)(PJ + (size_t)(t0 + tok) * PJW + 256 + 64 * gi + 8 * ch));
    }
#pragma unroll
    for (int L = 0; L < 16; ++L) {
        const int tok = 8 * L + (lane >> 3);
        float ss = 0.f;
#pragma unroll
        for (int e = 0; e < 4; ++e) { const float a = bflo(gv[L][e]), c = bfhi(gv[L][e]); ss += a * a + c * c; }
        ss += __shfl_xor(ss, 1); ss += __shfl_xor(ss, 2); ss += __shfl_xor(ss, 4);
        if (ch == 0) sgp[gi * 128 + tok] = ss;
    }
    __syncthreads();
    if (tid < 128) { float tot = 0.f;
#pragma unroll
        for (int g = 0; g < 8; ++g) tot += sgp[g * 128 + tid];
        sgr[tid] = 1.0f / sqrtf(tot * (1.0f / 512.0f) + EPS); }
    __syncthreads();
    MSTAMP(23);
    float gn[8];
    { const f32x4 a = *(const f32x4*)(F.in[I_SGU_NORM] + 64 * gi + 8 * ch), c = *(const f32x4*)(F.in[I_SGU_NORM] + 64 * gi + 8 * ch + 4);
      gn[0] = a[0]; gn[1] = a[1]; gn[2] = a[2]; gn[3] = a[3]; gn[4] = c[0]; gn[5] = c[1]; gn[6] = c[2]; gn[7] = c[3]; }
    LAS unsigned char* vcb = lds + gi * 16384;
#pragma unroll
    for (int L = 0; L < 16; ++L) {
        const int tok = 8 * L + (lane >> 3);
        const float r = sgr[tok];
        u32x4 w;
#pragma unroll
        for (int e = 0; e < 4; ++e) w[e] = pk2(bflo(gv[L][e]) * r * gn[2 * e], bfhi(gv[L][e]) * r * gn[2 * e + 1]);
        *(LAS u32x4*)(vcb + (ch >> 2) * 8192 + tok * 64 + (ch & 3) * 16) = w;
    }
    LDS_WAIT();
    __syncthreads();
    MSTAMP(24);
    const bf16_t* Wg = (const bf16_t*)(F.ws + WS_WRT + 512 * 1024) + (size_t)gi * 128 * 128;
    const float* bias = F.in[I_SGU_B] + gi * 128;
    const int vtr_off = ((lane & 15) >> 2) * 64 + (16 * ((lane >> 4) & 1) + 4 * (lane & 3)) * 2;
    f32x16 ov[4][2];
#pragma unroll
    for (int ib = 0; ib < 4; ++ib) {
        const int it = 32 * ib + ql;
        f32x16 a[2]; a[0] = f32x16{}; a[1] = f32x16{};
        const float bi = bias[it];
        const unsigned char* up = F.ws + WS_RD + ((size_t)((t0 >> 5) + ib) * 128 + 64 + 8 * gi) * 512 + ql * 16 + 8 * hh;
        u32x2 uw[2][4];
#pragma unroll
        for (int d = 0; d < 2; ++d)
#pragma unroll
            for (int g = 0; g < 4; ++g) uw[d][g] = __builtin_nontemporal_load((const GAS u32x2*)(up + (size_t)(4 * d + g) * 512));
        bf16x8 wfr[8];
#pragma unroll
        for (int js = 0; js < 2 * (ib + 1); ++js) wfr[js] = *(const GAS bf16x8*)(Wg + (size_t)it * 128 + 16 * js + 8 * hh);
        s16x4 vlo[8][2], vhi[8][2];
#pragma unroll
        for (int js = 0; js < 2 * (ib + 1); ++js)
#pragma unroll
            for (int d = 0; d < 2; ++d) { const LAS unsigned char* vp = vcb + d * 8192 + (16 * js + 8 * hh) * 64 + vtr_off; vlo[js][d] = vtr(vp); vhi[js][d] = vtr(vp + 4 * 64); }
#pragma unroll
        for (int js = 0; js < 2 * (ib + 1); ++js)
#pragma unroll
            for (int d = 0; d < 2; ++d) a[d] = MFMA32(cat8(vlo[js][d], vhi[js][d]), wfr[js], a[d]);
#pragma unroll
        for (int d = 0; d < 2; ++d)
#pragma unroll
            for (int g = 0; g < 4; ++g) {
                const u32x2 uu = uw[d][g];
                a[d][4 * g] = bflo(uu.x) * (a[d][4 * g] + bi); a[d][4 * g + 1] = bfhi(uu.x) * (a[d][4 * g + 1] + bi);
                a[d][4 * g + 2] = bflo(uu.y) * (a[d][4 * g + 2] + bi); a[d][4 * g + 3] = bfhi(uu.y) * (a[d][4 * g + 3] + bi);
            }
        ov[ib][0] = a[0]; ov[ib][1] = a[1];
        asm volatile("" ::: "memory");
    }
    MSTAMP(25);
    norm_store_unit(F, ov, ql, hh, (unsigned char*)MX + ((size_t)(t0 >> 5) * 128 + 64 + 8 * gi) * 512 + ql * 16 + 8 * hh);
    MSTAMP(26);
}

DI void mix_phase(Frame& F) {
    { const int i = F.bid * NTHR + F.tid;
      if (i < NMEM * 4 * 8) { const int piece = i & 7, kh = i >> 3, key = kh >> 2, h = kh & 3;
          const f32x4 p = *(const f32x4*)((const float*)(F.ws + WS_SSQK) + (size_t)kh * 4);
          const float r = 1.0f / sqrtf(((p[0] + p[1]) + (p[2] + p[3])) * (1.0f / 256.0f) + EPS);
          GAS u32x4* kp = (GAS u32x4*)((bf16_t*)(F.ws + WS_KMEM) + (size_t)key * D + h * 256 + piece * 32);
#pragma unroll
          for (int q = 0; q < 4; ++q) { u32x4 v = kp[q];
#pragma unroll
              for (int e = 0; e < 4; ++e) v[e] = pk2(bflo(v[e]) * r, bfhi(v[e]) * r);
              kp[q] = v; } } }
    MSTAMP(20);
    for (int uidx = F.bid; uidx < 256; uidx += F.G) attn_unit(F, uidx >> 5, uidx & 31);
    MSTAMP(21);
    for (int uidx = F.bid; uidx < 256; uidx += F.G) sgu_unit(F, uidx >> 5, uidx & 31);
    MSTAMP(27);
}

DI void xattn_unit(Frame& F, int pm, int pn) {
    if (F.wave >= 4) __builtin_amdgcn_s_setprio(1);
    int tid = F.tid; asm volatile("" : "+v"(tid));
    const int lane = tid & 63, ql = lane & 31, hh = lane >> 5, w = F.wave;
    const int b = pm >> 4, h = pn;
    const size_t row = (size_t)pm * 256 + 32 * w + ql;
    LAS unsigned char* lds = F.lds;
    const bf16_t* QC = (const bf16_t*)(F.ws + WS_RB);
    bf16x8 qf[16];
#pragma unroll
    for (int ks = 0; ks < 16; ++ks) qf[ks] = __builtin_nontemporal_load((const GAS bf16x8*)(QC + row * D + h * 256 + 16 * ks + 8 * hh));
    const f32x4 pq = *(const f32x4*)((const float*)(F.ws + WS_SSQQ) + (row * 4 + h) * 4);
    const float rq = (0.0625f * 1.4426950408889634f) / sqrtf(((pq[0] + pq[1]) + (pq[2] + pq[3])) * (1.0f / 256.0f) + EPS);
    __syncthreads();
    { const bf16_t* KM = (const bf16_t*)(F.ws + WS_KMEM) + (size_t)(b * MEML) * D + h * 256;
#pragma unroll 8
      for (int j = 0; j < 16; ++j) { const int p = tid + NTHR * j, key = p >> 5, c = p & 31;
          const u32x4 v = *(const GAS u32x4*)(KM + (size_t)key * D + 8 * c);
          *(LAS u32x4*)(lds + key * 512 + ((c ^ (key & 15)) << 4)) = v; } }
    __syncthreads();
    const float shift2 = *(const float*)(F.ws + WS_WRT + 256 * 1024);
    bf16x8 pf[8][2];
    float l = 0.f;
#pragma unroll
    for (int kt = 0; kt < 8; ++kt) {
        const int key = 32 * kt + ql;
        f32x16 a = {};
#pragma unroll
        for (int ks = 0; ks < 16; ++ks) {
            const bf16x8 kf = *(const LAS bf16x8*)(lds + key * 512 + (((2 * ks + hh) ^ (key & 15)) << 4));
            a = MFMA32(kf, qf[ks], a);
        }
#pragma unroll
        for (int r = 0; r < 16; ++r) { a[r] = __builtin_amdgcn_exp2f(a[r] * rq - shift2); l += a[r]; }
        pf[kt][0] = pack8(a[0], a[1], a[2], a[3], a[4], a[5], a[6], a[7]);
        pf[kt][1] = pack8(a[8], a[9], a[10], a[11], a[12], a[13], a[14], a[15]);
    }
    l += __shfl_xor(l, 32);
    __syncthreads();
    { const bf16_t* VM = (const bf16_t*)(F.ws + WS_VMT) + (size_t)(b * MEML) * D + h * 256;
#pragma unroll 8
      for (int j = 0; j < 16; ++j) { const int p = tid + NTHR * j, key = p >> 5, c = p & 31;
          const u32x4 v = *(const GAS u32x4*)(VM + (size_t)key * D + 8 * c);
          *(LAS u32x4*)(lds + (c >> 2) * 16384 + key * 64 + (c & 3) * 16) = v; } }
    __syncthreads();
    const int vtr_off = ((lane & 15) >> 2) * 64 + (16 * ((lane >> 4) & 1) + 4 * (lane & 3)) * 2;
    const float inv = 1.0f / l;
    unsigned char* OC = F.ws + WS_RD + ((size_t)(pm * 8 + w) * 128 + h * 32) * 512 + ql * 16 + 8 * hh;
#pragma unroll
    for (int d = 0; d < 8; ++d) {
        f32x16 o = {};
#pragma unroll
        for (int kt = 0; kt < 8; ++kt)
#pragma unroll
            for (int s2 = 0; s2 < 2; ++s2) {
                const LAS unsigned char* vp = lds + d * 16384 + (32 * kt + 16 * s2 + 4 * hh) * 64 + vtr_off;
                const s16x4 lo = vtr(vp), hi = vtr(vp + 8 * 64);
                o = MFMA32(cat8(lo, hi), pf[kt][s2], o);
            }
#pragma unroll
        for (int g = 0; g < 4; ++g) {
            u32x2 wv; wv.x = pk2(o[4 * g] * inv, o[4 * g + 1] * inv); wv.y = pk2(o[4 * g + 2] * inv, o[4 * g + 3] * inv);
            *(GAS u32x2*)(OC + (size_t)(4 * d + g) * 512) = wv;
        }
    }
    __builtin_amdgcn_s_setprio(0);
}
DI void xattn_phase(Frame& F) {
    for (int i = 0; i < 2; ++i) {
        const int L = i * F.G + F.bid; if (L >= 512) break;
        const int wg = xcd_remap(L, 512); int pm, pn; grouped_tile(wg, 128, 4, pm, pn);
        xattn_unit(F, pm, pn);
    }
    asm volatile("s_waitcnt vmcnt(0)" ::: "memory"); __syncthreads();
}

DI void route_phase(Frame& F, bool dummy) {
    const int lane = F.lane, tr = lane & 15, kq = lane >> 4, w = F.wave;
    const bf16_t* WRP = (const bf16_t*)(F.ws + WS_WRT);
    unsigned* cnt = (unsigned*)(F.ws + WS_CTL) + CW_CNT + (dummy ? 4096 : 0);
    int* LT = (int*)(F.ws + (dummy ? WS_RD : WS_LTOK)); float* LG = (float*)(F.ws + (dummy ? WS_RD + 8 * MiB : WS_LGATE)); float* LR = (float*)(F.ws + (dummy ? WS_RD + 16 * MiB : WS_LRSTD));
    LAS float* red = (LAS float*)(F.lds);
    LAS float* lgs = (LAS float*)(F.lds + 98304);
    LAS float* ssp = (LAS float*)(F.lds + 98304 + 25600);
    LAS unsigned* hist = (LAS unsigned*)(F.lds + 98304 + 25600 + 4096);
    bf16x8 bfr[4][3][2];
#pragma unroll
    for (int sp = 0; sp < 4; ++sp)
#pragma unroll
        for (int nb = 0; nb < 3; ++nb)
#pragma unroll
            for (int hl = 0; hl < 2; ++hl) bfr[sp][nb][hl] = *(const GAS bf16x8*)(WRP + ((size_t)(((4 * w + sp) * 3 + nb) * 2 + hl) * 64 + lane) * 8);
    for (int chunk = F.bid; chunk < T / 128; chunk += F.G) {
        __syncthreads();
        if (F.tid < 128) hist[F.tid] = 0u;
        const int tok0 = chunk * 128;
        const bf16_t* xbase = (const bf16_t*)(F.ws + WS_RC) + (size_t)(tok0 + tr) * D + 128 * w + 8 * kq;
        unsigned char* x8base = F.ws + (dummy ? WS_RD + 24 * MiB : WS_X2F8) + (size_t)(tok0 + tr) * D + 128 * w + 8 * kq;
        u32x4 xc[2][4], xn[2][4];
#pragma unroll
        for (int tq = 0; tq < 2; ++tq)
#pragma unroll
            for (int sp = 0; sp < 4; ++sp) xc[tq][sp] = *(const GAS u32x4*)(xbase + (size_t)(16 * tq) * D + 32 * sp);
#pragma unroll 1
        for (int half = 0; half < 4; ++half) {
            f32x4 acc[2][3];
            { const int hn = (half < 3) ? half + 1 : half;
#pragma unroll
              for (int tq = 0; tq < 2; ++tq)
#pragma unroll
                for (int sp = 0; sp < 4; ++sp) xn[tq][sp] = *(const GAS u32x4*)(xbase + (size_t)(16 * (2 * hn + tq)) * D + 32 * sp); }
#pragma unroll
            for (int tq = 0; tq < 2; ++tq) {
                const int tb = 2 * half + tq;
                float ss = 0.f;
                acc[tq][0] = (f32x4){0.f, 0.f, 0.f, 0.f}; acc[tq][1] = acc[tq][0]; acc[tq][2] = acc[tq][0];
#pragma unroll
                for (int sp = 0; sp < 4; ++sp) {
                    const u32x4 xw = xc[tq][sp];
#pragma unroll
                    for (int e = 0; e < 4; ++e) { const float a0 = bflo(xw[e]), a1 = bfhi(xw[e]); ss += a0 * a0 + a1 * a1; }
                    { u32x2 w8; w8.x = pk4_fp8(bflo(xw.x), bfhi(xw.x), bflo(xw.y), bfhi(xw.y)); w8.y = pk4_fp8(bflo(xw.z), bfhi(xw.z), bflo(xw.w), bfhi(xw.w));
                      *(GAS u32x2*)(x8base + (size_t)(16 * tb) * D + 32 * sp) = w8; }
                    const bf16x8 ah = __builtin_bit_cast(bf16x8, xw);
#pragma unroll
                    for (int nb = 0; nb < 3; ++nb) {
                        acc[tq][nb] = __builtin_amdgcn_mfma_f32_16x16x32_bf16(ah, bfr[sp][nb][0], acc[tq][nb], 0, 0, 0);
                        acc[tq][nb] = __builtin_amdgcn_mfma_f32_16x16x32_bf16(ah, bfr[sp][nb][1], acc[tq][nb], 0, 0, 0);
                    }
                }
                ss += __shfl_xor(ss, 16); ss += __shfl_xor(ss, 32);
                if (kq == 0) ssp[w * 128 + 16 * tb + tr] = ss;
            }
#pragma unroll
            for (int tq = 0; tq < 2; ++tq)
#pragma unroll
                for (int sp = 0; sp < 4; ++sp) xc[tq][sp] = xn[tq][sp];
#pragma unroll
            for (int tq = 0; tq < 2; ++tq)
#pragma unroll
                for (int nb = 0; nb < 3; ++nb)
#pragma unroll
                    for (int r = 0; r < 4; ++r) red[w * 1536 + ((tq * 3 + nb) * 4 + r) * 64 + lane] = acc[tq][nb][r];
            __syncthreads();
#pragma unroll
            for (int q = 0; q < 3; ++q) {
                const int e = F.tid + 512 * q, idx = e >> 6, ln = e & 63;
                float sum = 0.f;
#pragma unroll
                for (int ww = 0; ww < 8; ++ww) sum += red[ww * 1536 + e];
                const int r = idx & 3, nb = (idx >> 2) % 3, tq = idx / 12;
                lgs[(16 * (2 * half + tq) + 4 * (ln >> 4) + r) * 49 + 16 * nb + (ln & 15)] = sum;
            }
            __syncthreads();
        }
        __syncthreads();
        int re1 = 0, re2 = 0; float g1 = 0.f, g2 = 0.f, rstd = 0.f; unsigned s1 = 0, s2 = 0;
        const int t = F.tid;
        if (t < 128) {
            float ss = 0.f;
#pragma unroll
            for (int q = 0; q < 8; ++q) ss += ssp[q * 128 + t];
            rstd = 1.0f / sqrtf(ss * (1.0f / D) + EPS);
            float lg[36];
#pragma unroll
            for (int e = 0; e < 36; ++e) lg[e] = lgs[t * 49 + e] * rstd;
            float gmax = lg[0]; int gi = 0;
#pragma unroll
            for (int j = 1; j < 4; ++j) if (lg[j] > gmax) { gmax = lg[j]; gi = j; }
            float den = 0.f;
#pragma unroll
            for (int j = 0; j < 4; ++j) den += __expf(lg[j] - gmax);
            const float gwt = 1.0f / den;
            float le[8];
#pragma unroll
            for (int e = 0; e < 8; ++e) le[e] = gi == 0 ? lg[4 + e] : (gi == 1 ? lg[12 + e] : (gi == 2 ? lg[20 + e] : lg[28 + e]));
            float t1 = le[0]; int i1 = 0;
#pragma unroll
            for (int e = 1; e < 8; ++e) if (le[e] > t1) { t1 = le[e]; i1 = e; }
            float t2 = -INFINITY; int i2 = 0;
#pragma unroll
            for (int e = 0; e < 8; ++e) if (e != i1 && le[e] > t2) { t2 = le[e]; i2 = e; }
            const float ex = __expf(t2 - t1), p1 = 1.0f / (1.0f + ex), p2 = ex * p1;
            re1 = gi * 8 + i1; re2 = gi * 8 + i2; g1 = p1 * gwt; g2 = p2 * gwt;
            s1 = __hip_atomic_fetch_add(hist + re1, 1u, __ATOMIC_RELAXED, __HIP_MEMORY_SCOPE_WORKGROUP); s2 = __hip_atomic_fetch_add(hist + re2, 1u, __ATOMIC_RELAXED, __HIP_MEMORY_SCOPE_WORKGROUP);
        }
        __syncthreads();
        if (t < 64) { const unsigned c = hist[t]; hist[64 + t] = c ? __hip_atomic_fetch_add(cnt + 64 * t, c, RLX_AGENT) : 0u; }
        __syncthreads();
        if (t < 128) {
            const size_t p1 = (size_t)re1 * CAP + hist[64 + re1] + s1, p2 = (size_t)re2 * CAP + hist[64 + re2] + s2;
            LT[p1] = 2 * (tok0 + t); LG[p1] = g1; LR[p1] = rstd;
            LT[p2] = 2 * (tok0 + t) + 1; LG[p2] = g2; LR[p2] = rstd;
        }
    }
}
DI void build_tile_table(Frame& F) {
    LAS int* tbl = (LAS int*)(F.lds + TBL_OFF);
    unsigned* cnt = (unsigned*)(F.ws + WS_CTL) + CW_CNT;
    __syncthreads();
    if (F.tid < 64) tbl[F.tid] = (F.tid < 32) ? (int)__hip_atomic_load(cnt + 64 * F.tid, RLX_AGENT) : 0;
    __syncthreads();
    if (F.tid == 0) { int a = 0; for (int j = 0; j < 64; ++j) { tbl[64 + j] = a; a += (tbl[j] + 255) >> 8; } tbl[128] = a; }
    __syncthreads();
}

DI void final_phase(Frame& F) {
    const bf16_t* C0 = (const bf16_t*)(F.ws + WS_RB); const bf16_t* C1 = (const bf16_t*)(F.ws + WS_RA); const bf16_t* X2 = (const bf16_t*)(F.ws + WS_RC);
    const size_t n8 = (size_t)T * D / 8;
    for (size_t i = (size_t)F.bid * NTHR + F.tid; i < n8; i += (size_t)F.G * NTHR) {
        const u32x4 a = __builtin_nontemporal_load((const GAS u32x4*)(C0 + i * 8)), b = __builtin_nontemporal_load((const GAS u32x4*)(C1 + i * 8)), x = __builtin_nontemporal_load((const GAS u32x4*)(X2 + i * 8));
        GAS f32x4* o = (GAS f32x4*)(F.out + i * 8);
        f32x4 o0, o1;
        o0[0] = bflo(x.x) + (bflo(a.x) + bflo(b.x)); o0[1] = bfhi(x.x) + (bfhi(a.x) + bfhi(b.x)); o0[2] = bflo(x.y) + (bflo(a.y) + bflo(b.y)); o0[3] = bfhi(x.y) + (bfhi(a.y) + bfhi(b.y));
        o1[0] = bflo(x.z) + (bflo(a.z) + bflo(b.z)); o1[1] = bfhi(x.z) + (bfhi(a.z) + bfhi(b.z)); o1[2] = bflo(x.w) + (bflo(a.w) + bflo(b.w)); o1[3] = bfhi(x.w) + (bfhi(a.w) + bfhi(b.w));
        __builtin_nontemporal_store(o0, o); __builtin_nontemporal_store(o1, o + 1);
    }
}

__global__ void __launch_bounds__(NTHR, 2) fwd_kernel(Args args) {
    extern __shared__ __attribute__((aligned(16))) unsigned char lds_raw[];
    Frame F;
    F.lds = (LAS unsigned char*)lds_raw;
    F.ws = args.ws; F.out = args.out; F.in = args.in;
    F.tid = threadIdx.x; F.lane = F.tid & 63; F.wave = __builtin_amdgcn_readfirstlane(F.tid >> 6);
    F.G = gridDim.x; F.bid = blockIdx.x;
    for (int u = F.tid; u < (LDS_BYTES - LDSCTL_OFF) / 4; u += NTHR) ((LAS unsigned*)(F.lds + LDSCTL_OFF))[u] = 0u;
    __syncthreads();
    unsigned* ctl = (unsigned*)(args.ws + WS_CTL);
    const int lo = args.ph_lo, hi = args.ph_hi;
    XcdBarrier bar; bar.bar = ctl + CW_BAR; bar.x = 0; bar.st = nullptr;
    if (hi - lo > 1) bar = xcd_barrier_post(ctl + CW_BAR, (volatile LAS unsigned*)(F.lds + MISC_OFF) + 8);
    Sched S; S.G = F.G; S.c = F.bid; S.ws = F.ws; S.tbl = (const LAS int*)(F.lds + TBL_OFF); S.round = 0;
    EpiCtx E; E.ws = F.ws; E.out = F.out; E.in = F.in;
#define IN(k) (lo <= (k) && (k) < hi)
#define SEAM(k) do { if (IN(k) && IN((k) + 1)) xcd_barrier(bar); } while (0)
#ifndef DUP_PHASE
#define DUP_PHASE -1
#endif
#ifndef TS_UNIT
#define TS_UNIT 100
#endif
#if TS_PHASE >= 0
    volatile LAS unsigned long long* tsw = (volatile LAS unsigned long long*)(F.lds + MISC_OFF + 64);
#define STAMP(k) do { if (F.tid == 0) tsw[k] = __builtin_amdgcn_s_memrealtime(); } while (0)
#else
#define STAMP(k) do { } while (0)
#endif
    STAMP(0);
#define RUNPH(k, body) do { if (IN(k)) { const int nrep_ = (DUP_PHASE == (k)) ? 2 + (lo >> 20) : 1; for (int rep_ = 0; rep_ < nrep_; ++rep_) { if (rep_) xcd_barrier(bar); body; } } SEAM(k); STAMP((k) + 1); } while (0)
    RUNPH(PH_P0, p0_prologue(F));
#if DUP_PHASE == 100
    for (int i = 0; i < 4; ++i) xcd_barrier(bar);
#endif
    RUNPH(PH_PROJ, { const bool conv_first = (F.bid & 7) < 4; if (conv_first) p0b_expert_weights(F); gemm_phase<PH_PROJ>(F.lds, S, E); gemm_phase<PH_MEMK>(F.lds, S, E); gemm_phase<PH_MEMV>(F.lds, S, E); if (!conv_first) p0b_expert_weights(F); });
    RUNPH(PH_MIX, mix_phase(F));
    RUNPH(PH_WOUT, gemm_phase<PH_WOUT>(F.lds, S, E));
    RUNPH(PH_WCQ, { gemm_phase<PH_WCQ>(F.lds, S, E); xattn_phase(F); });
    STAMP(PH_SC + 1); STAMP(PH_PV + 1);
    RUNPH(PH_WCO, gemm_phase<PH_WCO>(F.lds, S, E));
    RUNPH(PH_ROUTE, route_phase(F, rep_ + 1 < nrep_));
    RUNPH(PH_UP, { build_tile_table(F); gemm_phase<PH_UP>(F.lds, S, E); (gemm_phase<PH_UP, 1>)(F.lds, S, E); (gemm_phase<PH_UP, 2>)(F.lds, S, E); });
    RUNPH(PH_DOWN0, { build_tile_table(F); gemm_phase<PH_DOWN0>(F.lds, S, E); (gemm_phase<PH_DOWN0, 1>)(F.lds, S, E); (gemm_phase<PH_DOWN0, 2>)(F.lds, S, E); });
    RUNPH(PH_DOWN1, final_phase(F));
#if TS_PHASE >= 0
    xcd_barrier(bar);
    if (F.bid == 0 && F.tid == 0) { const unsigned long long dt = (TS_PHASE == 30 ? (tsw[PH_N] - tsw[0]) : (tsw[TS_PHASE + 1] - tsw[TS_PHASE])) / TS_UNIT; F.out[0] += (float)(dt > 250ull ? 250ull : dt); }
#endif
#undef RUNPH
#undef IN
#undef SEAM
}

#ifndef N_LAUNCH_MODE
#define N_LAUNCH_MODE 1
#endif
extern "C" void kernel_launch(void* const* d_in, const int* in_sizes, int n_in, void* d_out, int out_size, void* d_ws, size_t ws_size, hipStream_t stream) {
    static int grid = 0;
    if (grid == 0) {
        if (n_in != 27 || out_size != T * D || ws_size < WS_END) { fprintf(stderr, "kernel_launch: unexpected shapes (n_in %d out %d ws %zu)\n", n_in, out_size, ws_size); grid = -1; return; }
        int dev = 0, cus = 0, per_cu = 0;
        if (hipGetDevice(&dev) != hipSuccess || hipDeviceGetAttribute(&cus, hipDeviceAttributeMultiprocessorCount, dev) != hipSuccess) { grid = -1; return; }
        if (hipFuncSetAttribute((const void*)fwd_kernel, hipFuncAttributeMaxDynamicSharedMemorySize, LDS_BYTES) != hipSuccess) { fprintf(stderr, "kernel_launch: hipFuncSetAttribute failed\n"); grid = -1; return; }
        if (hipOccupancyMaxActiveBlocksPerMultiprocessor(&per_cu, (const void*)fwd_kernel, NTHR, LDS_BYTES) != hipSuccess || per_cu < 1) { fprintf(stderr, "kernel_launch: occupancy query says %d\n", per_cu); }
        (void)hipGetLastError();
        grid = cus;
    }
    if (grid < 0) return;
    (void)hipMemsetAsync((char*)d_ws + WS_CTL, 0, CTL_ZERO_BYTES, stream);
    Args a{};
    for (int i = 0; i < 27; ++i) a.in[i] = (const float*)d_in[i];
    a.out = (float*)d_out; a.ws = (unsigned char*)d_ws;
    if (N_LAUNCH_MODE == 1) { a.ph_lo = 0; a.ph_hi = PH_N; hipLaunchKernelGGL(fwd_kernel, dim3(grid), dim3(NTHR), LDS_BYTES, stream, a); }
    else for (int p = 0; p < PH_N; ++p) { a.ph_lo = p; a.ph_hi = p + 1; hipLaunchKernelGGL(fwd_kernel, dim3(grid), dim3(NTHR), LDS_BYTES, stream, a); }
}
```

```cpp
#include <hip/hip_runtime.h>
#include <hip/hip_bf16.h>
#include <cstdio>
#include <cstdint>

#define GAS __attribute__((address_space(1)))
#define LAS __attribute__((address_space(3)))
typedef unsigned short bf16_t;
typedef short bf16x8 __attribute__((ext_vector_type(8)));
typedef short s16x4 __attribute__((ext_vector_type(4)));
typedef float f32x4 __attribute__((ext_vector_type(4)));
typedef float f32x2 __attribute__((ext_vector_type(2)));
typedef float f32x16 __attribute__((ext_vector_type(16)));
typedef unsigned u32x4 __attribute__((ext_vector_type(4)));
typedef unsigned u32x2 __attribute__((ext_vector_type(2)));
typedef __bf16 bf16x2_t __attribute__((ext_vector_type(2)));
typedef int v8i_t __attribute__((ext_vector_type(8)));
typedef int v4i_t __attribute__((ext_vector_type(4)));
#define DI __device__ __forceinline__

#ifndef TS_PHASE
#define TS_PHASE -1
#endif
constexpr int T = 32768, D = 1024, BATCH = 8, SEQ = 4096, MEML = 256, NMEM = BATCH * MEML;
constexpr int INW = 1792;
constexpr int PJW = 768;
constexpr float EPS = 1e-6f;
constexpr int NWAVES = 8, NTHR = 512;
constexpr int CAP = 32768;
constexpr int MAXRT = 320;

constexpr size_t MiB = 1u << 20;
constexpr size_t WS_CTL = 0, CTL_ZERO_BYTES = 64 * 1024;
constexpr size_t WS_WRT = 1 * MiB;
constexpr size_t WS_SSQ1P = 2 * MiB;
constexpr size_t WS_SSQQ = 4 * MiB;
constexpr size_t WS_LSUM = 6 * MiB;
constexpr size_t WS_SSQK = 8 * MiB;
constexpr size_t WS_RSTDK = 8 * MiB + 512 * 1024;
constexpr size_t WS_RSTD0 = 9 * MiB;
constexpr size_t WS_LTOK = 10 * MiB, WS_LGATE = 18 * MiB, WS_LRSTD = 26 * MiB;
constexpr size_t WS_WIN = 34 * MiB, WS_WOUT = 38 * MiB, WS_WCQ = 40 * MiB, WS_WCK = 42 * MiB, WS_WCV = 44 * MiB, WS_WCO = 46 * MiB;
constexpr size_t WS_W13 = 48 * MiB, WS_W2 = 112 * MiB;
constexpr size_t WS_X2F8 = 80 * MiB;
constexpr size_t WS_MEMB = 144 * MiB, WS_KMEM = 148 * MiB, WS_VMT = 152 * MiB;
constexpr size_t WS_RA = 156 * MiB;
constexpr size_t WS_RB = 220 * MiB;
constexpr size_t WS_RC = 332 * MiB;
constexpr size_t WS_RD = 396 * MiB;
constexpr size_t WS_END = 476 * MiB;
constexpr int CW_TKT = 96, CW_TKT2 = 160;
constexpr int CW_BAR = 4096, CW_CNT = 8192;

constexpr int RING_BYTES = 131072;
constexpr int LDS_BYTES = 147456;
constexpr int LDSCTL_OFF = RING_BYTES, MISC_OFF = LDS_BYTES - 256;
constexpr int TBL_OFF = RING_BYTES + 512;
constexpr int XCH_OFF = RING_BYTES + 2048;
constexpr int SGP_OFF = RING_BYTES + 4096;
constexpr int SGR_OFF = RING_BYTES + 8192;
constexpr int RT_XT_BYTES = 16 * 260 * 4;
constexpr int RT_HIST_OFF = 8 * RT_XT_BYTES;

#define RLX_AGENT __ATOMIC_RELAXED, __HIP_MEMORY_SCOPE_AGENT
#define LDS_WAIT() asm volatile("s_waitcnt lgkmcnt(0)" ::: "memory")
#define VM_WAIT() asm volatile("s_waitcnt vmcnt(0)" ::: "memory")
DI unsigned f2bf(float f) { unsigned u = __builtin_bit_cast(unsigned, f); return (u + 0x7fffu + ((u >> 16) & 1u)) >> 16; }
DI unsigned pk2(float lo, float hi) { f32x2 v = {lo, hi}; bf16x2_t b = __builtin_convertvector(v, bf16x2_t); return __builtin_bit_cast(unsigned, b); }
DI unsigned pk4_fp8(float a, float b, float c, float d) { int w = 0; w = __builtin_amdgcn_cvt_pk_fp8_f32(a, b, w, false); w = __builtin_amdgcn_cvt_pk_fp8_f32(c, d, w, true); return (unsigned)w; }
DI float bf2f(unsigned short h) { return __builtin_bit_cast(float, (unsigned)h << 16); }
DI float bflo(unsigned w) { return __builtin_bit_cast(float, w << 16); }
DI float bfhi(unsigned w) { return __builtin_bit_cast(float, w & 0xffff0000u); }
DI unsigned long long rt_now() { unsigned long long t; asm volatile("s_memrealtime %0\n\ts_waitcnt lgkmcnt(0)" : "=s"(t) :: "memory"); return t; }
DI int lane_id() { unsigned z = 0u; asm volatile("" : "+v"(z)); return (int)__builtin_amdgcn_mbcnt_hi(~0u, __builtin_amdgcn_mbcnt_lo(~0u, z)); }
DI float wave_sum(float v) {
#pragma unroll
    for (int o = 1; o < 64; o <<= 1) v += __shfl_xor(v, o);
    return v;
}
DI float fast_exp(float x) { return __builtin_amdgcn_exp2f(x * 1.4426950408889634f); }
DI float gelu_tanh(float x) {
    const float w = x * __builtin_fmaf(x * x, 0.10294324f, 2.3022082f);
    return x * __builtin_amdgcn_rcpf(1.0f + __builtin_amdgcn_exp2f(-w));
}
DI float silu(float x) { return x * __builtin_amdgcn_rcpf(1.0f + fast_exp(-x)); }

#define XB_TMO      128
#define XB_XCNT(j)  (256  + 64 * (j))
#define XB_XSUB(j)  (1280 + 64 * (j))
#define XB_XGEN(j)  (2304 + 64 * (j))
#define XB_TOP      3328
#define XB_TOPGEN   3392
#define XCD_BAR_WORDS 3456
#define XB_SPIN_CAP (1u << 18)
DI unsigned xb_ld(unsigned* p)              { return __hip_atomic_load(p, __ATOMIC_RELAXED, __HIP_MEMORY_SCOPE_AGENT); }
DI unsigned xb_add(unsigned* p, unsigned v) { return __hip_atomic_fetch_add(p, v, __ATOMIC_RELAXED, __HIP_MEMORY_SCOPE_AGENT); }
DI unsigned xb_xcc_id() { return (unsigned)__builtin_amdgcn_s_getreg((3 << 11) | 20) & 0xFu; }
#define XB_SPIN(cond, bar) do { unsigned _sp = 0; while (cond) { __builtin_amdgcn_s_sleep(1); \
    if ((++_sp & 255u) == 0u) { if (xb_ld(&(bar)[XB_TMO])) break; if (_sp > XB_SPIN_CAP) { atomicAdd(&(bar)[XB_TMO], 1u); break; } } } } while (0)
struct XcdBarrier { unsigned* bar; unsigned x; volatile LAS unsigned* st; int wave; };
DI XcdBarrier xcd_barrier_post(unsigned* bar, volatile LAS unsigned* st, int wave) {
    XcdBarrier b; b.bar = bar; b.x = xb_xcc_id(); b.st = st; b.wave = wave;
    if (wave == 0 && lane_id() == 0) (void)xb_add(&bar[XB_XCNT(b.x)], 1u);
    return b;
}
DI void xcd_barrier_complete(unsigned* bar, unsigned x, unsigned& nloc, unsigned& nx) {
    const unsigned G = gridDim.x * gridDim.y * gridDim.z;
    unsigned sum, cnt, mine, sp = 0u;
    for (;;) {
        sum = 0u; cnt = 0u; mine = 0u;
#pragma unroll
        for (unsigned j = 0; j < 16; ++j) { const unsigned c = xb_ld(&bar[XB_XCNT(j)]); sum += c; cnt += (c > 0u) ? 1u : 0u; mine = (j == x) ? c : mine; }
        if (sum == G) break;
        __builtin_amdgcn_s_sleep(1);
        if ((++sp & 255u) == 0u) { if (xb_ld(&bar[XB_TMO])) break; if (sp > XB_SPIN_CAP) { atomicAdd(&bar[XB_TMO], 1u); break; } }
    }
    nloc = mine > 0u ? mine : 1u; nx = cnt > 0u ? cnt : 1u;
}
DI void xcd_barrier(const XcdBarrier& b) {
    asm volatile("s_waitcnt vmcnt(0)" ::: "memory");
    __syncthreads();
    if (b.wave == 0 && lane_id() == 0) {
        unsigned* bar = b.bar;
        __builtin_amdgcn_s_waitcnt(0);
        unsigned nloc = b.st[0], nx = b.st[1];
        if (nloc == 0u) { xcd_barrier_complete(bar, b.x, nloc, nx); b.st[0] = nloc; b.st[1] = nx; }
        const unsigned old = xb_add(&bar[XB_XSUB(b.x)], 1u);
        const unsigned gen = old / nloc;
        if (old + 1u == (gen + 1u) * nloc) {
            __builtin_amdgcn_fence(__ATOMIC_RELEASE, "agent");
            asm volatile("s_waitcnt vmcnt(0)" ::: "memory");
            const unsigned og = xb_add(&bar[XB_TOP], 1u);
            const unsigned tg = og / nx;
            if (og + 1u == (tg + 1u) * nx) xb_add(&bar[XB_TOPGEN], 1u);
            else XB_SPIN(xb_ld(&bar[XB_TOPGEN]) == tg, bar);
            __builtin_amdgcn_fence(__ATOMIC_ACQUIRE, "agent");
            xb_add(&bar[XB_XGEN(b.x)], 1u);
            asm volatile("s_waitcnt vmcnt(0)" ::: "memory");
        } else {
            XB_SPIN(xb_ld(&bar[XB_XGEN(b.x)]) == gen, bar);
            __builtin_amdgcn_fence(__ATOMIC_ACQUIRE, "agent");
            asm volatile("s_waitcnt vmcnt(0)" ::: "memory");
        }
    }
    __syncthreads();
}

struct Args {
    const float* in[27];
    float* out; unsigned char* ws;
    int ph_lo, ph_hi;
};
struct Frame {
    LAS unsigned char* lds;
    unsigned char* ws; float* out;
    int tid, lane, wave, G, bid;
    const float* const* in;
};
enum { I_X = 0, I_MEM, I_NORM_MIX, I_W_IN, I_Q_NORM, I_K_NORM, I_SINKS, I_SGU_NORM, I_SGU_W, I_SGU_B, I_ON_ATTN, I_ON_SGU, I_W_OUT,
       I_NORM_CROSS, I_NORM_MEM, I_W_CQ, I_W_CK, I_W_CV, I_CQ_NORM, I_CK_NORM, I_W_CO, I_NORM_FFN, I_WRG, I_WRE, I_W1, I_W3, I_W2 };

DI void p0_transpose_item(const float* W, int N, bf16_t* WT, int ldt, int row_off, const float* gain, LAS unsigned* scr, int kb, int nb, int lane) {
    const int k0 = 64 * kb, n0 = 64 * nb, c = lane & 15, kp = lane >> 4;
    f32x4 va[8], vb[8];
#pragma unroll
    for (int i = 0; i < 8; ++i) { const int kk = 2 * (kp + 4 * i);
        va[i] = __builtin_nontemporal_load((const GAS f32x4*)(W + (size_t)(k0 + kk) * N + n0 + 4 * c)); vb[i] = __builtin_nontemporal_load((const GAS f32x4*)(W + (size_t)(k0 + kk + 1) * N + n0 + 4 * c)); }
#pragma unroll
    for (int i = 0; i < 8; ++i) { const int kk = 2 * (kp + 4 * i);
        float ga = 1.f, gb = 1.f; if (gain) { ga = gain[k0 + kk]; gb = gain[k0 + kk + 1]; }
#pragma unroll
        for (int e = 0; e < 4; ++e) scr[(4 * c + e) * 33 + (kp + 4 * i)] = pk2(va[i][e] * ga, vb[i][e] * gb); }
    LDS_WAIT(); asm volatile("" ::: "memory");
    const int ch = lane & 7;
#pragma unroll
    for (int j = 0; j < 8; ++j) { const int n = (lane >> 3) + 8 * j; const LAS unsigned* sp = scr + n * 33 + 4 * ch;
        u32x4 o; o.x = sp[0]; o.y = sp[1]; o.z = sp[2]; o.w = sp[3];
        *(GAS u32x4*)(WT + (size_t)(row_off + n0 + n) * ldt + k0 + 8 * ch) = o; }
    LDS_WAIT(); asm volatile("" ::: "memory");
}
DI void p0_transpose_item_f8(const float* W, int N, unsigned char* WT, int ldt, int row_off, const float* gain, LAS unsigned* scr, int kb, int nb, int lane) {
    const int k0 = 128 * kb, n0 = 32 * nb, c = lane & 7, kq = lane >> 3;
    f32x4 v[4][4], gg[4];
    if (gain) {
#pragma unroll
        for (int i = 0; i < 4; ++i) gg[i] = *(const f32x4*)(gain + k0 + 4 * (kq + 8 * i));
    } else {
#pragma unroll
        for (int i = 0; i < 4; ++i) gg[i] = (f32x4){1.f, 1.f, 1.f, 1.f};
    }
#pragma unroll
    for (int i = 0; i < 4; ++i)
#pragma unroll
        for (int r = 0; r < 4; ++r) v[i][r] = __builtin_nontemporal_load((const GAS f32x4*)(W + (size_t)(k0 + 4 * (kq + 8 * i) + r) * N + n0 + 4 * c));
    asm volatile("" : "+v"(gg[0]), "+v"(gg[1]), "+v"(gg[2]), "+v"(gg[3]) :: "memory");
#pragma unroll
    for (int i = 0; i < 4; ++i) {
        const f32x4 g = gg[i] * 32.f;
#pragma unroll
        for (int e = 0; e < 4; ++e) scr[(4 * c + e) * 33 + (kq + 8 * i)] = pk4_fp8(v[i][0][e] * g[0], v[i][1][e] * g[1], v[i][2][e] * g[2], v[i][3][e] * g[3]); }
    LDS_WAIT(); asm volatile("" ::: "memory");
    const int ch = lane & 7;
#pragma unroll
    for (int j = 0; j < 4; ++j) { const int n = (lane >> 3) + 8 * j; const LAS unsigned* sp = scr + n * 33 + 4 * ch;
        u32x4 o; o.x = sp[0]; o.y = sp[1]; o.z = sp[2]; o.w = sp[3];
        *(GAS u32x4*)(WT + (size_t)(row_off + n0 + n) * ldt + k0 + 16 * ch) = o; }
    LDS_WAIT(); asm volatile("" ::: "memory");
}
DI void rms_row_to_bf16(const float* xrow, bf16_t* orow, int lane, float* rstd_out) {
    const GAS f32x4* xr = (const GAS f32x4*)xrow + lane;
    f32x4 v[4]; float s = 0.f;
#pragma unroll
    for (int j = 0; j < 4; ++j) { v[j] = __builtin_nontemporal_load(xr + 64 * j); s += (v[j].x * v[j].x + v[j].y * v[j].y) + (v[j].z * v[j].z + v[j].w * v[j].w); }
    float rstd = 1.0f / sqrtf(wave_sum(s) * (1.f / D) + EPS);
    if (rstd_out) { if (lane == 0) *rstd_out = rstd; rstd = 1.0f; }
    GAS u32x2* o8 = (GAS u32x2*)orow + lane;
#pragma unroll
    for (int j = 0; j < 4; ++j) { u32x2 w; w.x = pk2(v[j].x * rstd, v[j].y * rstd); w.y = pk2(v[j].z * rstd, v[j].w * rstd); o8[64 * j] = w; }
}
DI void p0_prologue(Frame& F) {
    LAS unsigned* scr = (LAS unsigned*)(F.lds + F.wave * 16384);
    const int gw = F.bid * NWAVES + F.wave, NGW = F.G * NWAVES, lane = F.lane;
    unsigned char* ws = F.ws;
    constexpr int I_IN = 16 * 28, I_SQ = 16 * 16, I_E1 = 32 * 16 * 8, I_E2 = 32 * 8 * 16;
    constexpr int NITEMS = I_IN + 2 * I_SQ;
    for (int it = gw; it < NITEMS; it += NGW) {
        int r = it;
        if (r < I_IN) { p0_transpose_item(F.in[I_W_IN], INW, (bf16_t*)(ws + WS_WIN), D, 0, F.in[I_NORM_MIX], scr, r / 28, r % 28, lane); continue; } r -= I_IN;
        if (r < I_SQ) { p0_transpose_item(F.in[I_W_CK], D, (bf16_t*)(ws + WS_WCK), D, 0, F.in[I_NORM_MEM], scr, r / 16, r % 16, lane); continue; } r -= I_SQ;
        if (r < I_SQ) { p0_transpose_item(F.in[I_W_CV], D, (bf16_t*)(ws + WS_WCV), D, 0, F.in[I_NORM_MEM], scr, r / 16, r % 16, lane); continue; } r -= I_SQ;
    }
    (void)I_E1; (void)I_E2;
#if 0
        if (r < I_E1) { const int e = r / 128, q = r % 128;
                        p0_transpose_item(F.in[I_W1] + (size_t)e * D * 512, 512, (bf16_t*)(ws + WS_W13) + (size_t)e * 1024 * 1024, D, 0, F.in[I_NORM_FFN], scr, q / 8, q % 8, lane); continue; } r -= I_E1;
        if (r < I_E1) { const int e = r / 128, q = r % 128;
                        p0_transpose_item(F.in[I_W3] + (size_t)e * D * 512, 512, (bf16_t*)(ws + WS_W13) + (size_t)e * 1024 * 1024, D, 512, F.in[I_NORM_FFN], scr, q / 8, q % 8, lane); continue; } r -= I_E1;
        { const int e = r / 128, q = r % 128;
          p0_transpose_item(F.in[I_W2] + (size_t)e * 512 * D, D, (bf16_t*)(ws + WS_W2) + (size_t)e * 1024 * 512, 512, 0, nullptr, scr, q / 16, q % 16, lane); }
    }
#endif
    for (int m = gw; m < T + NMEM; m += NGW) {
        if (m < T) rms_row_to_bf16(F.in[I_X] + (size_t)m * D, (bf16_t*)(ws + WS_RA) + (size_t)m * D, lane, (float*)(ws + WS_RSTD0) + m);
        else rms_row_to_bf16(F.in[I_MEM] + (size_t)(m - T) * D, (bf16_t*)(ws + WS_MEMB) + (size_t)(m - T) * D, lane, nullptr);
    }
    {
        bf16_t* swb = (bf16_t*)(ws + WS_WRT + 512 * 1024);
        for (int i = F.bid * NTHR + F.tid; i < 8 * 128 * 128 / 8; i += F.G * NTHR) {
            const int j8 = (i & 15) * 8, ii = (i >> 4) & 127;
            const f32x4 a = *(const f32x4*)(F.in[I_SGU_W] + (size_t)i * 8), c = *(const f32x4*)(F.in[I_SGU_W] + (size_t)i * 8 + 4);
            float v[8] = {a[0], a[1], a[2], a[3], c[0], c[1], c[2], c[3]};
#pragma unroll
            for (int e = 0; e < 8; ++e) v[e] = (j8 + e <= ii) ? v[e] : 0.f;
            u32x4 w; w.x = pk2(v[0], v[1]); w.y = pk2(v[2], v[3]); w.z = pk2(v[4], v[5]); w.w = pk2(v[6], v[7]);
            *(GAS u32x4*)(swb + (size_t)i * 8) = w;
        }
    }
    if (F.bid == 0 && F.wave == 0) {
        float a = 0.f, b = 0.f;
        for (int i = lane; i < 256; i += 64) { a = fmaxf(a, fabsf(F.in[I_CQ_NORM][i])); b = fmaxf(b, fabsf(F.in[I_CK_NORM][i])); }
#pragma unroll
        for (int o = 1; o < 64; o <<= 1) { a = fmaxf(a, __shfl_xor(a, o)); b = fmaxf(b, __shfl_xor(b, o)); }
        if (lane == 0) *(float*)(ws + WS_WRT + 256 * 1024) = 16.0f * a * b * 1.4426950408889634f;
    }
    {
        bf16_t* wrp = (bf16_t*)(ws + WS_WRT);
        for (int i = F.bid * NTHR + F.tid; i < 32 * 3 * 64 * 8; i += F.G * NTHR) {
            const int j = i & 7, ln = (i >> 3) & 63, nb = (i >> 9) % 3, sidx = i / 1536;
            const int k = 32 * sidx + 8 * (ln >> 4) + j, e = 16 * nb + (ln & 15);
            float w = 0.f;
            if (e < 4) w = F.in[I_WRG][k * 4 + e];
            else if (e < 36) { const int g = (e - 4) >> 3, ee = (e - 4) & 7; w = F.in[I_WRE][((size_t)g * D + k) * 8 + ee]; }
            w *= F.in[I_NORM_FFN][k];
            const unsigned h = f2bf(w); const unsigned l = f2bf(w - bf2f((unsigned short)h));
            wrp[((size_t)((sidx * 3 + nb) * 2 + 0) * 64 + ln) * 8 + j] = (bf16_t)h;
            wrp[((size_t)((sidx * 3 + nb) * 2 + 1) * 64 + ln) * 8 + j] = (bf16_t)l;
        }
    }
}

DI void p0b_expert_weights(Frame& F, int mode) {
    const bool dyn = mode != 0;
    LAS unsigned* scr = (LAS unsigned*)(F.lds + F.wave * 16384);
    int lane = F.lane; asm volatile("" : "+v"(lane));
    unsigned char* ws = F.ws;
    constexpr int I_E1 = 32 * 16 * 8, I_E2 = 32 * 8 * 16, I_SQ = 16 * 16, NEXP = 2 * I_E1 + I_E2;
    constexpr int NSTAT = 2 * I_E1 - 8 * 512;
    constexpr int Q2T = 320;
    const int qbase = (mode == 2) ? NEXP - 8 * Q2T : NSTAT, qend = (mode == 2) ? NEXP : NEXP - 8 * Q2T;
    unsigned* tkt = (unsigned*)(F.ws + WS_CTL) + (mode == 2 ? CW_TKT2 : CW_TKT);
    volatile LAS unsigned* tk = (volatile LAS unsigned*)(F.lds + MISC_OFF) + 12;
    const int c = F.bid, G = F.G;
    int i0, i1;
    if (G == 256) { const int w0 = c < 192 ? 2 * c : 384 + 4 * (c - 192), w1 = w0 + (c < 192 ? 2 : 4); i0 = (int)(((long)w0 * NSTAT) / 640); i1 = (int)(((long)w1 * NSTAT) / 640); }
    else { i0 = (int)(((long)c * NSTAT) / G); i1 = (int)(((long)(c + 1) * NSTAT) / G); }
#pragma unroll 1
    for (int r = dyn ? I_SQ : c * NWAVES + F.wave; r < I_SQ; r += G * NWAVES) {
        const int kb = r >> 4, nb = r & 15;
        p0_transpose_item(F.in[I_W_OUT], D, (bf16_t*)(ws + WS_WOUT), D, 0, (kb < 8) ? F.in[I_ON_ATTN] : (F.in[I_ON_SGU] - 512), scr, kb, nb, lane);
    }
    const int dit = c * NWAVES + F.wave, nd = (!dyn && dit < 2 * I_SQ) ? 1 : 0;
    unsigned pend = 0;
    if (dyn && F.tid == 0) pend = xb_add(tkt, 1u);
#pragma unroll 1
    for (int k = 0; ; ++k) {
        const float* W; int N, ldt, row_off, kb, nb; unsigned char* WT; const float* gain;
        int itd = 0;
        if (dyn) {
            __syncthreads();
            if (F.tid == 0) tk[0] = pend;
            __syncthreads();
            const unsigned t_ = tk[0];
            if (qbase + 8 * (int)t_ >= qend) break;
            if (F.tid == 0) pend = xb_add(tkt, 1u);
            itd = qbase + 8 * (int)t_ + F.wave;
        }
        if (k < nd) { const int m = dit >> 8, q = dit & 255; kb = q >> 5; nb = q & 31; N = D; ldt = D; row_off = 0;
            W = F.in[m == 0 ? I_W_CQ : I_W_CO]; WT = ws + (m == 0 ? WS_WCQ : WS_WCO); gain = (m == 0) ? F.in[I_NORM_CROSS] : nullptr; }
        else {
            const int it = dyn ? itd : i0 + F.wave + (k - nd) * NWAVES; if (!dyn && it >= i1) break;
            if (it < 2 * I_E1) { const int which = it < I_E1 ? 0 : 1, r = it - which * I_E1, e = r >> 7, q = r & 127;
                W = F.in[which == 0 ? I_W1 : I_W3] + (size_t)e * D * 512; N = 512; WT = ws + WS_W13 + (size_t)e * 1024 * 1024; ldt = D; row_off = which * 512; gain = F.in[I_NORM_FFN]; kb = q >> 4; nb = q & 15; }
            else { const int r = it - 2 * I_E1, e = r >> 7, q = r & 127;
                W = F.in[I_W2] + (size_t)e * 512 * D; N = D; WT = ws + WS_W2 + (size_t)e * 1024 * 512; ldt = 512; row_off = 0; gain = nullptr; kb = q >> 5; nb = q & 31; }
        }
        p0_transpose_item_f8(W, N, WT, ldt, row_off, gain, scr, kb, nb, lane);
    }
    asm volatile("s_waitcnt vmcnt(0) lgkmcnt(0)" ::: "memory"); __syncthreads();
}

constexpr int BM = 256, BK = 64, HALF = 128, HTB = HALF * BK * 2;
DI int lds_byte(int r, int c) { const int st = (r >> 4) * 2 + (c >> 5), rr = r & 15, cc = c & 31, ob = rr * 64 + cc * 2; return st * 1024 + (ob ^ (((ob >> 9) & 1) << 5)); }
DI void stage_rc(int b, int& R, int& C) { const int st = b / 1024, sb = b % 1024, swz = sb ^ (((sb >> 9) & 1) << 5); R = (st >> 1) * 16 + swz / 64; C = (st & 1) * 32 + (swz % 64) / 2; }
DI v8i_t cat32(bf16x8 lo, bf16x8 hi) { return __builtin_shufflevector(__builtin_bit_cast(v4i_t, lo), __builtin_bit_cast(v4i_t, hi), 0, 1, 2, 3, 4, 5, 6, 7); }
DI int perm32(int rho) { const int n = rho >> 4, i = rho & 15; return 8 * (i >> 2) + 4 * n + (i & 3); }

enum { K_PROJ = 0, K_MEMK, K_MEMVT, K_WOUT, K_WCQ, K_SC, K_PV, K_WCO, K_UP, K_DOWN };
enum { PH_MEMK = 100, PH_MEMV = 101 };
enum { PH_P0 = 0, PH_PROJ, PH_MIX, PH_WOUT, PH_WCQ, PH_SC, PH_PV, PH_WCO, PH_ROUTE, PH_UP, PH_DOWN0, PH_DOWN1, PH_N };

struct GUnit {
    int half;
    const char* A; const char* B;
    int kind, pm, pn;
    const int* gl; int gcnt;
    int aux;
};

DI int xcd_remap(int wgid, int nwg) { const int q = nwg / 8, r = nwg % 8, xcd = wgid % 8, off = wgid / 8; return (xcd < r ? xcd * (q + 1) : r * (q + 1) + (xcd - r) * q) + off; }
DI void grouped_tile(int wgid, int nM, int nN, int& pm, int& pn) {
    const int nig = 8 * nN, gid = wgid / nig, fm = gid * 8, gsz = (nM - fm) < 8 ? (nM - fm) : 8;
    pm = fm + ((wgid % nig) % gsz); pn = (wgid % nig) / gsz;
}

struct Sched { int G, c; unsigned char* ws; const LAS int* tbl; int round, wave; };
template <int PH> struct PCfg { static constexpr int K = 1024; static constexpr unsigned lda2 = 2048, ldb2 = 2048, hstepB = 32 * 2048; static constexpr int RS = 64; };
template <> struct PCfg<PH_UP> { static constexpr int K = 512; static constexpr unsigned lda2 = 1024, ldb2 = 1024, hstepB = 512 * 1024; static constexpr int RS = 32; };
template <> struct PCfg<PH_WCQ> { static constexpr int K = 512; static constexpr unsigned lda2 = 1024, ldb2 = 1024, hstepB = 32 * 1024; static constexpr int RS = 64; };
template <> struct PCfg<PH_WCO> { static constexpr int K = 512; static constexpr unsigned lda2 = 1024, ldb2 = 1024, hstepB = 32 * 1024; static constexpr int RS = 64; };
template <> struct PCfg<PH_DOWN0> { static constexpr int K = 256; static constexpr unsigned lda2 = 512, ldb2 = 512, hstepB = 32 * 512; static constexpr int RS = 64; };

template <int PH, int HV = 0> DI bool sched_next(const Sched& S, int i, GUnit& u) {
    const int L = i * S.G + S.c; unsigned char* ws = S.ws; (void)L;
    u.gl = nullptr; u.gcnt = 256; u.aux = 0; u.half = 0;
    if constexpr (PH == PH_PROJ) {
        constexpr int NP = 128 * 7;
        if (i >= 2) return false;
        const int L = (2 * S.round + i) * S.G + S.c;
        if (L >= NP) return false;
        const int w = xcd_remap(L, NP); grouped_tile(w, 128, 7, u.pm, u.pn); u.kind = K_PROJ;
        u.A = (const char*)(ws + WS_RA) + (size_t)u.pm * 256 * 2048; u.B = (const char*)(ws + WS_WIN) + (size_t)u.pn * 256 * 2048;
        return true;
    } else if constexpr (PH == PH_MEMK) {
        const int j = S.c - 128; if (i != 0 || j < 0 || j >= 32) return false;
        u.pm = j >> 2; u.pn = j & 3; u.kind = K_MEMK;
        u.A = (const char*)(ws + WS_MEMB) + (size_t)u.pm * 256 * 2048; u.B = (const char*)(ws + WS_WCK) + (size_t)u.pn * 256 * 2048;
        return true;
    } else if constexpr (PH == PH_MEMV) {
        const int j = S.c - 160; if (i != 0 || j < 0 || j >= 32) return false;
        u.pm = j >> 2; u.pn = j & 3; u.kind = K_MEMVT;
        u.A = (const char*)(ws + WS_MEMB) + (size_t)u.pm * 256 * 2048; u.B = (const char*)(ws + WS_WCV) + (size_t)u.pn * 256 * 2048;
        return true;
    } else if constexpr (PH == PH_WOUT || PH == PH_WCQ || PH == PH_WCO) {
        if (L >= 512) return false;
        const int w = xcd_remap(L, 512); grouped_tile(w, 128, 4, u.pm, u.pn);
        constexpr size_t wa = PH == PH_WOUT ? WS_RC : (PH == PH_WCQ ? WS_X2F8 : WS_RD), wb = PH == PH_WOUT ? WS_WOUT : (PH == PH_WCQ ? WS_WCQ : WS_WCO);
        u.kind = PH == PH_WOUT ? K_WOUT : (PH == PH_WCQ ? K_WCQ : K_WCO);
        constexpr size_t rb = PCfg<PH>::lda2;
        u.A = (const char*)(ws + wa) + (size_t)u.pm * 256 * rb; u.B = (const char*)(ws + wb) + (size_t)u.pn * 256 * rb;
        return true;
    } else {
        const LAS int* tbl = S.tbl;
        const int r0 = 0, r1 = 64;
        const int t0 = __builtin_amdgcn_readfirstlane(tbl[64 + r0]), t1 = __builtin_amdgcn_readfirstlane(tbl[64 + r1]), nu = (t1 - t0) * 4;
        const int nfull = nu / S.G, rem = nu - nfull * S.G;
        int Lu = L;
        if constexpr (HV) {
            if (i != 0 || 2 * rem > S.G || S.c >= 2 * rem || (S.c & 1) != HV - 1) return false;
            Lu = nfull * S.G + (S.c >> 1); u.half = HV;
        } else {
            if (i >= nfull) { if (i > nfull || 2 * rem <= S.G || S.c >= rem) return false; }
        }
        const int w = xcd_remap(Lu, nu); const int rt = t0 + (w >> 2), pn = w & 3;
        int ln_ = lane_id(); asm volatile("" : "+v"(ln_));
        const int jl = r0 + 1 + ln_;
        const bool hit = (jl < r1) && (tbl[64 + (jl < 64 ? jl : 64)] <= rt);
        const int re = r0 + (int)__popcll(__ballot(hit));
        const int jt = rt - __builtin_amdgcn_readfirstlane(tbl[64 + re]), cnt = __builtin_amdgcn_readfirstlane(tbl[re]), e = re & 31;
        u.pm = rt; u.pn = pn; u.gcnt = (cnt - jt * 256) < 256 ? (cnt - jt * 256) : 256; u.aux = re * CAP + jt * 256;
        if constexpr (PH == PH_UP) { u.kind = K_UP; u.gl = (const int*)(ws + WS_LTOK) + u.aux;
            u.A = (const char*)(ws + WS_X2F8); u.B = (const char*)(ws + WS_W13) + ((size_t)e * 1024 + pn * 128) * 1024; }
        else { u.kind = K_DOWN;
            u.A = (const char*)(ws + WS_RD) + (size_t)rt * 256 * 512; u.B = (const char*)(ws + WS_W2) + ((size_t)e * 1024 + pn * 256) * 512; }
        return true;
    }
}

struct EpiCtx {
    unsigned char* ws; float* out; const float* const* in;
};

DI void store_bf16x8(bf16_t* p, const f32x4& a, const f32x4& b) { u32x4 w; w.x = pk2(a[0], a[1]); w.y = pk2(a[2], a[3]); w.z = pk2(b[0], b[1]); w.w = pk2(b[2], b[3]); *(GAS u32x4*)p = w; }
DI float sumsq16(const f32x4& a, const f32x4& b, const f32x4& c, const f32x4& d) {
    return ((a[0] * a[0] + a[1] * a[1]) + (a[2] * a[2] + a[3] * a[3])) + ((b[0] * b[0] + b[1] * b[1]) + (b[2] * b[2] + b[3] * b[3])) +
           ((c[0] * c[0] + c[1] * c[1]) + (c[2] * c[2] + c[3] * c[3])) + ((d[0] * d[0] + d[1] * d[1]) + (d[2] * d[2] + d[3] * d[3]));
}
#define RSLOT(p) (((p) == 0 ? 4 : (p) == 1 ? 5 : (p) == 2 ? 0 : (p) == 3 ? 1 : (p) == 4 ? 6 : (p) == 5 ? 7 : 2) * 16384)
#define PIN_ROW(ai, m) asm volatile("" : "+v"(acc[ai][0][m][0]), "+v"(acc[ai][0][m][1]), "+v"(acc[ai][1][m][0]), "+v"(acc[ai][1][m][1]))
DI float quad_sum(float s) { s += __shfl_xor(s, 16); s += __shfl_xor(s, 32); return s; }

template <int PH, int HV = 0> DI void epilogue(const EpiCtx& E, const GUnit& u, f32x4 (&acc)[2][2][4][2], int wr, int wc, int fr_, int fq_, const float (&epre)[8], LAS unsigned char* lds, bool resl) {
    int fr = lane_id() & 15, fq = lane_id() >> 4; asm volatile("" : "+v"(fr), "+v"(fq));
    (void)fr_; (void)fq_;
    unsigned char* ws = E.ws;
    const int rbase = wr * 64 + fr;
    const int cb = 64 * wc + 8 * fq;
    const int kind = (PH == PH_PROJ) ? K_PROJ : (PH == PH_MEMK) ? K_MEMK : (PH == PH_MEMV) ? K_MEMVT : (PH == PH_WOUT ? K_WOUT : PH == PH_WCQ ? K_WCQ : PH == PH_WCO ? K_WCO : PH == PH_UP ? K_UP : K_DOWN);
    switch (kind) {
    case K_PROJ: {
        const int hd = 4 * u.pn + wc;
        bf16_t* PJ = (bf16_t*)(ws + WS_RB) + ((size_t)u.pm * 256 + rbase) * PJW + 64 * (hd < 12 ? hd - 8 : hd - 16) + 8 * fq;
        const int cmh = (hd < 8) ? hd : hd - 4;
        unsigned char* QU = ws + WS_RD + ((size_t)(u.pm * 8 + (rbase >> 5)) * 128 + 8 * cmh + fq) * 512 + (rbase & 31) * 16;
        const float* R0 = (const float*)(ws + WS_RSTD0) + (size_t)u.pm * 256 + rbase;
        float r0v[2][4];
#pragma unroll
        for (int ai = 0; ai < 2; ++ai)
#pragma unroll
            for (int m = 0; m < 4; ++m) r0v[ai][m] = *(const LAS float*)(lds + XCH_OFF + (ai * 128 + m * 16 + rbase) * 4);
        if (hd < 10) {
            const float* gp = (hd < 8) ? E.in[I_Q_NORM] : E.in[I_K_NORM]; const float sc = (hd < 8) ? 0.125f * 1.4426950408889634f : 1.0f;
#pragma unroll
            for (int ai = 0; ai < 2; ++ai)
#pragma unroll
                for (int m = 0; m < 4; ++m) {
                    const float r0 = r0v[ai][m];
                    const float ss = quad_sum(sumsq16(acc[ai][0][m][0], acc[ai][0][m][1], acc[ai][1][m][0], acc[ai][1][m][1])) * (r0 * r0);
                    const float rstd = sc * r0 / sqrtf(ss * (1.0f / 64.0f) + EPS);
#pragma unroll
                    for (int bj = 0; bj < 2; ++bj) {
                        const f32x4 g0 = *(const f32x4*)(gp + 32 * bj + 8 * fq), g1 = *(const f32x4*)(gp + 32 * bj + 8 * fq + 4);
                        if (hd < 8) store_bf16x8((bf16_t*)(QU + (size_t)((ai * 4 + (m >> 1)) * 128 + 4 * bj) * 512 + (m & 1) * 256), acc[ai][bj][m][0] * rstd * g0, acc[ai][bj][m][1] * rstd * g1);
                        else store_bf16x8(PJ + (size_t)(ai * 128 + m * 16) * PJW + 32 * bj, acc[ai][bj][m][0] * rstd * g0, acc[ai][bj][m][1] * rstd * g1);
                    }
                    asm volatile("" ::: "memory");
                }
        } else if (hd < 12) {
#pragma unroll
            for (int ai = 0; ai < 2; ++ai)
#pragma unroll
                for (int m = 0; m < 4; ++m) {
                    const float r0 = r0v[ai][m];
#pragma unroll
                    for (int bj = 0; bj < 2; ++bj) store_bf16x8(PJ + (size_t)(ai * 128 + m * 16) * PJW + 32 * bj, acc[ai][bj][m][0] * r0, acc[ai][bj][m][1] * r0);
                }
        } else {
#pragma unroll
            for (int ai = 0; ai < 2; ++ai)
#pragma unroll
                for (int m = 0; m < 4; ++m) {
                    const float r0 = r0v[ai][m];
#pragma unroll
                    for (int bj = 0; bj < 2; ++bj) {
                        f32x4 v0 = acc[ai][bj][m][0] * r0, v1 = acc[ai][bj][m][1] * r0;
#pragma unroll
                        for (int e = 0; e < 4; ++e) { v0[e] = gelu_tanh(v0[e]); v1[e] = gelu_tanh(v1[e]); }
                        if (hd < 20) store_bf16x8((bf16_t*)(QU + (size_t)((ai * 4 + (m >> 1)) * 128 + 4 * bj) * 512 + (m & 1) * 256), v0, v1);
                        else store_bf16x8(PJ + (size_t)(ai * 128 + m * 16) * PJW + 32 * bj, v0, v1);
                    }
                    asm volatile("" ::: "memory");
                }
        }
        break; }
    case K_MEMK: {
        bf16_t* KM = (bf16_t*)(ws + WS_KMEM); float* SK = (float*)(ws + WS_SSQK);
        f32x4 g[2][2];
#pragma unroll
        for (int bj = 0; bj < 2; ++bj)
#pragma unroll
            for (int n = 0; n < 2; ++n) g[bj][n] = *(const f32x4*)(E.in[I_CK_NORM] + cb + 32 * bj + 4 * n);
#pragma unroll
        for (int ai = 0; ai < 2; ++ai)
#pragma unroll
            for (int m = 0; m < 4; ++m) {
                const size_t grow = (size_t)u.pm * 256 + ai * 128 + m * 16 + rbase;
                const float ss = quad_sum(sumsq16(acc[ai][0][m][0], acc[ai][0][m][1], acc[ai][1][m][0], acc[ai][1][m][1]));
                if (fq == 0) SK[(grow * 4 + u.pn) * 4 + wc] = ss;
#pragma unroll
                for (int bj = 0; bj < 2; ++bj) store_bf16x8(KM + grow * D + u.pn * 256 + cb + 32 * bj, acc[ai][bj][m][0] * g[bj][0], acc[ai][bj][m][1] * g[bj][1]);
            }
        break; }
    case K_MEMVT: {
        bf16_t* VT = (bf16_t*)(ws + WS_VMT);
#pragma unroll
        for (int ai = 0; ai < 2; ++ai)
#pragma unroll
            for (int m = 0; m < 4; ++m) {
                const size_t grow = (size_t)u.pm * 256 + ai * 128 + m * 16 + rbase;
#pragma unroll
                for (int bj = 0; bj < 2; ++bj) store_bf16x8(VT + grow * D + u.pn * 256 + cb + 32 * bj, acc[ai][bj][m][0], acc[ai][bj][m][1]);
            }
        break; }
    case K_WOUT: {
        const size_t off0 = ((size_t)u.pm * 256 + rbase) * D + u.pn * 256 + cb;
        unsigned char* X8 = ws + WS_X2F8 + off0;
        bf16_t* XB = (bf16_t*)(ws + WS_RA) + off0; float* SP = (float*)(ws + WS_SSQ1P) + ((size_t)u.pm * 256 + rbase) * 16 + u.pn * 4 + wc;
        u32x4 rv[2][4][2];
#pragma unroll
        for (int ai = 0; ai < 2; ++ai)
#pragma unroll
            for (int m = 0; m < 4; ++m)
#pragma unroll
                for (int bj = 0; bj < 2; ++bj) rv[ai][m][bj] = (resl && !(ai == 1 && wc == 3)) ? *(const LAS u32x4*)(lds + RSLOT(ai * 4 + wc) + lds_byte(wr * 64 + m * 16 + fr, 32 * bj + 8 * fq)) : __builtin_nontemporal_load((const GAS u32x4*)(XB + (size_t)(ai * 128 + m * 16) * D + 32 * bj));
        asm volatile("" ::: "memory");
#pragma unroll
        for (int ai = 0; ai < 2; ++ai) {
#pragma unroll
            for (int m = 0; m < 4; ++m) {
                const size_t ro = (size_t)(ai * 128 + m * 16) * D;
                f32x4 v[2][2];
#pragma unroll
                for (int bj = 0; bj < 2; ++bj) {
                    const u32x4 r = rv[ai][m][bj];
                    f32x4 v0 = acc[ai][bj][m][0], v1 = acc[ai][bj][m][1];
                    v0[0] += bflo(r.x); v0[1] += bfhi(r.x); v0[2] += bflo(r.y); v0[3] += bfhi(r.y);
                    v1[0] += bflo(r.z); v1[1] += bfhi(r.z); v1[2] += bflo(r.w); v1[3] += bfhi(r.w);
                    v[bj][0] = v0; v[bj][1] = v1;
                    store_bf16x8(XB + ro + 32 * bj, v0, v1);
                    { u32x2 w8; w8.x = pk4_fp8(v0[0], v0[1], v0[2], v0[3]); w8.y = pk4_fp8(v1[0], v1[1], v1[2], v1[3]); *(GAS u32x2*)(X8 + ro + 32 * bj) = w8; }
                }
                const float ss = quad_sum(sumsq16(v[0][0], v[0][1], v[1][0], v[1][1])); if (fq == 0) SP[(size_t)(ai * 128 + m * 16) * 16] = ss;
            }
            asm volatile("" ::: "memory");
        }
        break; }
    case K_WCO: {
        const size_t off0 = ((size_t)u.pm * 256 + rbase) * D + u.pn * 256 + cb;
        const bf16_t* X1 = (const bf16_t*)(ws + WS_RA) + off0;
        bf16_t* XB = (bf16_t*)(ws + WS_RC) + off0;
        u32x4 rv[2][4][2];
#pragma unroll
        for (int ai = 0; ai < 2; ++ai)
#pragma unroll
            for (int m = 0; m < 4; ++m)
#pragma unroll
                for (int bj = 0; bj < 2; ++bj) rv[ai][m][bj] = (resl && !(ai == 1 && wc == 3)) ? *(const LAS u32x4*)(lds + RSLOT(ai * 4 + wc) + lds_byte(wr * 64 + m * 16 + fr, 32 * bj + 8 * fq)) : __builtin_nontemporal_load((const GAS u32x4*)(X1 + (size_t)(ai * 128 + m * 16) * D + 32 * bj));
        asm volatile("" ::: "memory");
#pragma unroll
        for (int ai = 0; ai < 2; ++ai) {
#pragma unroll
            for (int m = 0; m < 4; ++m) {
                const size_t ro = (size_t)(ai * 128 + m * 16) * D;
#pragma unroll
                for (int bj = 0; bj < 2; ++bj) {
                    const u32x4 r = rv[ai][m][bj];
                    f32x4 v0 = acc[ai][bj][m][0] * (1.0f / 512.0f), v1 = acc[ai][bj][m][1] * (1.0f / 512.0f);
                    v0[0] += bflo(r.x); v0[1] += bfhi(r.x); v0[2] += bflo(r.y); v0[3] += bfhi(r.y);
                    v1[0] += bflo(r.z); v1[1] += bfhi(r.z); v1[2] += bflo(r.w); v1[3] += bfhi(r.w);
                    store_bf16x8(XB + ro + 32 * bj, v0, v1);
                }
            }
            asm volatile("" ::: "memory");
        }
        break; }
    case K_WCQ: {
        unsigned char* QC = ws + WS_RB; const float* SP = (const float*)(ws + WS_SSQ1P); float* SQ = (float*)(ws + WS_SSQQ);
        f32x4 g[2][2];
#pragma unroll
        for (int bj = 0; bj < 2; ++bj)
#pragma unroll
            for (int n = 0; n < 2; ++n) g[bj][n] = *(const f32x4*)(E.in[I_CQ_NORM] + cb + 32 * bj + 4 * n);
        f32x4 pp[2][4];
#pragma unroll
        for (int ai = 0; ai < 2; ++ai)
#pragma unroll
            for (int m = 0; m < 4; ++m) pp[ai][m] = *(const f32x4*)(SP + ((size_t)u.pm * 256 + ai * 128 + m * 16 + rbase) * 16 + 4 * fq);
        asm volatile("" ::: "memory");
#pragma unroll
        for (int ai = 0; ai < 2; ++ai)
#pragma unroll
            for (int m = 0; m < 4; ++m) {
                const size_t grow = (size_t)u.pm * 256 + ai * 128 + m * 16 + rbase;
                const f32x4 p = pp[ai][m];
                const float tot = quad_sum((p[0] + p[1]) + (p[2] + p[3]));
                const float rstd1 = 0.03125f / sqrtf(tot * (1.0f / D) + EPS);
                f32x4 v[2][2];
#pragma unroll
                for (int bj = 0; bj < 2; ++bj)
#pragma unroll
                    for (int n = 0; n < 2; ++n) v[bj][n] = acc[ai][bj][m][n] * rstd1;
                const float ss = quad_sum(sumsq16(v[0][0], v[0][1], v[1][0], v[1][1]));
                if (fq == 0) SQ[(grow * 4 + u.pn) * 4 + wc] = ss;
#pragma unroll
                for (int bj = 0; bj < 2; ++bj) { const f32x4 q0 = v[bj][0] * g[bj][0], q1 = v[bj][1] * g[bj][1]; u32x2 w8; w8.x = pk4_fp8(q0[0], q0[1], q0[2], q0[3]); w8.y = pk4_fp8(q1[0], q1[1], q1[2], q1[3]);
                    *(GAS u32x2*)(QC + grow * D + u.pn * 256 + cb + 32 * bj) = w8; }
            }
        break; }
    case K_UP: {
        unsigned char* HID = ws + WS_RD;
#pragma unroll
        for (int ai = (HV ? HV - 1 : 0); ai < (HV ? HV : 2); ++ai)
#pragma unroll
            for (int m = 0; m < 4; ++m) {
                PIN_ROW(ai, m);
                const int lrow = ai * 128 + m * 16 + rbase;
                const float rs = (lrow < u.gcnt) ? *(const LAS float*)(lds + XCH_OFF + lrow * 4) * 0.03125f : 0.f;
                f32x4 hv[2];
#pragma unroll
                for (int n = 0; n < 2; ++n)
#pragma unroll
                    for (int e = 0; e < 4; ++e) hv[n][e] = silu(acc[ai][0][m][n][e] * rs) * (acc[ai][1][m][n][e] * rs);
                { u32x2 w8; w8.x = pk4_fp8(hv[0][0], hv[0][1], hv[0][2], hv[0][3]); w8.y = pk4_fp8(hv[1][0], hv[1][1], hv[1][2], hv[1][3]);
                  *(GAS u32x2*)(HID + ((size_t)u.pm * 256 + lrow) * 512 + u.pn * 128 + 32 * wc + 8 * fq) = w8; }
                asm volatile("" ::: "memory");
            }
        break; }
    case K_DOWN: {
        const int* LT = (const int*)(ws + WS_LTOK) + u.aux; const float* LG = (const float*)(ws + WS_LGATE) + u.aux;
        unsigned char* CB0 = ws + WS_RB + u.pn * 256 + cb; unsigned char* CB1 = ws + WS_RA + u.pn * 256 + cb;
        int tk[2][4]; float gt[2][4];
#pragma unroll
        for (int ai = (HV ? HV - 1 : 0); ai < (HV ? HV : 2); ++ai)
#pragma unroll
            for (int m = 0; m < 4; ++m) { const int lrow = ai * 128 + m * 16 + rbase; const bool ok = (lrow < u.gcnt); const int tv_ = *(const LAS int*)(lds + XCH_OFF + lrow * 4); const float gv_ = *(const LAS float*)(lds + XCH_OFF + 1024 + lrow * 4);        tk[ai][m] = ok ? tv_ : -1; gt[ai][m] = ok ? gv_ * 0.5f : 0.f; }
#pragma unroll
        for (int ai = (HV ? HV - 1 : 0); ai < (HV ? HV : 2); ++ai)
#pragma unroll
            for (int m = 0; m < 4; ++m) {
                if (tk[ai][m] >= 0) {
                    unsigned char* o = ((tk[ai][m] & 1) ? CB1 : CB0) + (size_t)(tk[ai][m] >> 1) * D; const float g = gt[ai][m];
#pragma unroll
                    for (int bj = 0; bj < 2; ++bj) { const f32x4 c0 = acc[ai][bj][m][0] * g, c1 = acc[ai][bj][m][1] * g; u32x2 w8; w8.x = pk4_fp8(c0[0], c0[1], c0[2], c0[3]); w8.y = pk4_fp8(c1[0], c1[1], c1[2], c1[3]);
                        *(GAS u32x2*)(o + 32 * bj) = w8; }
                }
            }
        break; }
    }
}

template <int PH> struct Stagger { static constexpr int ways = 1; static constexpr unsigned ticks = 0; };
#ifndef STG_WOUT
#define STG_WOUT 0
#endif
#ifndef STG_WCO
#define STG_WCO 0
#endif
#ifndef STG_DOWN
#define STG_DOWN 0
#endif
template <> struct Stagger<PH_WOUT> { static constexpr int ways = 2; static constexpr unsigned ticks = STG_WOUT; };
template <> struct Stagger<PH_WCO> { static constexpr int ways = 2; static constexpr unsigned ticks = STG_WCO; };
template <> struct Stagger<PH_DOWN0> { static constexpr int ways = 4; static constexpr unsigned ticks = STG_DOWN; };
template <int PH, int HV = 0> DI void gemm_phase(LAS unsigned char* lds, const Sched& S, const EpiCtx& E) {
    if constexpr (Stagger<PH>::ways > 1 && Stagger<PH>::ticks > 0) {
        const unsigned way = ((unsigned)S.c >> 3) % Stagger<PH>::ways;
        if (way) { const unsigned long long t0 = __builtin_amdgcn_s_memrealtime(), dl = (unsigned long long)way * Stagger<PH>::ticks;
            while (__builtin_amdgcn_s_memrealtime() - t0 < dl) __builtin_amdgcn_s_sleep(8); }
    }
    typedef PCfg<(PH == PH_DOWN1 ? PH_DOWN0 : PH)> g;
    constexpr bool GATHER = (PH == PH_UP);
    static_assert(PH != PH_UP || PCfg<PH_UP>::K / 64 >= 4, "the gather index prefetch needs two K trips");
    constexpr bool F8 = (PH == PH_UP || PH == PH_DOWN0 || PH == PH_WCQ || PH == PH_WCO);
    constexpr bool CMA = (PH == PH_WOUT || PH == PH_WCO);
    constexpr bool RESL = (PH == PH_WOUT || PH == PH_WCO);
    constexpr bool HALVES = (PH == PH_UP || PH == PH_DOWN0);
    int tid = S.wave * 64 + lane_id(); asm volatile("" : "+v"(tid));
    const int wid = __builtin_amdgcn_readfirstlane(tid >> 6), lane = tid & 63, wr = wid >> 2, wc = wid & 3, fr = lane & 15, fq = lane >> 4;
    constexpr int nt = g::K / BK;
    int R0, C0; stage_rc(tid * 16, R0, C0);
    const int RA0 = (wid >> 1) * 16 + (lane & 15), CA0 = (wid & 1) * 32 + (lane >> 4) * 8; (void)RA0; (void)CA0;
    unsigned vB[2], vA0[2], vR[2];
#pragma unroll
    for (int i = 0; i < 2; ++i) { const int R = R0 + 64 * i; vB[i] = (unsigned)(g::RS * (R >> 5) + perm32(R & 31)) * g::ldb2 + (unsigned)C0 * 2u; vR[i] = (unsigned)R * 2048u + (unsigned)C0 * 2u; vA0[i] = CMA ? (unsigned)((((RA0 + 64 * i) >> 5) * (int)(g::lda2 / 16) + (CA0 >> 3)) * 512 + ((RA0 + 64 * i) & 31) * 16) : (unsigned)R * g::lda2 + (unsigned)C0 * 2u; }
    const unsigned ldsw = (unsigned)wid * 1024u;
    const int aoff = CMA ? (wr * 8192 + fq * 256 + fr * 16) : lds_byte(wr * 64 + fr, fq * 8), boff = lds_byte(wc * 32 + fr, fq * 8);
    constexpr size_t hA = (size_t)HALF * g::lda2;
#define SA(b, h) (((b) * 2 + (h)) * HTB)
#define SB(b, h) ((4 + (b) * 2 + (h)) * HTB)
#define GLDS(gp, loff) __builtin_amdgcn_global_load_lds((const unsigned*)(gp), (LAS unsigned*)(lds + (loff)), 16, 0, 0)
#define STG_A(bufoff, base, h, useN) do { if constexpr (GATHER) { \
        GLDS((base) + vAc[h][0], (bufoff) + ldsw); GLDS((base) + vAc[h][1], (bufoff) + ldsw + 8192); } else { \
        GLDS((base) + (h) * hA + vA0[0], (bufoff) + ldsw); GLDS((base) + (h) * hA + vA0[1], (bufoff) + ldsw + 8192); } } while (0)
#define STG_B(bufoff, base) do { GLDS((base) + vB[0], (bufoff) + ldsw); GLDS((base) + vB[1], (bufoff) + ldsw + 8192); } while (0)
#define STG_BR(bufoff, base, piece) do { if constexpr (RESL) { const char* bb_ = resm ? resb + ((piece) >> 2) * (128 * 2048) + ((piece) & 3) * 128 : (const char*)(base); \
        GLDS(bb_ + (resm ? vR[0] : vB[0]), (bufoff) + ldsw); GLDS(bb_ + (resm ? vR[1] : vB[1]), (bufoff) + ldsw + 8192); } else { STG_B(bufoff, base); } } while (0)
#define STG_AR(bufoff, base, h, useN, piece) do { if constexpr (RESL) { const char* bb_ = resm ? resb + ((piece) >> 2) * (128 * 2048) + ((piece) & 3) * 128 : (const char*)(base) + (h) * hA; \
        GLDS(bb_ + (resm ? vR[0] : vA0[0]), (bufoff) + ldsw); GLDS(bb_ + (resm ? vR[1] : vA0[1]), (bufoff) + ldsw + 8192); } else { STG_A(bufoff, base, h, useN); } } while (0)
#define LDA(dst, b, h) do { _Pragma("unroll") for (int m = 0; m < 4; ++m) _Pragma("unroll") for (int k = 0; k < 2; ++k) dst[m][k] = *(const LAS bf16x8*)(lds + SA(b, h) + aoff + m * 2048 + k * 1024); } while (0)
#define LDB(dst, b, h) do { _Pragma("unroll") for (int n = 0; n < 2; ++n) _Pragma("unroll") for (int k = 0; k < 2; ++k) dst[n][k] = *(const LAS bf16x8*)(lds + SB(b, h) + boff + n * 2048 + k * 1024); } while (0)
#define MMA(ai, bj, At, Bt) do { __builtin_amdgcn_s_setprio(1); _Pragma("unroll") for (int m = 0; m < 4; ++m) _Pragma("unroll") for (int n = 0; n < 2; ++n) { if constexpr (F8) { \
        asm volatile("v_mfma_f32_16x16x128_f8f6f4 %0, %1, %2, %0" : "+v"(acc[ai][bj][m][n]) : "v"(cat32(Bt[n][0], Bt[n][1])), "v"(cat32(At[m][0], At[m][1]))); } else { _Pragma("unroll") for (int k = 0; k < 2; ++k) \
        acc[ai][bj][m][n] = __builtin_amdgcn_mfma_f32_16x16x32_bf16(Bt[n][k], At[m][k], acc[ai][bj][m][n], 0, 0, 0); } } __builtin_amdgcn_s_setprio(0); } while (0)
#define WAIT_V(n) asm volatile("s_waitcnt vmcnt(" #n ")" ::: "memory")
#define WAIT_L(n) asm volatile("s_waitcnt lgkmcnt(" #n ")" ::: "memory")
#define BAR __builtin_amdgcn_s_barrier()
#define SCHED __builtin_amdgcn_sched_barrier(0)
#define LOAD_IDX(ii, U) do { _Pragma("unroll") for (int h = 0; h < 2; ++h) _Pragma("unroll") for (int i = 0; i < 2; ++i) { const int r_ = 128 * h + R0 + 64 * i; \
        (ii)[h][i] = (U).gl[r_]; } } while (0)
#define IDX_TO_VA(vv, ii, U) do { _Pragma("unroll") for (int h = 0; h < 2; ++h) _Pragma("unroll") for (int i = 0; i < 2; ++i) { const int r_ = 128 * h + R0 + 64 * i; \
        (vv)[h][i] = (unsigned)((r_ < (U).gcnt) ? ((ii)[h][i] >> 1) : 0) * g::lda2 + (unsigned)C0 * 2u; } } while (0)
    GUnit cur, nxt; int ui = 0;
    if (!sched_next<PH, HV>(S, 0, cur)) return;
#ifdef TS_GEMM
#ifndef TS_GUNIT
#define TS_GUNIT -1
#endif
    constexpr bool TSG = (PH == TS_GEMM && HV == 0);
    unsigned long long tg0 = 0, tkl = 0, tep = 0, tcn = 0, tft = 0;
#endif
    f32x4 acc[2][2][4][2];
#pragma unroll
    for (int a = 0; a < 2; ++a)
#pragma unroll
        for (int b = 0; b < 2; ++b)
#pragma unroll
            for (int m = 0; m < 4; ++m)
#pragma unroll
                for (int n = 0; n < 2; ++n) acc[a][b][m][n] = (f32x4){0.f, 0.f, 0.f, 0.f};
    bf16x8 At[4][2], B0[2][2], B1[2][2];
    unsigned vAc[2][2]; int idxn[2][2]; float epre[8];
    if constexpr (GATHER) { LOAD_IDX(idxn, cur); IDX_TO_VA(vAc, idxn, cur); }
    const char* cA = cur.A; const char* cB = cur.B;
    constexpr size_t kstep = BK * 2; constexpr size_t hB = g::hstepB;
    constexpr size_t kstepA = CMA ? 8 * 512 : BK * 2;
    STG_B(SB(0, 0), cB); STG_B(SB(0, 1), cB + hB); STG_A(SA(0, 0), cA, 0, false); STG_A(SA(0, 1), cA, 1, false);
    if (wr == 1) BAR;
    WAIT_V(2); BAR;
    STG_B(SB(1, 0), cB + kstep); STG_A(SA(1, 0), cA + kstepA, 0, false); STG_B(SB(1, 1), cB + hB + kstep);
    WAIT_V(6); BAR;
    for (;;) {
        const bool has_next = sched_next<PH, HV>(S, ui + 1, nxt);
        const char* nA = has_next ? nxt.A : cA; const char* nB = has_next ? nxt.B : cB;
#ifdef TS_GEMM
        if (TSG) tg0 = rt_now();
#endif
#pragma unroll 1
        for (int t = 0; t < nt; t += 2) {
            const bool last = (t == nt - 2);
            asm volatile("" : "+v"(vB[0]), "+v"(vB[1]), "+v"(vA0[0]), "+v"(vA0[1]));
            if constexpr (RESL) asm volatile("" : "+v"(vR[0]), "+v"(vR[1]));
            if constexpr (GATHER) asm volatile("" : "+v"(vAc[0][0]), "+v"(vAc[0][1]), "+v"(vAc[1][0]), "+v"(vAc[1][1]));
            if constexpr (PH == PH_DOWN0) { if (last && wid < 4) {
                __builtin_amdgcn_global_load_lds((const unsigned*)((const int*)(E.ws + WS_LTOK) + cur.aux + 64 * wid + lane), (LAS unsigned*)(lds + XCH_OFF + 256 * wid), 4, 0, 0);
                __builtin_amdgcn_global_load_lds((const unsigned*)((const float*)(E.ws + WS_LGATE) + cur.aux + 64 * wid + lane), (LAS unsigned*)(lds + XCH_OFF + 1024 + 256 * wid), 4, 0, 0); } }
            if constexpr (PH == PH_PROJ) { if (last && wid < 4)
                __builtin_amdgcn_global_load_lds((const unsigned*)((const float*)(E.ws + WS_RSTD0) + (size_t)cur.pm * 256 + 64 * wid + lane), (LAS unsigned*)(lds + XCH_OFF + 256 * wid), 4, 0, 0); }
            if constexpr (GATHER) { if (t == nt - 4 && has_next && wid < 4)
                __builtin_amdgcn_global_load_lds((const unsigned*)(nxt.gl + 64 * wid + lane), (LAS unsigned*)(lds + XCH_OFF + 1024 + 256 * wid), 4, 0, 0); }
            if constexpr (GATHER) { if (last) {
                if (wid < 4) __builtin_amdgcn_global_load_lds((const unsigned*)((const float*)(E.ws + WS_LRSTD) + cur.aux + 64 * wid + lane), (LAS unsigned*)(lds + XCH_OFF + 256 * wid), 4, 0, 0); } }
            const bool resm = RESL && last && !has_next;
            const char* resb = (const char*)(E.ws + WS_RA) + ((size_t)cur.pm * 256 * D + cur.pn * 256) * 2;
            const char* a1 = cA + (size_t)(t + 1) * kstepA;
            const char* a2 = last ? nA : cA + (size_t)(t + 2) * kstepA; const char* b2 = last ? nB : cB + (size_t)(t + 2) * kstep;
            const char* a3 = a2 + kstepA; const char* b3 = b2 + kstep;
            LDB(B0, 0, 0); LDB(B1, 0, 1); SCHED; if constexpr (HV != 2) LDA(At, 0, 0); STG_A(SA(1, 1), a1, 1, false);
            WAIT_V(8); WAIT_L(0); BAR; if constexpr (HV != 2) { MMA(0, 0, At, B0); MMA(0, 1, At, B1); } BAR; SCHED;
            if constexpr (GATHER) { if (last) { if (has_next) {
#pragma unroll
                for (int h = 0; h < 2; ++h)
#pragma unroll
                    for (int i = 0; i < 2; ++i) idxn[h][i] = *(const LAS int*)(lds + XCH_OFF + 1024 + (128 * h + R0 + 64 * i) * 4);
                IDX_TO_VA(vAc, idxn, nxt); } } }
            if constexpr (HV != 1) LDA(At, 0, 1); STG_BR(SB(0, 0), b2, 0); STG_BR(SB(0, 1), b2 + hB, 1); STG_AR(SA(0, 0), a2, 0, last, 2);
            WAIT_V(8); WAIT_L(0); BAR; if constexpr (HV != 1) { MMA(1, 0, At, B0); MMA(1, 1, At, B1); } BAR; SCHED;
            LDB(B0, 1, 0); LDB(B1, 1, 1); SCHED; if constexpr (HV != 2) LDA(At, 1, 0); STG_AR(SA(0, 1), a2, 1, last, 3);
            WAIT_V(8); WAIT_L(0); BAR; if constexpr (HV != 2) { MMA(0, 0, At, B0); MMA(0, 1, At, B1); } BAR; SCHED;
            if constexpr (HV != 1) LDA(At, 1, 1); STG_BR(SB(1, 0), b3, 4); STG_BR(SB(1, 1), b3 + hB, 5); STG_AR(SA(1, 0), a3, 0, last, 6);
            WAIT_V(8); WAIT_L(0); BAR; if constexpr (HV != 1) { MMA(1, 0, At, B0); MMA(1, 1, At, B1); } BAR; SCHED;
#ifdef TS_GEMM
            if (TSG && t == 0) tft += rt_now() - tg0;
#endif
        }
#ifdef TS_GEMM
        unsigned long long tg1 = 0; if (TSG) { tg1 = rt_now(); if (TS_GUNIT < 0 || ui == TS_GUNIT) tkl += tg1 - tg0; }
#endif
        if constexpr (F8) asm volatile("s_nop 15\n\ts_nop 15" ::: "memory");
        if (wr == 0) BAR;
        if constexpr (RESL) { if (!has_next) { WAIT_V(0); BAR; } }
        epilogue<PH, HV>(E, cur, acc, wr, wc, fr, fq, epre, lds, RESL && !has_next);
#ifdef TS_GEMM
        if (TSG) { asm volatile("s_waitcnt vmcnt(0)" ::: "memory"); const unsigned long long tg2 = rt_now(); if (TS_GUNIT < 0 || ui == TS_GUNIT) tep += tg2 - tg1; ++tcn; }
#endif
        if (!has_next) break;
#pragma unroll
        for (int a = 0; a < 2; ++a)
#pragma unroll
            for (int b = 0; b < 2; ++b)
#pragma unroll
                for (int m = 0; m < 4; ++m)
#pragma unroll
                    for (int n = 0; n < 2; ++n) acc[a][b][m][n] = (f32x4){0.f, 0.f, 0.f, 0.f};
        cur = nxt; cA = nA; cB = nB; ++ui;
        if (wr == 1) BAR;
    }
    WAIT_V(0);
    BAR;
#ifdef TS_GEMM
    if (TSG && tid == 0) { volatile LAS unsigned long long* tsw_ = (volatile LAS unsigned long long*)(lds + MISC_OFF + 64); tsw_[14] = 0; tsw_[15] = tkl; tsw_[16] = tkl + tep; tsw_[17] = tkl + tep + tft; }
#endif
#undef SA
#undef SB
#undef GLDS
#undef STG_A
#undef STG_B
#undef STG_BR
#undef STG_AR
#undef LDA
#undef LDB
#undef MMA
#undef WAIT_V
#undef WAIT_L
#undef BAR
#undef SCHED
#undef LOAD_IDX
#undef IDX_TO_VA
}

DI int crow(int r, int hi) { return (r & 3) + 8 * (r >> 2) + 4 * hi; }
typedef short v4i16_t __attribute__((ext_vector_type(4)));
DI s16x4 vtr(const LAS unsigned char* p) { return __builtin_bit_cast(s16x4, __builtin_amdgcn_ds_read_tr16_b64_v4i16((LAS v4i16_t*)p)); }
#define MFMA32(a, b, c) __builtin_amdgcn_mfma_f32_32x32x16_bf16((a), (b), (c), 0, 0, 0)
DI bf16x8 cat8(s16x4 lo, s16x4 hi) { return __builtin_shufflevector(lo, hi, 0, 1, 2, 3, 4, 5, 6, 7); }
DI bf16x8 pack8(float a0, float a1, float a2, float a3, float a4, float a5, float a6, float a7) {
    u32x4 w; w.x = pk2(a0, a1); w.y = pk2(a2, a3); w.z = pk2(a4, a5); w.w = pk2(a6, a7); return __builtin_bit_cast(bf16x8, w);
}
DI void norm_store_unit(Frame& F, f32x16 (&ov)[4][2], int ql, int hh, unsigned char* dst0  ) {
    LAS float* xch = (LAS float*)(F.lds + SGP_OFF);
    __syncthreads();
#pragma unroll
    for (int blk = 0; blk < 4; ++blk) {
        float ss = 0.f;
#pragma unroll
        for (int d = 0; d < 2; ++d)
#pragma unroll
            for (int r = 0; r < 16; ++r) ss += ov[blk][d][r] * ov[blk][d][r];
        ss += __shfl_xor(ss, 32);
        if (hh == 0) xch[F.wave * 128 + 32 * blk + ql] = ss;
    }
    __syncthreads();
#pragma unroll
    for (int blk = 0; blk < 4; ++blk) {
        float tot = 0.f;
#pragma unroll
        for (int w = 0; w < 8; ++w) tot += xch[w * 128 + 32 * blk + ql];
        const float rstd = 1.0f / sqrtf(tot * (1.0f / 512.0f) + EPS);
#pragma unroll
        for (int d = 0; d < 2; ++d)
#pragma unroll
            for (int g = 0; g < 4; ++g) {
                u32x2 w; w.x = pk2(ov[blk][d][4 * g] * rstd, ov[blk][d][4 * g + 1] * rstd); w.y = pk2(ov[blk][d][4 * g + 2] * rstd, ov[blk][d][4 * g + 3] * rstd);
                *(GAS u32x2*)(dst0 + (size_t)blk * 128 * 512 + (size_t)(4 * d + g) * 512) = w;
            }
    }
}
DI void norm_store_512(Frame& F, f32x16 (&o)[2], int par, int ql, int hh, unsigned char* dst  ) {
    LAS float* xch = (LAS float*)(F.lds + XCH_OFF) + par * 256;
    float ss = 0.f;
#pragma unroll
    for (int d = 0; d < 2; ++d)
#pragma unroll
        for (int r = 0; r < 16; ++r) ss += o[d][r] * o[d][r];
    ss += __shfl_xor(ss, 32);
    if (hh == 0) xch[F.wave * 32 + ql] = ss;
    __syncthreads();
    float tot = 0.f;
#pragma unroll
    for (int w = 0; w < 8; ++w) tot += xch[w * 32 + ql];
    const float rstd = 1.0f / sqrtf(tot * (1.0f / 512.0f) + EPS);
#pragma unroll
    for (int d = 0; d < 2; ++d)
#pragma unroll
        for (int g = 0; g < 4; ++g) {
            u32x2 w; w.x = pk2(o[d][4 * g] * rstd, o[d][4 * g + 1] * rstd); w.y = pk2(o[d][4 * g + 2] * rstd, o[d][4 * g + 3] * rstd);
            *(GAS u32x2*)(dst + (size_t)(4 * d + g) * 512) = w;
        }
}

#if defined(TS_PHASE) && TS_PHASE >= 20
#define MSTAMP(k) do { __syncthreads(); if (F.tid == 0) ((volatile LAS unsigned long long*)(F.lds + MISC_OFF + 64))[k] = __builtin_amdgcn_s_memrealtime(); } while (0)
#else
#define MSTAMP(k) do { } while (0)
#endif
DI void attn_unit(Frame& F, int b, int n) {
    if (F.wave >= 4) __builtin_amdgcn_s_setprio(1);
    int tid = F.tid; asm volatile("" : "+v"(tid));
    const int lane = tid & 63, ql = lane & 31, hh = lane >> 5;
    const int t0 = b * SEQ + n * 128;
    const bf16_t* PJ = (const bf16_t*)(F.ws + WS_RB);
    bf16_t* MX = (bf16_t*)(F.ws + WS_RC);
    LAS unsigned char* lds = F.lds;
    const int h = F.wave, kvh = h >> 2;
    bf16x8 qfa[4][4];
#pragma unroll
    for (int i = 0; i < 4; ++i) { const unsigned char* qp = F.ws + WS_RD + ((size_t)((t0 >> 5) + i) * 128 + 8 * h + hh) * 512 + ql * 16;
#pragma unroll
        for (int ks = 0; ks < 4; ++ks) qfa[i][ks] = __builtin_nontemporal_load((const GAS bf16x8*)(qp + (size_t)(2 * ks) * 512)); }
    __syncthreads();
#pragma unroll 8
    for (int j = 0; j < 16; ++j) {
        const int p = tid + NTHR * j, row = p >> 5, c = p & 31;
        int tok = t0 - 128 + row; if (n == 0 && row < 128) tok = t0;
        const u32x4 v = *(const GAS u32x4*)(PJ + (size_t)tok * PJW + 8 * c);
        int addr;
        if (c < 16) { const int kvh = c >> 3, ch = c & 7; addr = kvh * 32768 + row * 128 + ((ch ^ ((row >> 1) & 7)) << 4); }
        else { const int cc = c - 16, kvh = cc >> 3, ch = cc & 7; addr = 65536 + kvh * 32768 + (ch >> 2) * 16384 + row * 64 + (ch & 3) * 16; }
        *(LAS u32x4*)(lds + addr) = v;
    }
    __syncthreads();
    const float sinkv = F.in[I_SINKS][h] * 1.4426950408889634f;
    const LAS unsigned char* Kb = lds + kvh * 32768;
    const LAS unsigned char* Vb = lds + 65536 + kvh * 32768;
    const int vtr_off = ((lane & 15) >> 2) * 64 + (16 * ((lane >> 4) & 1) + 4 * (lane & 3)) * 2;
#pragma unroll
    for (int i = 0; i < 4; ++i) {
        const bf16x8* qf = qfa[i];
        f32x16 s[5];
#pragma unroll
        for (int jt = 0; jt < 5; ++jt) {
            const int key = 32 * (i + jt) + ql;
            f32x16 a = {};
#pragma unroll
            for (int ks = 0; ks < 4; ++ks) {
                const bf16x8 kf = *(const LAS bf16x8*)(Kb + key * 128 + (((2 * ks + hh) ^ ((key >> 1) & 7)) << 4));
                a = MFMA32(kf, qf[ks], a);
            }
            s[jt] = a;
        }
        float m = sinkv;
#pragma unroll
        for (int jt = 0; jt < 5; ++jt) {
            const bool tile_ok = (n != 0) || (i + jt >= 4);
#pragma unroll
            for (int r = 0; r < 16; ++r) {
                const int c = crow(r, hh);
                bool ok = tile_ok;
                if (jt == 0) ok = ok && (c > ql);
                if (jt == 4) ok = ok && (c <= ql);
                const float v = ok ? s[jt][r] : -INFINITY;
                s[jt][r] = v; m = fmaxf(m, v);
            }
        }
        m = fmaxf(m, __shfl_xor(m, 32));
        float l = 0.f;
#pragma unroll
        for (int jt = 0; jt < 5; ++jt)
#pragma unroll
            for (int r = 0; r < 16; ++r) { const float p = __builtin_amdgcn_exp2f(s[jt][r] - m); s[jt][r] = p; l += p; }
        l += __shfl_xor(l, 32);
        l += __builtin_amdgcn_exp2f(sinkv - m);
        f32x16 o[2]; o[0] = f32x16{}; o[1] = f32x16{};
#pragma unroll
        for (int jt = 0; jt < 5; ++jt)
#pragma unroll
            for (int s2 = 0; s2 < 2; ++s2) {
                const bf16x8 pf = pack8(s[jt][8 * s2], s[jt][8 * s2 + 1], s[jt][8 * s2 + 2], s[jt][8 * s2 + 3], s[jt][8 * s2 + 4], s[jt][8 * s2 + 5], s[jt][8 * s2 + 6], s[jt][8 * s2 + 7]);
                const int k0 = 32 * (i + jt) + 16 * s2 + 4 * hh;
#pragma unroll
                for (int d = 0; d < 2; ++d) {
                    const LAS unsigned char* vp = Vb + d * 16384 + k0 * 64 + vtr_off;
                    const s16x4 lo = vtr(vp), hi = vtr(vp + 8 * 64);
                    o[d] = MFMA32(cat8(lo, hi), pf, o[d]);
                }
            }
        const float inv = 1.0f / l;
#pragma unroll
        for (int d = 0; d < 2; ++d)
#pragma unroll
            for (int r = 0; r < 16; ++r) o[d][r] *= inv;
        norm_store_512(F, o, i & 1, ql, hh, (unsigned char*)MX + ((size_t)((t0 >> 5) + i) * 128 + 8 * h) * 512 + ql * 16 + 8 * hh);
    }
    __builtin_amdgcn_s_setprio(0);
}

DI void sgu_unit(Frame& F, int b, int n) {
    int tid = F.tid; asm volatile("" : "+v"(tid));
    const int lane = tid & 63, ql = lane & 31, hh = lane >> 5, gi = F.wave;
    const int t0 = b * SEQ + n * 128;
    const bf16_t* PJ = (const bf16_t*)(F.ws + WS_RB);
    bf16_t* MX = (bf16_t*)(F.ws + WS_RC);
    LAS unsigned char* lds = F.lds;
    LAS float* sgp = (LAS float*)(lds + SGP_OFF);
    LAS float* sgr = (LAS float*)(lds + SGR_OFF);
    __syncthreads();
    MSTAMP(22);
    u32x4 gv[16];
    const int ch = lane & 7;
#pragma unroll
    for (int L = 0; L < 16; ++L) {
        const int tok = 8 * L + (lane >> 3);
        gv[L] = __builtin_nontemporal_load((const GAS u32x4*)(PJ + (size_t)(t0 + tok) * PJW + 256 + 64 * gi + 8 * ch));
    }
#pragma unroll
    for (int L = 0; L < 16; ++L) {
        const int tok = 8 * L + (lane >> 3);
        float ss = 0.f;
#pragma unroll
        for (int e = 0; e < 4; ++e) { const float a = bflo(gv[L][e]), c = bfhi(gv[L][e]); ss += a * a + c * c; }
        ss += __shfl_xor(ss, 1); ss += __shfl_xor(ss, 2); ss += __shfl_xor(ss, 4);
        if (ch == 0) sgp[gi * 128 + tok] = ss;
    }
    __syncthreads();
    if (tid < 128) { float tot = 0.f;
#pragma unroll
        for (int g = 0; g < 8; ++g) tot += sgp[g * 128 + tid];
        sgr[tid] = 1.0f / sqrtf(tot * (1.0f / 512.0f) + EPS); }
    __syncthreads();
    MSTAMP(23);
    float gn[8];
    { const f32x4 a = *(const f32x4*)(F.in[I_SGU_NORM] + 64 * gi + 8 * ch), c = *(const f32x4*)(F.in[I_SGU_NORM] + 64 * gi + 8 * ch + 4);
      gn[0] = a[0]; gn[1] = a[1]; gn[2] = a[2]; gn[3] = a[3]; gn[4] = c[0]; gn[5] = c[1]; gn[6] = c[2]; gn[7] = c[3]; }
    LAS unsigned char* vcb = lds + gi * 16384;
#pragma unroll
    for (int L = 0; L < 16; ++L) {
        const int tok = 8 * L + (lane >> 3);
        const float r = sgr[tok];
        u32x4 w;
#pragma unroll
        for (int e = 0; e < 4; ++e) w[e] = pk2(bflo(gv[L][e]) * r * gn[2 * e], bfhi(gv[L][e]) * r * gn[2 * e + 1]);
        *(LAS u32x4*)(vcb + (ch >> 2) * 8192 + tok * 64 + (ch & 3) * 16) = w;
    }
    LDS_WAIT();
    __syncthreads();
    MSTAMP(24);
    const bf16_t* Wg = (const bf16_t*)(F.ws + WS_WRT + 512 * 1024) + (size_t)gi * 128 * 128;
    const float* bias = F.in[I_SGU_B] + gi * 128;
    const int vtr_off = ((lane & 15) >> 2) * 64 + (16 * ((lane >> 4) & 1) + 4 * (lane & 3)) * 2;
    f32x16 ov[4][2];
#pragma unroll
    for (int ib = 0; ib < 4; ++ib) {
        const int it = 32 * ib + ql;
        f32x16 a[2]; a[0] = f32x16{}; a[1] = f32x16{};
        const float bi = bias[it];
        const unsigned char* up = F.ws + WS_RD + ((size_t)((t0 >> 5) + ib) * 128 + 64 + 8 * gi) * 512 + ql * 16 + 8 * hh;
        u32x2 uw[2][4];
#pragma unroll
        for (int d = 0; d < 2; ++d)
#pragma unroll
            for (int g = 0; g < 4; ++g) uw[d][g] = __builtin_nontemporal_load((const GAS u32x2*)(up + (size_t)(4 * d + g) * 512));
        bf16x8 wfr[8];
#pragma unroll
        for (int js = 0; js < 2 * (ib + 1); ++js) wfr[js] = *(const GAS bf16x8*)(Wg + (size_t)it * 128 + 16 * js + 8 * hh);
        s16x4 vlo[8][2], vhi[8][2];
#pragma unroll
        for (int js = 0; js < 2 * (ib + 1); ++js)
#pragma unroll
            for (int d = 0; d < 2; ++d) { const LAS unsigned char* vp = vcb + d * 8192 + (16 * js + 8 * hh) * 64 + vtr_off; vlo[js][d] = vtr(vp); vhi[js][d] = vtr(vp + 4 * 64); }
#pragma unroll
        for (int js = 0; js < 2 * (ib + 1); ++js)
#pragma unroll
            for (int d = 0; d < 2; ++d) a[d] = MFMA32(cat8(vlo[js][d], vhi[js][d]), wfr[js], a[d]);
#pragma unroll
        for (int d = 0; d < 2; ++d)
#pragma unroll
            for (int g = 0; g < 4; ++g) {
                const u32x2 uu = uw[d][g];
                a[d][4 * g] = bflo(uu.x) * (a[d][4 * g] + bi); a[d][4 * g + 1] = bfhi(uu.x) * (a[d][4 * g + 1] + bi);
                a[d][4 * g + 2] = bflo(uu.y) * (a[d][4 * g + 2] + bi); a[d][4 * g + 3] = bfhi(uu.y) * (a[d][4 * g + 3] + bi);
            }
        ov[ib][0] = a[0]; ov[ib][1] = a[1];
        asm volatile("" ::: "memory");
    }
    MSTAMP(25);
    norm_store_unit(F, ov, ql, hh, (unsigned char*)MX + ((size_t)(t0 >> 5) * 128 + 64 + 8 * gi) * 512 + ql * 16 + 8 * hh);
    MSTAMP(26);
}

DI void mix_phase(Frame& F) {
    { const int i = F.bid * NTHR + F.tid;
      if (i < NMEM * 4 * 8) { const int piece = i & 7, kh = i >> 3, key = kh >> 2, h = kh & 3;
          const f32x4 p = *(const f32x4*)((const float*)(F.ws + WS_SSQK) + (size_t)kh * 4);
          const float r = 1.0f / sqrtf(((p[0] + p[1]) + (p[2] + p[3])) * (1.0f / 256.0f) + EPS);
          GAS u32x4* kp = (GAS u32x4*)((bf16_t*)(F.ws + WS_KMEM) + (size_t)key * D + h * 256 + piece * 32);
#pragma unroll
          for (int q = 0; q < 4; ++q) { u32x4 v = kp[q];
#pragma unroll
              for (int e = 0; e < 4; ++e) v[e] = pk2(bflo(v[e]) * r, bfhi(v[e]) * r);
              kp[q] = v;
              u32x2 w8; w8.x = pk4_fp8(bflo(v[0]), bfhi(v[0]), bflo(v[1]), bfhi(v[1])); w8.y = pk4_fp8(bflo(v[2]), bfhi(v[2]), bflo(v[3]), bfhi(v[3]));
              *(GAS u32x2*)(F.ws + WS_MEMB + (size_t)key * D + h * 256 + piece * 32 + 8 * q) = w8; }
          { const GAS u32x4* vp = (const GAS u32x4*)((const bf16_t*)(F.ws + WS_VMT) + (size_t)key * D + h * 256 + piece * 32);
            const int keyl = key & 255, bb = key >> 8, kk = keyl & 31, pos = (keyl & 192) + 32 * ((kk >> 2) & 1) + 16 * ((keyl >> 5) & 1) + (kk & 3) + 4 * (kk >> 3);
            GAS unsigned char* vt = (GAS unsigned char*)(F.ws + WS_MEMB + 2 * MiB) + ((size_t)((bb * 4 + h) * 256 + piece * 32)) * 256 + pos;
#pragma unroll
            for (int q = 0; q < 4; ++q) { const u32x4 v = vp[q];
                const unsigned w0 = pk4_fp8(bflo(v[0]), bfhi(v[0]), bflo(v[1]), bfhi(v[1])), w1 = pk4_fp8(bflo(v[2]), bfhi(v[2]), bflo(v[3]), bfhi(v[3]));
#pragma unroll
                for (int e = 0; e < 4; ++e) { vt[(size_t)(8 * q + e) * 256] = (unsigned char)(w0 >> (8 * e)); vt[(size_t)(8 * q + 4 + e) * 256] = (unsigned char)(w1 >> (8 * e)); } } } } }
    MSTAMP(20);
    for (int uidx = F.bid; uidx < 256; uidx += F.G) attn_unit(F, uidx >> 5, uidx & 31);
    MSTAMP(21);
    for (int uidx = F.bid; uidx < 256; uidx += F.G) sgu_unit(F, uidx >> 5, uidx & 31);
    MSTAMP(27);
}

DI void xattn_unit(Frame& F, int pm, int pn, bool stage) {
    if (F.wave >= 4) __builtin_amdgcn_s_setprio(1);
    int tid = F.tid; asm volatile("" : "+v"(tid));
    const int lane = tid & 63, ql = lane & 31, hh = lane >> 5, w = F.wave;
    const int b = pm >> 4, h = pn;
    const size_t row = (size_t)pm * 256 + 32 * w + ql;
    LAS unsigned char* lds = F.lds;
    const unsigned char* QC = F.ws + WS_RB;
    v8i_t qf[4];
#pragma unroll
    for (int s4 = 0; s4 < 4; ++s4) { const u32x4 q0 = __builtin_nontemporal_load((const GAS u32x4*)(QC + row * D + h * 256 + 64 * s4 + 32 * hh)), q1 = __builtin_nontemporal_load((const GAS u32x4*)(QC + row * D + h * 256 + 64 * s4 + 32 * hh + 16));
        qf[s4] = __builtin_shufflevector(__builtin_bit_cast(v4i_t, q0), __builtin_bit_cast(v4i_t, q1), 0, 1, 2, 3, 4, 5, 6, 7); }
    const f32x4 pq = *(const f32x4*)((const float*)(F.ws + WS_SSQQ) + (row * 4 + h) * 4);
    const float rq = (0.0625f * 1.4426950408889634f) / sqrtf(((pq[0] + pq[1]) + (pq[2] + pq[3])) * (1.0f / 256.0f) + EPS);
    if (stage) {
    __syncthreads();
    { const unsigned char* KM = F.ws + WS_MEMB + (size_t)(b * MEML) * D + h * 256;
#pragma unroll
      for (int j = 0; j < 8; ++j) { const int p = tid + NTHR * j, key = p >> 4, c = p & 15;
          const u32x4 v = *(const GAS u32x4*)(KM + (size_t)key * D + 16 * c);
          *(LAS u32x4*)(lds + key * 256 + ((c ^ (key & 15)) << 4)) = v; } }
    { const unsigned char* VT = F.ws + WS_MEMB + 2 * MiB + (size_t)(b * 4 + h) * 65536;
#pragma unroll
      for (int j = 0; j < 8; ++j) { const int p = tid + NTHR * j, dr = p >> 4, c = p & 15;
          const u32x4 v = *(const GAS u32x4*)(VT + (size_t)dr * 256 + 16 * c);
          *(LAS u32x4*)(lds + 65536 + dr * 256 + ((c ^ (dr & 15)) << 4)) = v; } }
    __syncthreads();
    }
    const float shift2 = *(const float*)(F.ws + WS_WRT + 256 * 1024);
    v8i_t pb[4]; int sc[4];
    float l = 0.f;
#pragma unroll
    for (int tp = 0; tp < 4; ++tp) {
        f32x16 a0 = {}, a1 = {};
        const int key0 = 64 * tp + ql, key1 = key0 + 32;
#pragma unroll
        for (int s4 = 0; s4 < 4; ++s4) {
            const int c0 = ((4 * s4 + 2 * hh) ^ (key0 & 15)) << 4, c1 = ((4 * s4 + 2 * hh + 1) ^ (key0 & 15)) << 4;
            const v4i_t k00 = *(const LAS v4i_t*)(lds + key0 * 256 + c0), k01 = *(const LAS v4i_t*)(lds + key0 * 256 + c1);
            const v4i_t k10 = *(const LAS v4i_t*)(lds + key1 * 256 + c0), k11 = *(const LAS v4i_t*)(lds + key1 * 256 + c1);
            a0 = __builtin_amdgcn_mfma_scale_f32_32x32x64_f8f6f4(__builtin_shufflevector(k00, k01, 0, 1, 2, 3, 4, 5, 6, 7), qf[s4], a0, 0, 0, 0, 0, 0, 0);
            a1 = __builtin_amdgcn_mfma_scale_f32_32x32x64_f8f6f4(__builtin_shufflevector(k10, k11, 0, 1, 2, 3, 4, 5, 6, 7), qf[s4], a1, 0, 0, 0, 0, 0, 0);
        }
        float m = -3.0e38f;
#pragma unroll
        for (int r = 0; r < 16; ++r) m = fmaxf(m, fmaxf(a0[r], a1[r]));
        { const unsigned mu_ = __builtin_bit_cast(unsigned, m); const auto sw_ = __builtin_amdgcn_permlane32_swap(mu_, mu_, false, false); const unsigned s0_ = sw_[0], s1_ = sw_[1];
          m = fmaxf(__builtin_bit_cast(float, s0_), __builtin_bit_cast(float, s1_)); }
        int kx = (int)floorf(m * rq - shift2); kx = kx < -120 ? -120 : kx;
        const float sh = shift2 + (float)kx;
        float sum = 0.f;
#pragma unroll
        for (int r = 0; r < 16; ++r) { a0[r] = __builtin_amdgcn_exp2f(a0[r] * rq - sh); a1[r] = __builtin_amdgcn_exp2f(a1[r] * rq - sh); sum += a0[r] + a1[r]; }
        l += __builtin_ldexpf(sum, kx);
        v8i_t pw;
        pw[0] = (int)pk4_fp8(a0[0], a0[1], a0[2], a0[3]);   pw[1] = (int)pk4_fp8(a0[4], a0[5], a0[6], a0[7]);   pw[2] = (int)pk4_fp8(a0[8], a0[9], a0[10], a0[11]);   pw[3] = (int)pk4_fp8(a0[12], a0[13], a0[14], a0[15]);
        pw[4] = (int)pk4_fp8(a1[0], a1[1], a1[2], a1[3]);   pw[5] = (int)pk4_fp8(a1[4], a1[5], a1[6], a1[7]);   pw[6] = (int)pk4_fp8(a1[8], a1[9], a1[10], a1[11]);   pw[7] = (int)pk4_fp8(a1[12], a1[13], a1[14], a1[15]);
        pb[tp] = pw; sc[tp] = 127 + kx;
    }
    l += __shfl_xor(l, 32);
    const float inv = 1.0f / l;
    const float inv16 = 16.0f * inv;
    unsigned char* OC = F.ws + WS_RD + ((size_t)(pm * 8 + w) * 64 + h * 16) * 512 + ql * 16 + 8 * hh;
#pragma unroll
    for (int d = 0; d < 8; ++d) {
        f32x16 o = {};
#pragma unroll
        for (int tp = 0; tp < 4; ++tp) {
            const int dr = 32 * d + ql;
            const v4i_t v0 = *(const LAS v4i_t*)(lds + 65536 + dr * 256 + (((4 * tp + 2 * hh) ^ (dr & 15)) << 4)), v1 = *(const LAS v4i_t*)(lds + 65536 + dr * 256 + (((4 * tp + 2 * hh + 1) ^ (dr & 15)) << 4));
            o = __builtin_amdgcn_mfma_scale_f32_32x32x64_f8f6f4(__builtin_shufflevector(v0, v1, 0, 1, 2, 3, 4, 5, 6, 7), pb[tp], o, 0, 0, 0, 127, 0, sc[tp]);
        }
#pragma unroll
        for (int gp = 0; gp < 2; ++gp) {
            const unsigned w0 = pk4_fp8(o[8 * gp] * inv16, o[8 * gp + 1] * inv16, o[8 * gp + 2] * inv16, o[8 * gp + 3] * inv16), w1 = pk4_fp8(o[8 * gp + 4] * inv16, o[8 * gp + 5] * inv16, o[8 * gp + 6] * inv16, o[8 * gp + 7] * inv16);
            const auto sw = __builtin_amdgcn_permlane32_swap(w0, w1, false, false);
            u32x2 wv; wv.x = sw[0]; wv.y = sw[1];
            *(GAS u32x2*)(OC + (size_t)(2 * d + gp) * 512) = wv;
        }
    }
    __builtin_amdgcn_s_setprio(0);
}
DI void xattn_phase(Frame& F) {
    int sb = -1, sh = -1;
    for (int i = 0; i < 2; ++i) {
        const int L = i * F.G + F.bid; if (L >= 512) break;
        const int wg = xcd_remap(L, 512); int pm, pn; grouped_tile(wg, 128, 4, pm, pn);
        xattn_unit(F, pm, pn, (pm >> 4) != sb || pn != sh);
        sb = pm >> 4; sh = pn;
    }
    asm volatile("s_waitcnt vmcnt(0)" ::: "memory"); __syncthreads();
}

DI void route_phase(Frame& F, bool dummy) {
    const int lane = F.lane, tr = lane & 15, kq = lane >> 4, w = F.wave;
    const bf16_t* WRP = (const bf16_t*)(F.ws + WS_WRT);
    unsigned* cnt = (unsigned*)(F.ws + WS_CTL) + CW_CNT + (dummy ? 4096 : 0);
    int* LT = (int*)(F.ws + (dummy ? WS_RD : WS_LTOK)); float* LG = (float*)(F.ws + (dummy ? WS_RD + 8 * MiB : WS_LGATE)); float* LR = (float*)(F.ws + (dummy ? WS_RD + 16 * MiB : WS_LRSTD));
    LAS float* red = (LAS float*)(F.lds);
    LAS float* lgs = (LAS float*)(F.lds + 98304);
    LAS float* ssp = (LAS float*)(F.lds + 98304 + 25600);
    LAS unsigned* hist = (LAS unsigned*)(F.lds + 98304 + 25600 + 4096);
    bf16x8 bfr[4][3][2];
#pragma unroll
    for (int sp = 0; sp < 4; ++sp)
#pragma unroll
        for (int nb = 0; nb < 3; ++nb)
#pragma unroll
            for (int hl = 0; hl < 2; ++hl) bfr[sp][nb][hl] = *(const GAS bf16x8*)(WRP + ((size_t)(((4 * w + sp) * 3 + nb) * 2 + hl) * 64 + lane) * 8);
    for (int chunk = F.bid; chunk < T / 128; chunk += F.G) {
        __syncthreads();
        if (F.tid < 128) hist[F.tid] = 0u;
        const int tok0 = chunk * 128;
        const bf16_t* xbase = (const bf16_t*)(F.ws + WS_RC) + (size_t)(tok0 + tr) * D + 128 * w + 8 * kq;
        unsigned char* x8base = F.ws + (dummy ? WS_RD + 24 * MiB : WS_X2F8) + (size_t)(tok0 + tr) * D + 128 * w + 8 * kq;
        u32x4 xc[2][4], xn[2][4];
#pragma unroll
        for (int tq = 0; tq < 2; ++tq)
#pragma unroll
            for (int sp = 0; sp < 4; ++sp) xc[tq][sp] = *(const GAS u32x4*)(xbase + (size_t)(16 * tq) * D + 32 * sp);
#pragma unroll 1
        for (int half = 0; half < 4; ++half) {
            f32x4 acc[2][3];
            { const int hn = (half < 3) ? half + 1 : half;
#pragma unroll
              for (int tq = 0; tq < 2; ++tq)
#pragma unroll
                for (int sp = 0; sp < 4; ++sp) xn[tq][sp] = *(const GAS u32x4*)(xbase + (size_t)(16 * (2 * hn + tq)) * D + 32 * sp); }
#pragma unroll
            for (int tq = 0; tq < 2; ++tq) {
                const int tb = 2 * half + tq;
                float ss = 0.f;
                acc[tq][0] = (f32x4){0.f, 0.f, 0.f, 0.f}; acc[tq][1] = acc[tq][0]; acc[tq][2] = acc[tq][0];
#pragma unroll
                for (int sp = 0; sp < 4; ++sp) {
                    const u32x4 xw = xc[tq][sp];
#pragma unroll
                    for (int e = 0; e < 4; ++e) { const float a0 = bflo(xw[e]), a1 = bfhi(xw[e]); ss += a0 * a0 + a1 * a1; }
                    { u32x2 w8; w8.x = pk4_fp8(bflo(xw.x), bfhi(xw.x), bflo(xw.y), bfhi(xw.y)); w8.y = pk4_fp8(bflo(xw.z), bfhi(xw.z), bflo(xw.w), bfhi(xw.w));
                      *(GAS u32x2*)(x8base + (size_t)(16 * tb) * D + 32 * sp) = w8; }
                    const bf16x8 ah = __builtin_bit_cast(bf16x8, xw);
#pragma unroll
                    for (int nb = 0; nb < 3; ++nb) {
                        acc[tq][nb] = __builtin_amdgcn_mfma_f32_16x16x32_bf16(ah, bfr[sp][nb][0], acc[tq][nb], 0, 0, 0);
                        acc[tq][nb] = __builtin_amdgcn_mfma_f32_16x16x32_bf16(ah, bfr[sp][nb][1], acc[tq][nb], 0, 0, 0);
                    }
                }
                ss += __shfl_xor(ss, 16); ss += __shfl_xor(ss, 32);
                if (kq == 0) ssp[w * 128 + 16 * tb + tr] = ss;
            }
#pragma unroll
            for (int tq = 0; tq < 2; ++tq)
#pragma unroll
                for (int sp = 0; sp < 4; ++sp) xc[tq][sp] = xn[tq][sp];
#pragma unroll
            for (int tq = 0; tq < 2; ++tq)
#pragma unroll
                for (int nb = 0; nb < 3; ++nb)
#pragma unroll
                    for (int r = 0; r < 4; ++r) red[w * 1536 + ((tq * 3 + nb) * 4 + r) * 64 + lane] = acc[tq][nb][r];
            __syncthreads();
#pragma unroll
            for (int q = 0; q < 3; ++q) {
                const int e = F.tid + 512 * q, idx = e >> 6, ln = e & 63;
                float sum = 0.f;
#pragma unroll
                for (int ww = 0; ww < 8; ++ww) sum += red[ww * 1536 + e];
                const int r = idx & 3, nb = (idx >> 2) % 3, tq = idx / 12;
                lgs[(16 * (2 * half + tq) + 4 * (ln >> 4) + r) * 49 + 16 * nb + (ln & 15)] = sum;
            }
            __syncthreads();
        }
        __syncthreads();
        int re1 = 0, re2 = 0; float g1 = 0.f, g2 = 0.f, rstd = 0.f; unsigned s1 = 0, s2 = 0;
        const int t = F.tid;
        if (t < 128) {
            float ss = 0.f;
#pragma unroll
            for (int q = 0; q < 8; ++q) ss += ssp[q * 128 + t];
            rstd = 1.0f / sqrtf(ss * (1.0f / D) + EPS);
            float lg[36];
#pragma unroll
            for (int e = 0; e < 36; ++e) lg[e] = lgs[t * 49 + e] * rstd;
            float gmax = lg[0]; int gi = 0;
#pragma unroll
            for (int j = 1; j < 4; ++j) if (lg[j] > gmax) { gmax = lg[j]; gi = j; }
            float den = 0.f;
#pragma unroll
            for (int j = 0; j < 4; ++j) den += __expf(lg[j] - gmax);
            const float gwt = 1.0f / den;
            float le[8];
#pragma unroll
            for (int e = 0; e < 8; ++e) le[e] = gi == 0 ? lg[4 + e] : (gi == 1 ? lg[12 + e] : (gi == 2 ? lg[20 + e] : lg[28 + e]));
            float t1 = le[0]; int i1 = 0;
#pragma unroll
            for (int e = 1; e < 8; ++e) if (le[e] > t1) { t1 = le[e]; i1 = e; }
            float t2 = -INFINITY; int i2 = 0;
#pragma unroll
            for (int e = 0; e < 8; ++e) if (e != i1 && le[e] > t2) { t2 = le[e]; i2 = e; }
            const float ex = __expf(t2 - t1), p1 = 1.0f / (1.0f + ex), p2 = ex * p1;
            re1 = gi * 8 + i1; re2 = gi * 8 + i2; g1 = p1 * gwt; g2 = p2 * gwt;
            s1 = __hip_atomic_fetch_add(hist + re1, 1u, __ATOMIC_RELAXED, __HIP_MEMORY_SCOPE_WORKGROUP); s2 = __hip_atomic_fetch_add(hist + re2, 1u, __ATOMIC_RELAXED, __HIP_MEMORY_SCOPE_WORKGROUP);
        }
        __syncthreads();
        if (t < 64) { const unsigned c = hist[t]; hist[64 + t] = c ? __hip_atomic_fetch_add(cnt + 64 * t, c, RLX_AGENT) : 0u; }
        __syncthreads();
        if (t < 128) {
            const size_t p1 = (size_t)re1 * CAP + hist[64 + re1] + s1, p2 = (size_t)re2 * CAP + hist[64 + re2] + s2;
            LT[p1] = 2 * (tok0 + t); LG[p1] = g1; LR[p1] = rstd;
            LT[p2] = 2 * (tok0 + t) + 1; LG[p2] = g2; LR[p2] = rstd;
        }
    }
}
DI void build_tile_table(Frame& F) {
    LAS int* tbl = (LAS int*)(F.lds + TBL_OFF);
    unsigned* cnt = (unsigned*)(F.ws + WS_CTL) + CW_CNT;
    __syncthreads();
    if (F.tid < 64) tbl[F.tid] = (F.tid < 32) ? (int)__hip_atomic_load(cnt + 64 * F.tid, RLX_AGENT) : 0;
    __syncthreads();
    if (F.tid == 0) { int a = 0; for (int j = 0; j < 64; ++j) { tbl[64 + j] = a; a += (tbl[j] + 255) >> 8; } tbl[128] = a; }
    __syncthreads();
}

DI void final_phase(Frame& F) {
    const unsigned char* C0 = F.ws + WS_RB; const unsigned char* C1 = F.ws + WS_RA; const bf16_t* X2 = (const bf16_t*)(F.ws + WS_RC);
    const size_t n8 = (size_t)T * D / 8;
    for (size_t i = (size_t)F.bid * NTHR + F.tid; i < n8; i += (size_t)F.G * NTHR) {
        const u32x2 a = __builtin_nontemporal_load((const GAS u32x2*)(C0 + i * 8)), b = __builtin_nontemporal_load((const GAS u32x2*)(C1 + i * 8)); const u32x4 x = __builtin_nontemporal_load((const GAS u32x4*)(X2 + i * 8));
        const f32x2 a0 = __builtin_amdgcn_cvt_pk_f32_fp8((int)a.x, false), a1 = __builtin_amdgcn_cvt_pk_f32_fp8((int)a.x, true), a2 = __builtin_amdgcn_cvt_pk_f32_fp8((int)a.y, false), a3 = __builtin_amdgcn_cvt_pk_f32_fp8((int)a.y, true);
        const f32x2 b0 = __builtin_amdgcn_cvt_pk_f32_fp8((int)b.x, false), b1 = __builtin_amdgcn_cvt_pk_f32_fp8((int)b.x, true), b2 = __builtin_amdgcn_cvt_pk_f32_fp8((int)b.y, false), b3 = __builtin_amdgcn_cvt_pk_f32_fp8((int)b.y, true);
        GAS f32x4* o = (GAS f32x4*)(F.out + i * 8);
        f32x4 o0, o1;
        o0[0] = bflo(x.x) + (a0[0] + b0[0]) * 0.0625f; o0[1] = bfhi(x.x) + (a0[1] + b0[1]) * 0.0625f; o0[2] = bflo(x.y) + (a1[0] + b1[0]) * 0.0625f; o0[3] = bfhi(x.y) + (a1[1] + b1[1]) * 0.0625f;
        o1[0] = bflo(x.z) + (a2[0] + b2[0]) * 0.0625f; o1[1] = bfhi(x.z) + (a2[1] + b2[1]) * 0.0625f; o1[2] = bflo(x.w) + (a3[0] + b3[0]) * 0.0625f; o1[3] = bfhi(x.w) + (a3[1] + b3[1]) * 0.0625f;
        __builtin_nontemporal_store(o0, o); __builtin_nontemporal_store(o1, o + 1);
    }
}

DI void proj_phase(Frame& F, Sched& S, const EpiCtx& E) {
    const int g8 = F.bid & 7, slot = g8 < 3 ? 0 : (g8 < 6 ? 1 : 2);
#pragma unroll 1
    for (int part = 0; part < 4; ++part) {
        int pp = part; asm volatile("" : "+s"(pp));
        const bool dyn = (pp == 3);
        if (slot == pp || dyn) p0b_expert_weights(F, dyn ? 1 : 0);
        if (pp < 2) { S.round = pp; gemm_phase<PH_PROJ>(F.lds, S, E); }
        else if (pp == 2) { gemm_phase<PH_MEMK>(F.lds, S, E); gemm_phase<PH_MEMV>(F.lds, S, E); }
    }
    S.round = 0;
}
__global__ void __launch_bounds__(NTHR, 2) fwd_kernel(Args args) {
    extern __shared__ __attribute__((aligned(16))) unsigned char lds_raw[];
    Frame F;
    F.lds = (LAS unsigned char*)lds_raw;
    F.ws = args.ws; F.out = args.out; F.in = args.in;
    F.tid = threadIdx.x; F.lane = F.tid & 63; F.wave = __builtin_amdgcn_readfirstlane(F.tid >> 6);
    F.G = gridDim.x; F.bid = blockIdx.x;
    for (int u = F.tid; u < (LDS_BYTES - LDSCTL_OFF) / 4; u += NTHR) ((LAS unsigned*)(F.lds + LDSCTL_OFF))[u] = 0u;
    __syncthreads();
    unsigned* ctl = (unsigned*)(args.ws + WS_CTL);
    const int lo = args.ph_lo, hi = args.ph_hi;
    XcdBarrier bar; bar.bar = ctl + CW_BAR; bar.x = 0; bar.st = nullptr; bar.wave = F.wave;
    if (hi - lo > 1) bar = xcd_barrier_post(ctl + CW_BAR, (volatile LAS unsigned*)(F.lds + MISC_OFF) + 8, F.wave);
    Sched S; S.G = F.G; S.c = F.bid; S.ws = F.ws; S.tbl = (const LAS int*)(F.lds + TBL_OFF); S.round = 0; S.wave = F.wave;
    EpiCtx E; E.ws = F.ws; E.out = F.out; E.in = F.in;
#define IN(k) (lo <= (k) && (k) < hi)
#define SEAM(k) do { if (IN(k) && IN((k) + 1)) xcd_barrier(bar); } while (0)
#ifndef DUP_PHASE
#define DUP_PHASE -1
#endif
#ifndef TS_UNIT
#define TS_UNIT 100
#endif
#if TS_PHASE >= 0
    volatile LAS unsigned long long* tsw = (volatile LAS unsigned long long*)(F.lds + MISC_OFF + 64);
#define STAMP(k) do { if (F.tid == 0) tsw[k] = __builtin_amdgcn_s_memrealtime(); } while (0)
#else
#define STAMP(k) do { } while (0)
#endif
    STAMP(0);
#ifdef TS_PREK
#define PRESTAMP(k) do { if ((k) == TS_PREK && F.tid == 0) { tsw[14] = tsw[k]; tsw[15] = __builtin_amdgcn_s_memrealtime(); } } while (0)
#else
#define PRESTAMP(k) do { } while (0)
#endif
#ifndef TS_BID
#define TS_BID 0
#endif
#define RUNPH(k, body) do { if (IN(k)) { const int nrep_ = (DUP_PHASE == (k)) ? 2 + (lo >> 20) : 1; for (int rep_ = 0; rep_ < nrep_; ++rep_) { if (rep_) xcd_barrier(bar); { int t_ = F.wave * 64 + lane_id(); asm volatile("" : "+v"(t_)); F.tid = t_; F.lane = t_ & 63; } body; } } PRESTAMP(k); SEAM(k); STAMP((k) + 1); } while (0)
    RUNPH(PH_P0, p0_prologue(F));
#if DUP_PHASE == 100
    for (int i = 0; i < 4; ++i) xcd_barrier(bar);
#endif
    RUNPH(PH_PROJ, proj_phase(F, S, E));
    RUNPH(PH_MIX, mix_phase(F));
    RUNPH(PH_WOUT, gemm_phase<PH_WOUT>(F.lds, S, E));
    RUNPH(PH_WCQ, { gemm_phase<PH_WCQ>(F.lds, S, E); xattn_phase(F); });
    STAMP(PH_SC + 1); STAMP(PH_PV + 1);
    RUNPH(PH_WCO, gemm_phase<PH_WCO>(F.lds, S, E));
    RUNPH(PH_ROUTE, route_phase(F, rep_ + 1 < nrep_));
    RUNPH(PH_UP, { build_tile_table(F); gemm_phase<PH_UP>(F.lds, S, E); (gemm_phase<PH_UP, 1>)(F.lds, S, E); (gemm_phase<PH_UP, 2>)(F.lds, S, E); p0b_expert_weights(F, 2); });
    RUNPH(PH_DOWN0, { build_tile_table(F); gemm_phase<PH_DOWN0>(F.lds, S, E); (gemm_phase<PH_DOWN0, 1>)(F.lds, S, E); (gemm_phase<PH_DOWN0, 2>)(F.lds, S, E); });
    RUNPH(PH_DOWN1, final_phase(F));
#if TS_PHASE >= 0
    xcd_barrier(bar);
    if (F.bid == TS_BID && F.tid == 0) { const unsigned long long dt = (TS_PHASE == 30 ? (tsw[PH_N] - tsw[0]) : (tsw[TS_PHASE + 1] - tsw[TS_PHASE])) / TS_UNIT; F.out[0] += (float)(dt > 250ull ? 250ull : dt); }
#endif
#undef RUNPH
#undef IN
#undef SEAM
}

#ifndef N_LAUNCH_MODE
#define N_LAUNCH_MODE 1
#endif
extern "C" void kernel_launch(void* const* d_in, const int* in_sizes, int n_in, void* d_out, int out_size, void* d_ws, size_t ws_size, hipStream_t stream) {
    static int grid = 0;
    if (grid == 0) {
        if (n_in != 27 || out_size != T * D || ws_size < WS_END) { fprintf(stderr, "kernel_launch: unexpected shapes (n_in %d out %d ws %zu)\n", n_in, out_size, ws_size); grid = -1; return; }
        int dev = 0, cus = 0, per_cu = 0;
        if (hipGetDevice(&dev) != hipSuccess || hipDeviceGetAttribute(&cus, hipDeviceAttributeMultiprocessorCount, dev) != hipSuccess) { grid = -1; return; }
        if (hipFuncSetAttribute((const void*)fwd_kernel, hipFuncAttributeMaxDynamicSharedMemorySize, LDS_BYTES) != hipSuccess) { fprintf(stderr, "kernel_launch: hipFuncSetAttribute failed\n"); grid = -1; return; }
        if (hipOccupancyMaxActiveBlocksPerMultiprocessor(&per_cu, (const void*)fwd_kernel, NTHR, LDS_BYTES) != hipSuccess || per_cu < 1) { fprintf(stderr, "kernel_launch: occupancy query says %d\n", per_cu); }
        (void)hipGetLastError();
        grid = cus;
    }
    if (grid < 0) return;
    (void)hipMemsetAsync((char*)d_ws + WS_CTL, 0, CTL_ZERO_BYTES, stream);
    Args a{};
    for (int i = 0; i < 27; ++i) a.in[i] = (const float*)d_in[i];
    a.out = (float*)d_out; a.ws = (unsigned char*)d_ws;
    if (N_LAUNCH_MODE == 1) { a.ph_lo = 0; a.ph_hi = PH_N; hipLaunchKernelGGL(fwd_kernel, dim3(grid), dim3(NTHR), LDS_BYTES, stream, a); }
    else for (int p = 0; p < PH_N; ++p) { a.ph_lo = p; a.ph_hi = p + 1; hipLaunchKernelGGL(fwd_kernel, dim3(grid), dim3(NTHR), LDS_BYTES, stream, a); }
}
```
